# Optimizing an MI355X kernel written in HIP

```python
import math
import jax, jax.numpy as jnp
from jax import lax
import numpy as np

D_MODEL = 1024
BATCH = 16
SEQ = 2048
DEPTH = 2

HEAD_DIM = 64
SB_HEADS = 8
DIFF_HEADS = 4
DIFF_SUB = 64
DIFF_VDIM = 2 * DIFF_SUB
DSA_HEADS = 16
DSA_LATENT = 128
DSA_VDIM = 64
IDX_HEADS = 8
IDX_DIM = 64
TOPK_MAX = 256
N_EXPERTS = 32
TOP_K = 4
D_FF = 1024
SWIGLU_LIMIT = 7.0
SWIGLU_ALPHA = 1.702
Q_BLOCK = 128
LN_EPS = 1e-5
RMS_EPS = 1e-5
DEEPNORM_ALPHA = (2 * DEPTH) ** 0.25
DEEPNORM_BETA = (8 * DEPTH) ** -0.25
N_EVEN = (DEPTH + 1) // 2
N_ODD = DEPTH // 2

SB_W = SB_HEADS * HEAD_DIM
DIFF_QK_W = DIFF_HEADS * 2 * DIFF_SUB
DIFF_V_W = DIFF_HEADS * DIFF_VDIM
EVEN_COLS = 3 * SB_W + 2 * DIFF_QK_W + DIFF_V_W
EVEN_SPLITS = (SB_W, 2 * SB_W, 3 * SB_W, 3 * SB_W + DIFF_QK_W, 3 * SB_W + 2 * DIFF_QK_W)
EVEN_MIX_W = SB_W + DIFF_V_W

DSA_Q_W = DSA_HEADS * DSA_LATENT
ODD_SPLITS = (DSA_Q_W, DSA_Q_W + DSA_LATENT, DSA_Q_W + DSA_LATENT + IDX_HEADS * IDX_DIM,
              DSA_Q_W + DSA_LATENT + IDX_HEADS * IDX_DIM + IDX_DIM)
ODD_COLS = DSA_Q_W + DSA_LATENT + IDX_HEADS * IDX_DIM + IDX_DIM + IDX_HEADS
ODD_MIX_W = DSA_HEADS * DSA_VDIM

kernel_name = 'stickbreak_diff_dsa_moe_deepnorm'


def _alibi_slopes(n):
    return 2.0 ** (-8.0 * jnp.arange(1, n + 1, dtype=jnp.float32) / n)


def _layer_norm(x, g, b):
    xf = x.astype(jnp.float32)
    mu = jnp.mean(xf, axis=-1, keepdims=True)
    var = jnp.mean(jnp.square(xf - mu), axis=-1, keepdims=True)
    y = (xf - mu) * lax.rsqrt(var + LN_EPS) * g.astype(jnp.float32) + b.astype(jnp.float32)
    return y.astype(x.dtype)


def _rms_norm(x, w):
    xf = x.astype(jnp.float32)
    y = xf * lax.rsqrt(jnp.mean(xf * xf, axis=-1, keepdims=True) + RMS_EPS) * w.astype(jnp.float32)
    return y.astype(x.dtype)


def _even_mixer(x, w_in, w_out, lam_q1, lam_k1, lam_q2, lam_k2, subln_w, layer):
    f32 = jnp.float32
    bsz, seq_len, _ = x.shape
    proj = x @ w_in
    q_a, k_a, v_a, q_b, k_b, v_b = jnp.split(proj, list(EVEN_SPLITS), axis=-1)
    q_a = q_a.reshape(bsz, seq_len, SB_HEADS, HEAD_DIM)
    k_a = k_a.reshape(bsz, seq_len, SB_HEADS, HEAD_DIM)
    v_a = v_a.reshape(bsz, seq_len, SB_HEADS, HEAD_DIM)
    q_b = q_b.reshape(bsz, seq_len, DIFF_HEADS, 2, DIFF_SUB)
    k_b = k_b.reshape(bsz, seq_len, DIFF_HEADS, 2, DIFF_SUB)
    v_b = v_b.reshape(bsz, seq_len, DIFF_HEADS, DIFF_VDIM)

    lam_init = 0.8 - 0.6 * math.exp(-0.3 * layer)
    lam = (jnp.exp(jnp.sum(lam_q1.astype(f32) * lam_k1.astype(f32)))
           - jnp.exp(jnp.sum(lam_q2.astype(f32) * lam_k2.astype(f32))) + lam_init)
    slopes = _alibi_slopes(DIFF_HEADS)
    sb_scale = HEAD_DIM ** -0.5
    diff_scale = DIFF_SUB ** -0.5
    key_pos = jnp.arange(seq_len)

    def block(i):
        t0 = i * Q_BLOCK
        t = t0 + jnp.arange(Q_BLOCK)
        dist = t[:, None] - key_pos[None, :]
        qa = lax.dynamic_slice_in_dim(q_a, t0, Q_BLOCK, axis=1)
        qb = lax.dynamic_slice_in_dim(q_b, t0, Q_BLOCK, axis=1)

        z = jnp.einsum('bqhd,bshd->bhqs', qa, k_a).astype(f32) * sb_scale
        strict = dist > 0
        log_keep = jnp.where(strict, jax.nn.log_sigmoid(-z), 0.0)
        log_after = lax.cumsum(log_keep, axis=3, reverse=True) - log_keep
        attn_a = jnp.where(strict, jnp.exp(jax.nn.log_sigmoid(z) + log_after), 0.0)
        o_a = jnp.einsum('bhqs,bshd->bqhd', attn_a.astype(v_a.dtype), v_a)

        s = jnp.einsum('bqhcd,bshcd->bhcqs', qb, k_b).astype(f32) * diff_scale
        s = s - slopes[:, None, None, None] * dist.astype(f32)
        s = jnp.where(dist >= 0, s, -jnp.inf)
        p = jax.nn.softmax(s, axis=-1)
        p = p[:, :, 0] - lam * p[:, :, 1]
        o_b = jnp.einsum('bhqs,bshe->bqhe', p.astype(v_b.dtype), v_b)
        o_b = _rms_norm(o_b, subln_w) * (1.0 - lam_init)

        return jnp.concatenate([o_a.reshape(bsz, Q_BLOCK, SB_W),
                                o_b.reshape(bsz, Q_BLOCK, DIFF_V_W)], axis=-1)

    out = lax.map(block, jnp.arange(seq_len // Q_BLOCK))
    out = jnp.moveaxis(out, 0, 1).reshape(bsz, seq_len, EVEN_MIX_W)
    return out @ w_out


def _odd_mixer(x, w_in, kv_norm_w, w_uv, w_out):
    f32 = jnp.float32
    bsz, seq_len, _ = x.shape
    k_sel = min(TOPK_MAX, seq_len // 4)
    proj = x @ w_in
    q, c_kv, q_idx, k_idx, w_idx = jnp.split(proj, list(ODD_SPLITS), axis=-1)
    q = q.reshape(bsz, seq_len, DSA_HEADS, DSA_LATENT)
    c_kv = _rms_norm(c_kv, kv_norm_w)
    q_idx = q_idx.reshape(bsz, seq_len, IDX_HEADS, IDX_DIM)
    w_idx = w_idx * (IDX_HEADS ** -0.5)
    slopes = _alibi_slopes(DSA_HEADS)
    idx_scale = IDX_DIM ** -0.5
    attn_scale = DSA_LATENT ** -0.5
    key_pos = jnp.arange(seq_len)
    batch_ix = jnp.arange(bsz)[:, None, None]

    def block(i):
        t0 = i * Q_BLOCK
        t = t0 + jnp.arange(Q_BLOCK)
        qi = lax.dynamic_slice_in_dim(q_idx, t0, Q_BLOCK, axis=1)
        wi = lax.dynamic_slice_in_dim(w_idx, t0, Q_BLOCK, axis=1)
        qm = lax.dynamic_slice_in_dim(q, t0, Q_BLOCK, axis=1)
        rel = jax.nn.relu(jnp.einsum('bqhd,bsd->bqhs', qi, k_idx).astype(f32) * idx_scale)
        score = jnp.einsum('bqhs,bqh->bqs', rel, wi.astype(f32))
        score = jnp.where(key_pos[None, None, :] <= t[None, :, None], score, -jnp.inf)
        _, idx = lax.top_k(score, k_sel)
        c_sel = c_kv[batch_ix, idx]
        valid = idx <= t[None, :, None]
        dist = (t[None, :, None] - idx).astype(f32)
        s = jnp.einsum('bqhc,bqkc->bqhk', qm, c_sel).astype(f32) * attn_scale
        s = s - slopes[None, None, :, None] * dist[:, :, None, :]
        s = jnp.where(valid[:, :, None, :], s, -jnp.inf)
        p = jax.nn.softmax(s, axis=-1)
        o = jnp.einsum('bqhk,bqkc->bqhc', p.astype(c_sel.dtype), c_sel)
        o = jnp.einsum('bqhc,hcd->bqhd', o, w_uv)
        return o.reshape(bsz, Q_BLOCK, ODD_MIX_W)

    out = lax.map(block, jnp.arange(seq_len // Q_BLOCK))
    out = jnp.moveaxis(out, 0, 1).reshape(bsz, seq_len, ODD_MIX_W)
    return out @ w_out


def _moe(x, router_w, router_b, w_gu, b_gu, w_down, b_down):
    bsz, seq_len, d = x.shape
    xt = x.reshape(-1, d)
    logits = (xt @ router_w + router_b).astype(jnp.float32)
    top_val, top_idx = lax.top_k(logits, TOP_K)
    gates = jax.nn.softmax(top_val, axis=-1)
    combine = jnp.sum(jax.nn.one_hot(top_idx, N_EXPERTS, dtype=jnp.float32) * gates[..., None], axis=1)

    def expert_step(acc, params):
        wgu, bgu, wd, bd, cw = params
        hgu = xt @ wgu + bgu
        gate = jnp.minimum(hgu[:, :D_FF], SWIGLU_LIMIT)
        up = jnp.clip(hgu[:, D_FF:], -SWIGLU_LIMIT, SWIGLU_LIMIT)
        act = gate * jax.nn.sigmoid(SWIGLU_ALPHA * gate) * (up + 1.0)
        y = act @ wd + bd
        return acc + cw[:, None] * y.astype(jnp.float32), None

    acc0 = jnp.zeros(xt.shape, jnp.float32)
    acc, _ = lax.scan(expert_step, acc0, (w_gu, b_gu, w_down, b_down, combine.T))
    return acc.astype(x.dtype).reshape(bsz, seq_len, d)


def setup_inputs(seed: int = 0) -> dict:
    key = jax.random.key(seed)
    ks = jax.random.split(key, 24)
    f32 = jnp.float32
    beta = DEEPNORM_BETA
    nrm = lambda k, shape: jax.random.normal(k, shape, f32)
    even_col_scale = jnp.concatenate([
        jnp.ones((2 * SB_W,), f32), jnp.full((SB_W,), beta, f32),
        jnp.ones((2 * DIFF_QK_W,), f32), jnp.full((DIFF_V_W,), beta, f32)])
    return {
        'x': nrm(ks[0], (BATCH, SEQ, D_MODEL)),
        'ev_w_in': nrm(ks[1], (N_EVEN, D_MODEL, EVEN_COLS)) * (D_MODEL ** -0.5) * even_col_scale,
        'ev_w_out': nrm(ks[2], (N_EVEN, EVEN_MIX_W, D_MODEL)) * (EVEN_MIX_W ** -0.5) * beta,
        'ev_lambda_q1': nrm(ks[3], (N_EVEN, DIFF_SUB)) * 0.1,
        'ev_lambda_k1': nrm(ks[4], (N_EVEN, DIFF_SUB)) * 0.1,
        'ev_lambda_q2': nrm(ks[5], (N_EVEN, DIFF_SUB)) * 0.1,
        'ev_lambda_k2': nrm(ks[6], (N_EVEN, DIFF_SUB)) * 0.1,
        'ev_subln_w': 1.0 + 0.02 * nrm(ks[7], (N_EVEN, DIFF_VDIM)),
        'od_w_in': nrm(ks[8], (N_ODD, D_MODEL, ODD_COLS)) * (D_MODEL ** -0.5),
        'od_kv_norm_w': 1.0 + 0.02 * nrm(ks[9], (N_ODD, DSA_LATENT)),
        'od_w_uv': nrm(ks[10], (N_ODD, DSA_HEADS, DSA_LATENT, DSA_VDIM)) * (DSA_LATENT ** -0.5) * beta,
        'od_w_out': nrm(ks[11], (N_ODD, ODD_MIX_W, D_MODEL)) * (ODD_MIX_W ** -0.5) * beta,
        'ln_mix_g': 1.0 + 0.02 * nrm(ks[12], (DEPTH, D_MODEL)),
        'ln_mix_b': 0.02 * nrm(ks[13], (DEPTH, D_MODEL)),
        'router_w': nrm(ks[14], (DEPTH, D_MODEL, N_EXPERTS)) * (D_MODEL ** -0.5),
        'router_b': 0.01 * nrm(ks[15], (DEPTH, N_EXPERTS)),
        'exp_w_gu': nrm(ks[16], (DEPTH, N_EXPERTS, D_MODEL, 2 * D_FF)) * (D_MODEL ** -0.5) * beta,
        'exp_b_gu': 0.02 * nrm(ks[17], (DEPTH, N_EXPERTS, 2 * D_FF)),
        'exp_w_down': nrm(ks[18], (DEPTH, N_EXPERTS, D_FF, D_MODEL)) * (D_FF ** -0.5) * beta,
        'exp_b_down': 0.02 * nrm(ks[19], (DEPTH, N_EXPERTS, D_MODEL)),
        'ln_ffn_g': 1.0 + 0.02 * nrm(ks[20], (DEPTH, D_MODEL)),
        'ln_ffn_b': 0.02 * nrm(ks[21], (DEPTH, D_MODEL)),
    }


def reference(x, ev_w_in, ev_w_out, ev_lambda_q1, ev_lambda_k1, ev_lambda_q2, ev_lambda_k2,
              ev_subln_w, od_w_in, od_kv_norm_w, od_w_uv, od_w_out, ln_mix_g, ln_mix_b,
              router_w, router_b, exp_w_gu, exp_b_gu, exp_w_down, exp_b_down,
              ln_ffn_g, ln_ffn_b):
    h = x
    for layer in range(DEPTH):
        j = layer // 2
        if layer % 2 == 0:
            mix = _even_mixer(h, ev_w_in[j], ev_w_out[j], ev_lambda_q1[j], ev_lambda_k1[j],
                              ev_lambda_q2[j], ev_lambda_k2[j], ev_subln_w[j], layer)
        else:
            mix = _odd_mixer(h, od_w_in[j], od_kv_norm_w[j], od_w_uv[j], od_w_out[j])
        h = _layer_norm(DEEPNORM_ALPHA * h + mix, ln_mix_g[layer], ln_mix_b[layer])
        ffn = _moe(h, router_w[layer], router_b[layer], exp_w_gu[layer], exp_b_gu[layer],
                   exp_w_down[layer], exp_b_down[layer])
        h = _layer_norm(DEEPNORM_ALPHA * h + ffn, ln_ffn_g[layer], ln_ffn_b[layer])
    return h
```

```cpp
#include <hip/hip_runtime.h>
#include <cstdio>
#include <cstdint>

#ifndef MK_PER_PHASE
#define MK_PER_PHASE 0
#endif

#define GAS __attribute__((address_space(1)))
#define LAS __attribute__((address_space(3)))
typedef unsigned short bf16_t;
typedef short bf16x8 __attribute__((ext_vector_type(8)));
typedef short s16x4 __attribute__((ext_vector_type(4)));
typedef float f32x2 __attribute__((ext_vector_type(2)));
typedef float f32x4 __attribute__((ext_vector_type(4)));
typedef float f32x16 __attribute__((ext_vector_type(16)));
typedef unsigned u32x2 __attribute__((ext_vector_type(2)));
typedef unsigned u32x4 __attribute__((ext_vector_type(4)));
typedef int i32x4 __attribute__((ext_vector_type(4)));
typedef GAS unsigned gu32;
#define RLX_AGENT __ATOMIC_RELAXED, __HIP_MEMORY_SCOPE_AGENT
#define DI __device__ __forceinline__

constexpr int BATCH = 16, SEQ = 2048, T = BATCH * SEQ, D = 1024;
constexpr int NEXP = 32, DFF = 1024;
constexpr int EV_COLS = 3072, OD_COLS = 2760, OD_COLS_P = 2816;
constexpr float ALPHA = 1.41421356237309515f;
constexpr float LN_EPS = 1e-5f, RMS_EPS = 1e-5f;
constexpr float LOG2E = 1.4426950408889634f;
constexpr int MAXROWS = 131072 + 32 * 256;
constexpr int NWAVES = 8, NTHR = 512;
#ifndef MOE_FP8_ON
#define MOE_FP8_ON 1
#endif
constexpr bool MOE_FP8 = MOE_FP8_ON != 0;
constexpr int MOE_EB = MOE_FP8 ? 1 : 2;
#ifndef PLAIN_FP8_ON
#define PLAIN_FP8_ON 1
#endif
constexpr bool PLAIN_FP8 = PLAIN_FP8_ON != 0;
#ifndef IN_FP8_ON
#define IN_FP8_ON 0
#endif
constexpr bool IN_FP8 = IN_FP8_ON != 0;
#ifndef IN1_FP8_ON
#define IN1_FP8_ON 0
#endif
constexpr bool IN1_FP8 = IN1_FP8_ON != 0;
constexpr int PL_EB = PLAIN_FP8 ? 1 : 2, IN_EB = IN_FP8 ? 1 : 2, IN1_EB = IN1_FP8 ? 1 : 2;
constexpr float YSCALE = 64.0f;
constexpr float MSCALE = 32.0f, WCSCALE = 1024.0f;
constexpr float WSCALE = 256.0f, XSCALE = 16.0f, ASCALE = 4.0f;

constexpr size_t MiB = 1u << 20;
constexpr size_t WS_CTL = 0, CTL_ZERO_BYTES = 1 * MiB;
constexpr size_t WS_WEVIN = 1 * MiB;
constexpr size_t WS_WEVOUT = 7 * MiB;
constexpr size_t WS_WODIN = 9 * MiB;
constexpr size_t WS_WCOMB = 15 * MiB;
constexpr size_t WS_WR = 19 * MiB;
constexpr size_t WS_WGU = 20 * MiB;
constexpr size_t WS_WD = 276 * MiB;
constexpr size_t WS_XB = 404 * MiB;
constexpr size_t WS_HB = 468 * MiB;
constexpr size_t WS_R1 = 532 * MiB;
constexpr size_t WS_R2 = 804 * MiB;
constexpr size_t WS_PRE = 1076 * MiB;
constexpr size_t WS_H1 = 1204 * MiB;
constexpr size_t WS_X8 = 1332 * MiB;
constexpr size_t WS_PERM = 1460 * MiB;
constexpr size_t WS_TOKER = 1464 * MiB;
constexpr size_t WS_TOKG = 1465 * MiB;
constexpr size_t WS_CKV = 1466 * MiB;
constexpr size_t WS_IDX = 1474 * MiB;
constexpr size_t WS_END = 1506 * MiB;
constexpr int CW_CNT0 = 64, CW_CNT1 = 128;
constexpr int CW_BAR = 4096;

constexpr int LDS_STAGE = 0, LDS_TAB = 131072, LDS_BIAS = 131072 + 18 * 1024, LDS_INTS = 151552, LDS_MISC = 152576, LDS_BYTES = 153600;

DI unsigned pk_bf16(float lo, float hi) { typedef __bf16 b2 __attribute__((ext_vector_type(2))); f32x2 v = {lo, hi}; b2 b = __builtin_convertvector(v, b2); return __builtin_bit_cast(unsigned, b); }
DI unsigned pk_fp8x4(float a, float b, float c, float d) {
    a = fminf(fmaxf(a, -440.f), 440.f); b = fminf(fmaxf(b, -440.f), 440.f); c = fminf(fmaxf(c, -440.f), 440.f); d = fminf(fmaxf(d, -440.f), 440.f);
    int p = __builtin_amdgcn_cvt_pk_fp8_f32(a, b, 0, false); p = __builtin_amdgcn_cvt_pk_fp8_f32(c, d, p, true); return (unsigned)p; }
DI float bf2f(unsigned short b) { return __uint_as_float(((unsigned)b) << 16); }
DI float bflo(unsigned u) { return __uint_as_float(u << 16); }
DI float bfhi(unsigned u) { return __uint_as_float(u & 0xffff0000u); }
DI float wave_sum(float v) {
#pragma unroll
    for (int o = 1; o < 64; o <<= 1) v += __shfl_xor(v, o);
    return v;
}
DI float fexp2(float x) { return __builtin_amdgcn_exp2f(x); }
DI float frcp(float x) { return __builtin_amdgcn_rcpf(x); }
#define LDS_WAIT() asm volatile("s_waitcnt lgkmcnt(0)" ::: "memory")
#define VM_WAIT() asm volatile("s_waitcnt vmcnt(0)" ::: "memory")

#define XB_TMO      128
#define XB_XCNT(j)  (256  + 64 * (j))
#define XB_XSUB(j)  (1280 + 64 * (j))
#define XB_XGEN(j)  (2304 + 64 * (j))
#define XB_TOP      3328
#define XB_TOPGEN   3392
#define XCD_BAR_WORDS 3456
#define XB_SPIN_CAP (1u << 22)
DI unsigned xb_ld(unsigned* p)              { return __hip_atomic_load(p, __ATOMIC_RELAXED, __HIP_MEMORY_SCOPE_AGENT); }
DI unsigned xb_add(unsigned* p, unsigned v) { return __hip_atomic_fetch_add(p, v, __ATOMIC_RELAXED, __HIP_MEMORY_SCOPE_AGENT); }
DI unsigned xb_xcc_id() { return (unsigned)__builtin_amdgcn_s_getreg((3 << 11) | 20) & 0xFu; }
#define XB_SPIN(cond, bar) do { unsigned _sp = 0; while (cond) { __builtin_amdgcn_s_sleep(1); \
    if ((++_sp & 255u) == 0u) { if (xb_ld(&(bar)[XB_TMO])) break; if (_sp > XB_SPIN_CAP) { atomicAdd(&(bar)[XB_TMO], 1u); break; } } } } while (0)
struct XcdBarrier { unsigned* bar; unsigned x; volatile LAS unsigned* st; };
DI XcdBarrier xcd_barrier_post(unsigned* bar, volatile LAS unsigned* st) {
    XcdBarrier b; b.bar = bar; b.x = xb_xcc_id(); b.st = st;
    if (threadIdx.x == 0) (void)xb_add(&bar[XB_XCNT(b.x)], 1u);
    return b;
}
DI void xcd_barrier_complete(unsigned* bar, unsigned x, unsigned& nloc, unsigned& nx) {
    const unsigned G = gridDim.x * gridDim.y * gridDim.z;
    unsigned sum, cnt, mine, sp = 0u;
    for (;;) {
        sum = 0u; cnt = 0u; mine = 0u;
#pragma unroll
        for (unsigned j = 0; j < 16; ++j) { const unsigned c = xb_ld(&bar[XB_XCNT(j)]); sum += c; cnt += (c > 0u) ? 1u : 0u; mine = (j == x) ? c : mine; }
        if (sum == G) break;
        __builtin_amdgcn_s_sleep(1);
        if ((++sp & 255u) == 0u) { if (xb_ld(&bar[XB_TMO])) break; if (sp > XB_SPIN_CAP) { atomicAdd(&bar[XB_TMO], 1u); break; } }
    }
    nloc = mine > 0u ? mine : 1u; nx = cnt > 0u ? cnt : 1u;
}
DI void xcd_barrier(const XcdBarrier& b) {
    asm volatile("s_waitcnt vmcnt(0)" ::: "memory");
    __syncthreads();
    if (threadIdx.x == 0) {
        unsigned* bar = b.bar;
        __builtin_amdgcn_s_waitcnt(0);
        unsigned nloc = b.st[0], nx = b.st[1];
        if (nloc == 0u) { xcd_barrier_complete(bar, b.x, nloc, nx); b.st[0] = nloc; b.st[1] = nx; }
        const unsigned old = xb_add(&bar[XB_XSUB(b.x)], 1u);
        const unsigned gen = old / nloc;
        if (old + 1u == (gen + 1u) * nloc) {
            __builtin_amdgcn_fence(__ATOMIC_RELEASE, "agent");
            asm volatile("s_waitcnt vmcnt(0)" ::: "memory");
            const unsigned og = xb_add(&bar[XB_TOP], 1u);
            const unsigned tg = og / nx;
            if (og + 1u == (tg + 1u) * nx) xb_add(&bar[XB_TOPGEN], 1u);
            else XB_SPIN(xb_ld(&bar[XB_TOPGEN]) == tg, bar);
            __builtin_amdgcn_fence(__ATOMIC_ACQUIRE, "agent");
            xb_add(&bar[XB_XGEN(b.x)], 1u);
            asm volatile("s_waitcnt vmcnt(0)" ::: "memory");
        } else {
            XB_SPIN(xb_ld(&bar[XB_XGEN(b.x)]) == gen, bar);
            __builtin_amdgcn_fence(__ATOMIC_ACQUIRE, "agent");
            asm volatile("s_waitcnt vmcnt(0)" ::: "memory");
        }
    }
    __syncthreads();
}

namespace pg8 {
constexpr int BM = 256, BK = 64, HALF = 128, HTB = HALF * BK * 2, STAGE_BYTES = 8 * HTB, NXCD = 8, WGM = 8;
__host__ __device__ __forceinline__ int lds_byte(int r, int c) { const int st = (r >> 4) * 2 + (c >> 5), rr = r & 15, cc = c & 31, ob = rr * 64 + cc * 2; return st * 1024 + (ob ^ (((ob >> 9) & 1) << 5)); }
__host__ __device__ __forceinline__ void stage_rc(int b, int& R, int& C) { const int st = b / 1024, sb = b % 1024, swz = sb ^ (((sb >> 9) & 1) << 5); R = (st >> 1) * 16 + swz / 64; C = (st & 1) * 32 + (swz % 64) / 2; }
__host__ __device__ __forceinline__ int perm32(int rho) { const int n = rho >> 4, i = rho & 15; return 8 * (i >> 2) + 4 * n + (i & 3); }

struct Unit { int pm, pn, e, slot; const char* Bp; };

typedef int v4i_t __attribute__((ext_vector_type(4)));
typedef int v8i_t __attribute__((ext_vector_type(8)));
template <class Epi, class Sched, bool FP8 = false>
DI void gemm_phase(LAS unsigned char* lds, const char* Abase, const int RB, const size_t hstepB, const Sched& S, const Epi& E) {
    const int tid = threadIdx.x, wid = __builtin_amdgcn_readfirstlane(tid >> 6), lane = tid & 63, wr = wid >> 2, wc = wid & 3, fr = lane & 15, fq = lane >> 4;
    const int nt = RB / 128;
    int RA[2], CA[2]; unsigned voffB[2];
#pragma unroll
    for (int i = 0; i < 2; ++i) { int R, C; stage_rc(tid * 16 + i * 8192, R, C); const int Rb = Epi::PERM ? ((R & ~31) + perm32(R & 31)) : R;
        RA[i] = R; CA[i] = C; voffB[i] = (unsigned)(Rb * RB + C * 2); }
    const size_t kstep = (size_t)(BK * 2);
    const unsigned ldsw = (unsigned)wid * 1024u;
    const int aoff = lds_byte(wr * 64 + fr, fq * 8), boff = lds_byte(wc * 32 + fr, fq * 8);
#define PG8_SA(b, h) (((b) * 2 + (h)) * HTB)
#define PG8_SB(b, h) ((4 + (b) * 2 + (h)) * HTB)
#define PG8_STAGE(bufoff, gbase, voff) do { _Pragma("unroll") for (int _i = 0; _i < 2; ++_i) \
        __builtin_amdgcn_global_load_lds((const unsigned*)((const char*)(gbase) + (voff)[_i]), (LAS unsigned*)(lds + (bufoff) + ldsw + _i * 8192), 16, 0, 0); } while (0)
#define PG8_LDA(dst, b, h) do { _Pragma("unroll") for (int m = 0; m < 4; ++m) { const v4i_t lo_ = *(const LAS v4i_t*)(lds + PG8_SA(b, h) + aoff + m * 2048), hi_ = *(const LAS v4i_t*)(lds + PG8_SA(b, h) + aoff + m * 2048 + 1024); \
        dst[m] = __builtin_shufflevector(lo_, hi_, 0, 1, 2, 3, 4, 5, 6, 7); } } while (0)
#define PG8_LDB(dst, b, h) do { _Pragma("unroll") for (int n = 0; n < 2; ++n) { const v4i_t lo_ = *(const LAS v4i_t*)(lds + PG8_SB(b, h) + boff + n * 2048), hi_ = *(const LAS v4i_t*)(lds + PG8_SB(b, h) + boff + n * 2048 + 1024); \
        dst[n] = __builtin_shufflevector(lo_, hi_, 0, 1, 2, 3, 4, 5, 6, 7); } } while (0)
#define PG8_LO(x) __builtin_bit_cast(bf16x8, __builtin_shufflevector(x, x, 0, 1, 2, 3))
#define PG8_HI(x) __builtin_bit_cast(bf16x8, __builtin_shufflevector(x, x, 4, 5, 6, 7))
#define PG8_MMA(ai, bj, At, Bt) do { __builtin_amdgcn_s_setprio(1); if constexpr (FP8) asm volatile("s_nop 1"); _Pragma("unroll") for (int m = 0; m < 4; ++m) _Pragma("unroll") for (int n = 0; n < 2; ++n) { \
        if constexpr (!FP8) { acc[ai][bj][m][n] = __builtin_amdgcn_mfma_f32_16x16x32_bf16(PG8_LO(Bt[n]), PG8_LO(At[m]), acc[ai][bj][m][n], 0, 0, 0); \
                              acc[ai][bj][m][n] = __builtin_amdgcn_mfma_f32_16x16x32_bf16(PG8_HI(Bt[n]), PG8_HI(At[m]), acc[ai][bj][m][n], 0, 0, 0); } \
        else asm volatile("v_mfma_f32_16x16x128_f8f6f4 %0, %1, %2, %0" : "+v"(acc[ai][bj][m][n]) : "v"(Bt[n]), "v"(At[m])); } __builtin_amdgcn_s_setprio(0); } while (0)
#define PG8_WAIT_V(n) asm volatile("s_waitcnt vmcnt(" #n ")" ::: "memory")
#define PG8_WAIT_L(n) asm volatile("s_waitcnt lgkmcnt(" #n ")" ::: "memory")
#define PG8_BAR __builtin_amdgcn_s_barrier()
#define PG8_SCHED __builtin_amdgcn_sched_barrier(0)
    Unit cur, nxt; int ui = 0;
    if (!S.next(0, cur)) return;
    f32x4 acc[2][2][4][2];
#pragma unroll
    for (int a = 0; a < 2; ++a)
#pragma unroll
        for (int b = 0; b < 2; ++b)
#pragma unroll
            for (int m = 0; m < 4; ++m)
#pragma unroll
                for (int n = 0; n < 2; ++n) acc[a][b][m][n] = (f32x4){0.f, 0.f, 0.f, 0.f};
    v8i_t At[4], B0[2], B1[2];
    unsigned vC0[2], vC1[2], vN0[2], vN1[2];
    S.arows(cur, RA, CA, vC0, vC1);
    const char* cB = cur.Bp;
    LAS unsigned char* bring = lds + (LDS_BIAS - LDS_STAGE);
    if constexpr (Epi::HAS_BIAS) { if (wid == 0) __builtin_amdgcn_global_load_lds((const unsigned*)E.bias_src(cur, lane), (LAS unsigned*)bring, 16, 0, 0); }
    PG8_STAGE(PG8_SB(0, 0), cB, voffB); PG8_STAGE(PG8_SB(0, 1), cB + hstepB, voffB); PG8_STAGE(PG8_SA(0, 0), Abase, vC0); PG8_STAGE(PG8_SA(0, 1), Abase, vC1);
    if (wr == 1) PG8_BAR;
    PG8_WAIT_V(2); PG8_BAR;
    PG8_STAGE(PG8_SB(1, 0), cB + kstep, voffB); PG8_STAGE(PG8_SA(1, 0), Abase + kstep, vC0); PG8_STAGE(PG8_SB(1, 1), cB + hstepB + kstep, voffB);
    PG8_WAIT_V(6); PG8_BAR;
    for (;;) {
        const bool has_next = S.next(ui + 1, nxt);
        if (has_next) S.arows(nxt, RA, CA, vN0, vN1); else { vN0[0] = vC0[0]; vN0[1] = vC0[1]; vN1[0] = vC1[0]; vN1[1] = vC1[1]; }
        const char* nB = has_next ? nxt.Bp : cB;
#pragma unroll 1
        for (int t = 0; t < nt; t += 2) {
            const bool last = (t == nt - 2);
            if constexpr (Epi::HAS_BIAS) { if (last && has_next && wid == 0) __builtin_amdgcn_global_load_lds((const unsigned*)E.bias_src(nxt, lane), (LAS unsigned*)(bring + ((ui + 1) & 1) * 1024), 16, 0, 0); }
            const char* a1 = Abase + (size_t)(t + 1) * kstep;
            const char* a2 = last ? Abase : Abase + (size_t)(t + 2) * kstep; const char* b2 = last ? nB : cB + (size_t)(t + 2) * kstep;
            const char* a3 = a2 + kstep; const char* b3 = b2 + kstep;
            unsigned v20[2], v21[2];
            v20[0] = last ? vN0[0] : vC0[0]; v20[1] = last ? vN0[1] : vC0[1]; v21[0] = last ? vN1[0] : vC1[0]; v21[1] = last ? vN1[1] : vC1[1];
            PG8_LDB(B0, 0, 0); PG8_LDB(B1, 0, 1); PG8_SCHED; PG8_LDA(At, 0, 0); PG8_STAGE(PG8_SA(1, 1), a1, vC1);
            PG8_WAIT_V(8); PG8_WAIT_L(0); PG8_BAR; PG8_MMA(0, 0, At, B0); PG8_MMA(0, 1, At, B1); PG8_BAR; PG8_SCHED;
            PG8_LDA(At, 0, 1); PG8_STAGE(PG8_SB(0, 0), b2, voffB); PG8_STAGE(PG8_SB(0, 1), b2 + hstepB, voffB); PG8_STAGE(PG8_SA(0, 0), a2, v20);
            PG8_WAIT_V(8); PG8_WAIT_L(0); PG8_BAR; PG8_MMA(1, 0, At, B0); PG8_MMA(1, 1, At, B1); PG8_BAR; PG8_SCHED;
            PG8_LDB(B0, 1, 0); PG8_LDB(B1, 1, 1); PG8_SCHED; PG8_LDA(At, 1, 0); PG8_STAGE(PG8_SA(0, 1), a2, v21);
            PG8_WAIT_V(8); PG8_WAIT_L(0); PG8_BAR; PG8_MMA(0, 0, At, B0); PG8_MMA(0, 1, At, B1); PG8_BAR; PG8_SCHED;
            PG8_LDA(At, 1, 1); PG8_STAGE(PG8_SB(1, 0), b3, voffB); PG8_STAGE(PG8_SB(1, 1), b3 + hstepB, voffB); PG8_STAGE(PG8_SA(1, 0), a3, v20);
            PG8_WAIT_V(8); PG8_WAIT_L(0); PG8_BAR; PG8_MMA(1, 0, At, B0); PG8_MMA(1, 1, At, B1); PG8_BAR; PG8_SCHED;
        }
        if (wr == 0) PG8_BAR;
        if constexpr (FP8) asm volatile("s_nop 15\n\ts_nop 15" ::: "memory");
        E(acc, cur, wr, wc, fr, fq, (const LAS float*)(bring + (ui & 1) * 1024));
#ifdef EPI_TWICE
        asm volatile("" ::: "memory"); E(acc, cur, wr, wc, fr, fq, (const LAS float*)(bring + (ui & 1) * 1024));
#endif
        if (!has_next) break;
#pragma unroll
        for (int a = 0; a < 2; ++a)
#pragma unroll
            for (int b = 0; b < 2; ++b)
#pragma unroll
                for (int m = 0; m < 4; ++m)
#pragma unroll
                    for (int n = 0; n < 2; ++n) acc[a][b][m][n] = (f32x4){0.f, 0.f, 0.f, 0.f};
        cur = nxt; cB = nB; vC0[0] = vN0[0]; vC0[1] = vN0[1]; vC1[0] = vN1[0]; vC1[1] = vN1[1]; ++ui;
        if (wr == 1) PG8_BAR;
    }
    PG8_WAIT_V(0);
    PG8_BAR;
#undef PG8_SA
#undef PG8_SB
#undef PG8_STAGE
#undef PG8_LDA
#undef PG8_LDB
#undef PG8_MMA
#undef PG8_LO
#undef PG8_HI
#undef PG8_WAIT_V
#undef PG8_WAIT_L
#undef PG8_BAR
#undef PG8_SCHED
}

struct PlainSched {
    int nM, nN, nwg, G, c; unsigned lda2; const char* Bt; size_t tstepB;
    DI void init(int M, int N, int K, int lda, const void* Bt_, int G_, int c_, int eb = 2) { nM = M / BM; nN = N / BM; nwg = nM * nN; G = G_; c = c_; lda2 = (unsigned)(lda * eb); Bt = (const char*)Bt_; tstepB = (size_t)BM * K * eb; }
    DI bool next(int i, Unit& u) const {
        const long L = (long)i * G + c; if (L >= nwg) return false;
        int wgid = (int)L; { const int q = nwg / NXCD, r = nwg % NXCD, xcd = wgid % NXCD, off = wgid / NXCD; wgid = (xcd < r ? xcd * (q + 1) : r * (q + 1) + (xcd - r) * q) + off; }
        const int nig = WGM * nN, gid = wgid / nig, fm = gid * WGM, gsz = (nM - fm) < WGM ? (nM - fm) : WGM;
        u.pm = fm + ((wgid % nig) % gsz); u.pn = (wgid % nig) / gsz; u.e = 0; u.slot = i; u.Bp = Bt + (size_t)u.pn * tstepB; return true;
    }
    DI void arows(const Unit& u, const int (&R)[2], const int (&C)[2], unsigned (&v0)[2], unsigned (&v1)[2]) const {
#pragma unroll
        for (int i = 0; i < 2; ++i) { v0[i] = (unsigned)(u.pm * BM + R[i]) * lda2 + (unsigned)C[i] * 2u; v1[i] = (unsigned)(u.pm * BM + HALF + R[i]) * lda2 + (unsigned)C[i] * 2u; }
    }
};
struct MoeSched {
    int to_lane;
    int total, G, c, ntshift; bool gather;
    const LAS unsigned* tab;
    const char* W; size_t wexp, wpn; unsigned rowb;
    DI bool next(int i, Unit& u) const {
        const int per = G >> 3, x = c / per, j = c - x * per, ntile = total >> ntshift, tpx = (ntile + 7) >> 3, tpr = per >> ntshift;
        const int loc = i * tpr + (j >> ntshift), mtg = x * tpx + loc, pn = j & ((1 << ntshift) - 1);
        if (loc >= tpx || mtg >= ntile) return false;
        const int e = __builtin_popcountll(__ballot(to_lane <= mtg));
        u.pm = mtg; u.pn = pn; u.e = e; u.slot = i; u.Bp = W + (size_t)e * wexp + (size_t)pn * wpn; return true;
    }
    DI void arows(const Unit& u, const int (&R)[2], const int (&C)[2], unsigned (&v0)[2], unsigned (&v1)[2]) const {
        if (gather) {
#pragma unroll
            for (int i = 0; i < 2; ++i) { v0[i] = tab[u.slot * 256 + R[i]] + (unsigned)C[i] * 2u; v1[i] = tab[u.slot * 256 + HALF + R[i]] + (unsigned)C[i] * 2u; }
        } else {
#pragma unroll
            for (int i = 0; i < 2; ++i) { v0[i] = (unsigned)(u.pm * BM + R[i]) * rowb + (unsigned)C[i] * 2u; v1[i] = (unsigned)(u.pm * BM + HALF + R[i]) * rowb + (unsigned)C[i] * 2u; }
        }
    }
};

struct EpiProj {
    static constexpr bool PERM = true, HAS_BIAS = false; bf16_t* O; int ldc; float ascale;
    DI void operator()(const f32x4 (&acc)[2][2][4][2], const Unit& u, int wr, int wc, int fr, int fq, const LAS float*) const {
        const int row0 = u.pm * BM + wr * 64 + fr, col0 = u.pn * BM + wc * 32 + 8 * fq;
#pragma unroll
        for (int ai = 0; ai < 2; ++ai)
#pragma unroll
            for (int m = 0; m < 4; ++m) { bf16_t* rowp = O + (size_t)(row0 + ai * HALF + m * 16) * ldc + col0;
#pragma unroll
                for (int bj = 0; bj < 2; ++bj) { const f32x4 v0 = acc[ai][bj][m][0] * ascale, v1 = acc[ai][bj][m][1] * ascale;
                    u32x4 w; w.x = pk_bf16(v0[0], v0[1]); w.y = pk_bf16(v0[2], v0[3]); w.z = pk_bf16(v1[0], v1[1]); w.w = pk_bf16(v1[2], v1[3]);
                    *(u32x4*)(rowp + bj * HALF) = w; } }
    }
};
struct EpiRes {
    static constexpr bool PERM = false, HAS_BIAS = false; const float* res; const bf16_t* resb; bf16_t* out; float ascale;
    DI void operator()(const f32x4 (&acc)[2][2][4][2], const Unit& u, int wr, int wc, int fr, int fq, const LAS float*) const {
        const int row0 = u.pm * BM + wr * 64 + fr, col0 = u.pn * BM + wc * 32 + 4 * fq;
#pragma unroll
        for (int ai = 0; ai < 2; ++ai)
#pragma unroll
            for (int m = 0; m < 4; ++m) { const size_t off = (size_t)(row0 + ai * HALF + m * 16) * D + col0;
#pragma unroll
                for (int bj = 0; bj < 2; ++bj)
#pragma unroll
                    for (int n = 0; n < 2; ++n) { f32x4 r;
                        if (resb) { const u32x2 rb = *(const u32x2*)(resb + off + bj * HALF + n * 16); r = (f32x4){bflo(rb.x), bfhi(rb.x), bflo(rb.y), bfhi(rb.y)}; }
                        else r = *(const f32x4*)(res + off + bj * HALF + n * 16);
                        const f32x4 o = acc[ai][bj][m][n] * ascale + r * ALPHA; u32x2 w; w.x = pk_bf16(o[0], o[1]); w.y = pk_bf16(o[2], o[3]);
                        *(u32x2*)(out + off + bj * HALF + n * 16) = w; } }
    }
};
struct EpiSwiglu {
    static constexpr bool PERM = true, HAS_BIAS = true; unsigned char* O; const float* bgu; float ascale;
    DI const float* bias_src(const Unit& u, int lane) const { return bgu + (size_t)u.e * 2048 + u.pn * HALF + (lane >> 5) * 1024 + 4 * (lane & 31); }
    DI void operator()(const f32x4 (&acc)[2][2][4][2], const Unit& u, int wr, int wc, int fr, int fq, const LAS float* bias) const {
        const int row0 = u.pm * BM + wr * 64 + fr, col0 = u.pn * HALF + wc * 32 + 8 * fq;
        f32x4 bgv[2], buv[2];
#pragma unroll
        for (int n = 0; n < 2; ++n) { bgv[n] = *(const LAS f32x4*)(bias + wc * 32 + 8 * fq + 4 * n); buv[n] = *(const LAS f32x4*)(bias + 128 + wc * 32 + 8 * fq + 4 * n); }
#pragma unroll
        for (int ai = 0; ai < 2; ++ai)
#pragma unroll
            for (int m = 0; m < 4; ++m) { float o[8];
#pragma unroll
                for (int n = 0; n < 2; ++n)
#pragma unroll
                    for (int jj = 0; jj < 2; ++jj) {
                        const f32x2 ag = {acc[ai][0][m][n][2 * jj], acc[ai][0][m][n][2 * jj + 1]}, au = {acc[ai][1][m][n][2 * jj], acc[ai][1][m][n][2 * jj + 1]};
                        const f32x2 bg2 = {bgv[n][2 * jj], bgv[n][2 * jj + 1]}, bu2 = {buv[n][2 * jj], buv[n][2 * jj + 1]};
                        f32x2 g = ag * ascale + bg2, up = au * ascale + bu2;
                        g = __builtin_elementwise_min(g, (f32x2){7.0f, 7.0f});
                        up = __builtin_elementwise_min(__builtin_elementwise_max(up, (f32x2){-7.0f, -7.0f}), (f32x2){7.0f, 7.0f});
                        const f32x2 ex = g * (-1.702f * LOG2E);
                        f32x2 e2; e2.x = fexp2(ex.x); e2.y = fexp2(ex.y);
                        const f32x2 den = e2 + 1.0f;
                        f32x2 sg; sg.x = frcp(den.x); sg.y = frcp(den.y);
                        const f32x2 r = (g * sg) * (up + 1.0f);
                        o[4 * n + 2 * jj] = r.x; o[4 * n + 2 * jj + 1] = r.y; }
                if (!MOE_FP8) { u32x4 w; w.x = pk_bf16(o[0], o[1]); w.y = pk_bf16(o[2], o[3]); w.z = pk_bf16(o[4], o[5]); w.w = pk_bf16(o[6], o[7]);
                    *(u32x4*)(O + ((size_t)(row0 + ai * HALF + m * 16) * DFF + col0) * 2) = w; }
                else { u32x2 w;
                    int p = __builtin_amdgcn_cvt_pk_fp8_f32(o[0] * ASCALE, o[1] * ASCALE, 0, false); p = __builtin_amdgcn_cvt_pk_fp8_f32(o[2] * ASCALE, o[3] * ASCALE, p, true); w.x = (unsigned)p;
                    p = __builtin_amdgcn_cvt_pk_fp8_f32(o[4] * ASCALE, o[5] * ASCALE, 0, false); p = __builtin_amdgcn_cvt_pk_fp8_f32(o[6] * ASCALE, o[7] * ASCALE, p, true); w.y = (unsigned)p;
                    *(u32x2*)(O + (size_t)(row0 + ai * HALF + m * 16) * DFF + col0) = w; } }
    }
};
struct EpiDown {
    static constexpr bool PERM = true, HAS_BIAS = true; unsigned char* O; const float* bd; float ascale;
    DI const float* bias_src(const Unit& u, int lane) const { return bd + (size_t)u.e * 1024 + u.pn * BM + 4 * lane; }
    DI void operator()(const f32x4 (&acc)[2][2][4][2], const Unit& u, int wr, int wc, int fr, int fq, const LAS float* bias) const {
        const int row0 = u.pm * BM + wr * 64 + fr, col0 = u.pn * BM + wc * 32 + 8 * fq;
        f32x4 bv[2][2];
#pragma unroll
        for (int bj = 0; bj < 2; ++bj)
#pragma unroll
            for (int n = 0; n < 2; ++n) bv[bj][n] = *(const LAS f32x4*)(bias + bj * HALF + wc * 32 + 8 * fq + 4 * n) * YSCALE;
        const float as = ascale * YSCALE;
#pragma unroll
        for (int ai = 0; ai < 2; ++ai)
#pragma unroll
            for (int m = 0; m < 4; ++m) { unsigned char* rowp = O + (size_t)(row0 + ai * HALF + m * 16) * D + col0;
#pragma unroll
                for (int bj = 0; bj < 2; ++bj) { const f32x4 v0 = acc[ai][bj][m][0] * as + bv[bj][0], v1 = acc[ai][bj][m][1] * as + bv[bj][1];
                    u32x2 w; w.x = pk_fp8x4(v0[0], v0[1], v0[2], v0[3]); w.y = pk_fp8x4(v1[0], v1[1], v1[2], v1[3]);
                    *(u32x2*)(rowp + bj * HALF) = w; } }
    }
};
}

struct Frame {
    LAS unsigned char* lds;
    gu32* ctl;
    int tid, lane, wave, vcu, G;
    unsigned char* ws;
    const float* in[22];
    float* out;
};
#define WSP(T_, off) ((T_*)(F.ws + (off)))

DI void p0_transpose_item(const float* W, int K, int N, int Nvalid, bf16_t* WT, LAS float* scr, int item, int lane) {
    const int nblk = N / 32, kb = item / nblk, nb = item % nblk, k0 = 64 * kb, n0 = 32 * nb;
    const int n = n0 + (lane & 31); const bool ok = n < Nvalid;
#pragma unroll 8
    for (int i = 0; i < 32; ++i) { const int kk = 2 * i + (lane >> 5); scr[kk * 33 + (lane & 31)] = ok ? W[(size_t)(k0 + kk) * Nvalid + n] : 0.f; }
    LDS_WAIT(); asm volatile("" ::: "memory");
    const int c = lane & 7;
#pragma unroll
    for (int j = 0; j < 4; ++j) { const int nn = (lane >> 3) + 8 * j; const LAS float* s = scr + (8 * c) * 33 + nn;
        u32x4 o; o.x = pk_bf16(s[0 * 33], s[1 * 33]); o.y = pk_bf16(s[2 * 33], s[3 * 33]); o.z = pk_bf16(s[4 * 33], s[5 * 33]); o.w = pk_bf16(s[6 * 33], s[7 * 33]);
        *(GAS u32x4*)(WT + (size_t)(n0 + nn) * K + k0 + 8 * c) = o; }
    LDS_WAIT(); asm volatile("" ::: "memory");
}
struct P0Desc { const float* W; unsigned char* WT; int N, Nvalid, sub, fp8; float scale; };
DI void p0_load(const P0Desc& d, f32x4 (&v)[16], int lane) {
    const int nblk = d.N / 64, kb = d.sub / nblk, nb = d.sub % nblk, k0 = 64 * kb, n0 = 64 * nb;
    const int nn = n0 + 4 * (lane & 15); const bool ok = nn < d.Nvalid;
#pragma unroll
    for (int i = 0; i < 16; ++i) { const int kk = 4 * i + (lane >> 4); v[i] = ok ? __builtin_nontemporal_load((const f32x4*)(d.W + (size_t)(k0 + kk) * d.Nvalid + nn)) : (f32x4){0.f, 0.f, 0.f, 0.f}; }
}
DI void p0_finish(const P0Desc& d, const f32x4 (&v)[16], LAS float* scr, int lane) {
    constexpr int K = 1024;
    const int nblk = d.N / 64, kb = d.sub / nblk, nb = d.sub % nblk, k0 = 64 * kb, n0 = 64 * nb;
#pragma unroll
    for (int i = 0; i < 16; ++i) { const int kk = 4 * i + (lane >> 4); LAS float* p = scr + kk * 65 + 4 * (lane & 15); p[0] = v[i][0]; p[1] = v[i][1]; p[2] = v[i][2]; p[3] = v[i][3]; }
    LDS_WAIT(); asm volatile("" ::: "memory");
    if (!d.fp8) {
        const int c = lane & 7;
#pragma unroll
        for (int j = 0; j < 8; ++j) { const int n = (lane >> 3) + 8 * j; const LAS float* sp = scr + (8 * c) * 65 + n;
            u32x4 o; o.x = pk_bf16(sp[0], sp[65]); o.y = pk_bf16(sp[2 * 65], sp[3 * 65]); o.z = pk_bf16(sp[4 * 65], sp[5 * 65]); o.w = pk_bf16(sp[6 * 65], sp[7 * 65]);
            *(GAS u32x4*)(d.WT + ((size_t)(n0 + n) * K + k0 + 8 * c) * 2) = o; }
    } else {
        const int c = lane & 3; const float ws = d.scale;
#pragma unroll
        for (int j = 0; j < 4; ++j) { const int n = (lane >> 2) + 16 * j; const LAS float* sp = scr + (16 * c) * 65 + n;
            u32x4 o;
#pragma unroll
            for (int q = 0; q < 4; ++q) { int p = __builtin_amdgcn_cvt_pk_fp8_f32(sp[(4 * q) * 65] * ws, sp[(4 * q + 1) * 65] * ws, 0, false);
                p = __builtin_amdgcn_cvt_pk_fp8_f32(sp[(4 * q + 2) * 65] * ws, sp[(4 * q + 3) * 65] * ws, p, true); o[q] = (unsigned)p; }
            *(GAS u32x4*)(d.WT + (size_t)(n0 + n) * K + k0 + 16 * c) = o; }
    }
    LDS_WAIT(); asm volatile("" ::: "memory");
}
DI void p0_prologue(Frame& F) {
    LAS float* scr = (LAS float*)(F.lds + F.wave * 16896);
    const int gw = F.vcu * NWAVES + F.wave, NGW = F.G * NWAVES;
    constexpr int I_GU = 16 * 32, I_DN = 16 * 16, I_EVIN = 16 * 48, I_EVOUT = 16 * 16, I_ODIN = 16 * 44;
    constexpr int N_GU = 64 * I_GU, N_DN = 64 * I_DN;
    constexpr int NITEMS = N_GU + N_DN + I_EVIN + I_EVOUT + I_ODIN;
    auto desc = [&](int it) -> P0Desc { P0Desc d; int r = it;
        if (r < N_GU) { const int mtx = r / I_GU; d.W = F.in[16] + (size_t)mtx * 1024 * 2048; d.WT = WSP(unsigned char, WS_WGU) + (size_t)mtx * 2048 * 1024 * MOE_EB; d.N = 2048; d.Nvalid = 2048; d.sub = r % I_GU; d.fp8 = MOE_FP8; d.scale = WSCALE; return d; } r -= N_GU;
        if (r < N_DN) { const int mtx = r / I_DN; d.W = F.in[18] + (size_t)mtx * 1024 * 1024; d.WT = WSP(unsigned char, WS_WD) + (size_t)mtx * 1024 * 1024 * MOE_EB; d.N = 1024; d.Nvalid = 1024; d.sub = r % I_DN; d.fp8 = MOE_FP8; d.scale = WSCALE; return d; } r -= N_DN;
        if (r < I_EVIN) { d.W = F.in[1]; d.WT = WSP(unsigned char, WS_WEVIN); d.N = EV_COLS; d.Nvalid = EV_COLS; d.sub = r; d.fp8 = IN_FP8; d.scale = WSCALE; return d; } r -= I_EVIN;
        if (r < I_EVOUT) { d.W = F.in[2]; d.WT = WSP(unsigned char, WS_WEVOUT); d.N = 1024; d.Nvalid = 1024; d.sub = r; d.fp8 = PLAIN_FP8; d.scale = WSCALE; return d; } r -= I_EVOUT;
        d.W = F.in[8]; d.WT = WSP(unsigned char, WS_WODIN); d.N = OD_COLS_P; d.Nvalid = OD_COLS; d.sub = r; d.fp8 = IN1_FP8; d.scale = WSCALE; return d; };
    {
        int it = gw; P0Desc d0, d1; f32x4 v0[16], v1[16];
        if (it < NITEMS) { d0 = desc(it); p0_load(d0, v0, F.lane); }
        while (it < NITEMS) {
            const int itn = it + NGW; const bool more = itn < NITEMS;
            if (more) { d1 = desc(itn); p0_load(d1, v1, F.lane); }
            p0_finish(d0, v0, scr, F.lane);
            if (more) { d0 = d1;
#pragma unroll
                for (int i = 0; i < 16; ++i) v0[i] = v1[i]; }
            it = itn;
        }
    }
    for (int it = gw; it < 32; it += NGW) { const int l = it >> 4; p0_transpose_item(F.in[14] + (size_t)l * 1024 * 32, 1024, 32, 32, WSP(bf16_t, WS_WR) + (size_t)l * 32 * 1024, scr, it & 15, F.lane); }
    {
        const float* wuv = F.in[10]; const float* wout = F.in[11]; bf16_t* wc = WSP(bf16_t, WS_WCOMB); unsigned char* wc8 = WSP(unsigned char, WS_WCOMB);
        for (int it = gw; it < 16 * 512; it += NGW) {
            const int nb = it & 15, kq = __builtin_amdgcn_readfirstlane(it >> 4), k0 = 4 * kq, h = k0 >> 7, n = 64 * nb + F.lane;
            const float* b = wout + (size_t)(h * 64) * 1024 + n; const float* a = wuv + (size_t)k0 * 64;
            float sv[4] = {0.f, 0.f, 0.f, 0.f};
#pragma unroll 32
            for (int d = 0; d < 64; ++d) { const float bv = b[(size_t)d * 1024];
#pragma unroll
                for (int q = 0; q < 4; ++q) sv[q] += a[q * 64 + d] * bv; }
            if (PLAIN_FP8) *(unsigned*)(wc8 + (size_t)n * 2048 + k0) = pk_fp8x4(sv[0] * WCSCALE, sv[1] * WCSCALE, sv[2] * WCSCALE, sv[3] * WCSCALE);
            else { u32x2 w2; w2.x = pk_bf16(sv[0], sv[1]); w2.y = pk_bf16(sv[2], sv[3]); *(u32x2*)(wc + (size_t)n * 2048 + k0) = w2; }
        }
    }
    {
        const float* x = F.in[0]; bf16_t* xb = WSP(bf16_t, WS_XB); unsigned char* x8 = WSP(unsigned char, WS_X8);
        const size_t gt = (size_t)F.vcu * NTHR + F.tid, NGT = (size_t)F.G * NTHR;
        for (size_t o = gt; o < (size_t)T * D / 8; o += 4 * NGT) {
            f32x4 a[4], b[4];
#pragma unroll
            for (int u = 0; u < 4; ++u) { const size_t oo = o + u * NGT; if (oo < (size_t)T * D / 8) { a[u] = __builtin_nontemporal_load((const f32x4*)(x + oo * 8)); b[u] = __builtin_nontemporal_load((const f32x4*)(x + oo * 8 + 4)); } }
#pragma unroll
            for (int u = 0; u < 4; ++u) { const size_t oo = o + u * NGT; if (oo >= (size_t)T * D / 8) break;
                if (IN_FP8) { u32x2 w; w.x = pk_fp8x4(a[u][0] * XSCALE, a[u][1] * XSCALE, a[u][2] * XSCALE, a[u][3] * XSCALE); w.y = pk_fp8x4(b[u][0] * XSCALE, b[u][1] * XSCALE, b[u][2] * XSCALE, b[u][3] * XSCALE); *(u32x2*)(x8 + oo * 8) = w; }
                else { u32x4 w; w.x = pk_bf16(a[u][0], a[u][1]); w.y = pk_bf16(a[u][2], a[u][3]); w.z = pk_bf16(b[u][0], b[u][1]); w.w = pk_bf16(b[u][2], b[u][3]); *(u32x4*)(xb + oo * 8) = w; } }
        }
    }
}

namespace att0 {
constexpr int KP = 144, VP_SB = 144, VP_DF = 288;
constexpr int BUF = 64 * KP + 64 * VP_DF;
constexpr int PITCH = EV_COLS;
DI int crow(int i, int hh) { return (i & 3) + 8 * (i >> 2) + 4 * hh; }
DI bf16x8 pack8(const f32x16& p, int s) {
    u32x4 w; w.x = pk_bf16(p[8 * s], p[8 * s + 1]); w.y = pk_bf16(p[8 * s + 2], p[8 * s + 3]); w.z = pk_bf16(p[8 * s + 4], p[8 * s + 5]); w.w = pk_bf16(p[8 * s + 6], p[8 * s + 7]);
    return __builtin_bit_cast(bf16x8, w);
}
DI s16x4 trrd(const LAS unsigned char* p) { typedef short v4i16_t __attribute__((ext_vector_type(4))); return __builtin_bit_cast(s16x4, __builtin_amdgcn_ds_read_tr16_b64_v4i16((LAS v4i16_t*)p)); }
DI f32x16 qk32(const LAS unsigned char* kb, const bf16x8 (&qf)[4], int lane, f32x16 p = f32x16{}) {
    const LAS unsigned char* kp = kb + (lane & 31) * KP + (lane >> 5) * 16;
#pragma unroll
    for (int s = 0; s < 4; ++s) { const bf16x8 a = *(const LAS bf16x8*)(kp + s * 32); p = __builtin_amdgcn_mfma_f32_32x32x16_bf16(a, qf[s], p, 0, 0, 0); }
    return p;
}
DI const LAS unsigned char* vtlane(const LAS unsigned char* vb, int pitch, int lane) {
    const int hh = lane >> 5, blk = (lane >> 4) & 1, q = (lane & 15) >> 2, p = lane & 3;
    return vb + (4 * hh + q) * pitch + (16 * blk + 4 * p) * 2;
}
DI bf16x8 vtfrag(const LAS unsigned char* vl, int pitch, int c, int rbase) {
    const s16x4 lo = trrd(vl + rbase * pitch + 64 * c), hi = trrd(vl + (rbase + 8) * pitch + 64 * c);
    return __builtin_shufflevector(lo, hi, 0, 1, 2, 3, 4, 5, 6, 7);
}
template <int VD> struct StageRegs { u32x4 k; u32x4 v[VD / 64]; };
template <int VD> DI void stage_load(StageRegs<VD>& r, const bf16_t* proj, int b, int kt, int colK, int colV, int tid) {
    const size_t rowb = (size_t)(b * SEQ + kt * 64);
    r.k = *(const u32x4*)(proj + (rowb + (tid >> 3)) * PITCH + colK + (tid & 7) * 8);
    if (VD == 64) r.v[0] = *(const u32x4*)(proj + (rowb + (tid >> 3)) * PITCH + colV + (tid & 7) * 8);
    else {
#pragma unroll
        for (int j = 0; j < VD / 64; ++j) { const int idx = tid + 512 * j; r.v[j] = *(const u32x4*)(proj + (rowb + (idx >> 4)) * PITCH + colV + (idx & 15) * 8); }
    }
}
template <int VD> DI void stage_write(const StageRegs<VD>& r, LAS unsigned char* buf, int tid) {
    constexpr int VP = VD == 64 ? VP_SB : VP_DF;
    *(LAS u32x4*)(buf + (tid >> 3) * KP + (tid & 7) * 16) = r.k;
    if (VD == 64) *(LAS u32x4*)(buf + 64 * KP + (tid >> 3) * VP + (tid & 7) * 16) = r.v[0];
    else {
#pragma unroll
        for (int j = 0; j < VD / 64; ++j) { const int idx = tid + 512 * j; *(LAS u32x4*)(buf + 64 * KP + (idx >> 4) * VP + (idx & 15) * 16) = r.v[j]; }
    }
}

DI void sb_unit(Frame& F, int b, int h, int qt, const bf16_t* proj, bf16_t* mix) {
    const int tid = F.tid, lane = F.lane, w = F.wave, hh = lane >> 5;
    LAS unsigned char* lds = F.lds;
    volatile LAS int* votes = (volatile LAS int*)(F.lds + LDS_INTS) + 160;
    const int q0 = qt * 256, tw = q0 + 32 * w, t = tw + (lane & 31);
    const int colQ = h * 64, colK = 512 + h * 64, colV = 1024 + h * 64;
    bf16x8 qf[4];
    { const bf16_t* qp = proj + (size_t)(b * SEQ + t) * PITCH + colQ + hh * 8;
#pragma unroll
      for (int s = 0; s < 4; ++s) qf[s] = *(const bf16x8*)(qp + 16 * s); }
    f32x16 O[2]; O[0] = f32x16{}; O[1] = f32x16{};
    float carry = 1.0f;
    int kt = qt * 4 + 3, it = 0;
    StageRegs<64> sr, sn;
    stage_load<64>(sr, proj, b, kt, colK, colV, tid);
    stage_write<64>(sr, lds, tid);
    if (kt > 0) stage_load<64>(sr, proj, b, kt - 1, colK, colV, tid);
    __syncthreads();
    for (;;) {
        const bool more = kt > 0;
        if (kt > 1) stage_load<64>(sn, proj, b, kt - 2, colK, colV, tid);
        const LAS unsigned char* kb = lds + (it & 1) * BUF; const LAS unsigned char* vb = vtlane(kb + 64 * KP, VP_SB, lane);
#pragma unroll
        for (int kbi = 1; kbi >= 0; --kbi) {
            const int key0 = kt * 64 + kbi * 32;
            if (key0 < tw + 31 && __ballot(carry > 0.0f) != 0ull) {
                f32x16 S = qk32(kb + kbi * 32 * KP, qf, lane);
                f32x16 beta, kp;
#pragma unroll
                for (int i = 0; i < 16; ++i) {
                    const int key = key0 + crow(i, hh);
                    float z = fmaxf(S[i] * 0.125f, -30.0f);
                    const float e = fexp2(-z * LOG2E), r = frcp(1.0f + e);
                    const bool valid = key < t;
                    beta[i] = valid ? r : 0.0f; kp[i] = valid ? e * r : 1.0f;
                }
                float a[4], bb[4], wgt[16];
#pragma unroll
                for (int m = 0; m < 4; ++m) { const float k0 = kp[4 * m], k1 = kp[4 * m + 1], k2 = kp[4 * m + 2], k3 = kp[4 * m + 3];
                    wgt[4 * m + 3] = 1.0f; wgt[4 * m + 2] = k3; wgt[4 * m + 1] = k3 * k2; wgt[4 * m] = wgt[4 * m + 1] * k1; a[m] = wgt[4 * m] * k0; }
#pragma unroll
                for (int m = 0; m < 4; ++m) bb[m] = __shfl_xor(a[m], 32);
                float run = carry; f32x16 P;
#pragma unroll
                for (int m = 3; m >= 0; --m) { const float SG = hh ? run : run * bb[m];
#pragma unroll
                    for (int j = 0; j < 4; ++j) P[4 * m + j] = beta[4 * m + j] * (SG * wgt[4 * m + j]);
                    run = run * (a[m] * bb[m]); }
                carry = run;
                const bf16x8 p0 = pack8(P, 0), p1 = pack8(P, 1);
                { const bf16x8 v00 = vtfrag(vb, VP_SB, 0, kbi * 32), v10 = vtfrag(vb, VP_SB, 1, kbi * 32), v01 = vtfrag(vb, VP_SB, 0, kbi * 32 + 16), v11 = vtfrag(vb, VP_SB, 1, kbi * 32 + 16);
                  O[0] = __builtin_amdgcn_mfma_f32_32x32x16_bf16(v00, p0, O[0], 0, 0, 0); O[1] = __builtin_amdgcn_mfma_f32_32x32x16_bf16(v10, p0, O[1], 0, 0, 0);
                  O[0] = __builtin_amdgcn_mfma_f32_32x32x16_bf16(v01, p1, O[0], 0, 0, 0); O[1] = __builtin_amdgcn_mfma_f32_32x32x16_bf16(v11, p1, O[1], 0, 0, 0); }
            }
        }
        if (more) stage_write<64>(sr, lds + ((it + 1) & 1) * BUF, tid);
        const bool act = __ballot(carry > 0.0f) != 0ull;
        if (lane == 0) votes[(it & 1) * 8 + w] = act ? 1 : 0;
        __syncthreads();
        if (!more) break;
        int any = 0;
#pragma unroll
        for (int j = 0; j < 8; ++j) any |= votes[(it & 1) * 8 + j];
        if (!any) break;
        --kt; ++it; sr = sn;
    }
    if (PLAIN_FP8) { unsigned char* op = (unsigned char*)mix + (size_t)(b * SEQ + t) * D + h * 64;
#pragma unroll
        for (int c = 0; c < 2; ++c)
#pragma unroll
            for (int m = 0; m < 4; ++m) *(unsigned*)(op + 32 * c + 8 * m + 4 * hh) = pk_fp8x4(O[c][4 * m] * MSCALE, O[c][4 * m + 1] * MSCALE, O[c][4 * m + 2] * MSCALE, O[c][4 * m + 3] * MSCALE);
    } else { bf16_t* op = mix + (size_t)(b * SEQ + t) * D + h * 64;
#pragma unroll
        for (int c = 0; c < 2; ++c)
#pragma unroll
            for (int m = 0; m < 4; ++m) { u32x2 wv; wv.x = pk_bf16(O[c][4 * m], O[c][4 * m + 1]); wv.y = pk_bf16(O[c][4 * m + 2], O[c][4 * m + 3]);
                *(u32x2*)(op + 32 * c + 8 * m + 4 * hh) = wv; } }
}

DI void diff_unit(Frame& F, int b, int hb, int qt, const bf16_t* proj, bf16_t* mix, float lam, const float* subln) {
    const int tid = F.tid, lane = F.lane, w = F.wave, hh = lane >> 5;
    LAS unsigned char* lds = F.lds;
    const int q0 = qt * 256, tw = q0 + 32 * w, t = tw + (lane & 31);
    const int colV = 2560 + hb * 128;
    const float slope2 = fexp2(-2.0f * (float)(hb + 1)) * LOG2E, sc2 = 0.125f * LOG2E;
    const int ntiles = qt * 4 + 4;
#pragma unroll 1
    for (int cm = 0; cm < 2; ++cm) {
        const int colQ = 1536 + hb * 128 + cm * 64, colK = 2048 + hb * 128 + cm * 64;
        bf16x8 qf[4];
        { const bf16_t* qp = proj + (size_t)(b * SEQ + t) * PITCH + colQ + hh * 8;
#pragma unroll
          for (int s = 0; s < 4; ++s) { const u32x4 raw = *(const u32x4*)(qp + 16 * s); u32x4 sc;
#pragma unroll
              for (int e = 0; e < 4; ++e) sc[e] = pk_bf16(bflo(raw[e]) * sc2, bfhi(raw[e]) * sc2);
              qf[s] = __builtin_bit_cast(bf16x8, sc); } }
        f32x16 O[4];
#pragma unroll
        for (int c = 0; c < 4; ++c) O[c] = f32x16{};
        float mref = 0.0f, lrun = 0.0f;
        StageRegs<128> sr;
        __syncthreads();
        stage_load<128>(sr, proj, b, ntiles - 1, colK, colV, tid);
        stage_write<128>(sr, lds, tid);
        __syncthreads();
        const int kd = tw >> 6;
#pragma unroll 1
        for (int it = 0; it < ntiles; ++it) {
            const int kt = ntiles - 1 - it;
            const bool more = kt > 0;
            if (more) stage_load<128>(sr, proj, b, kt - 1, colK, colV, tid);
            const LAS unsigned char* kb = lds + (it & 1) * BUF; const LAS unsigned char* vb = vtlane(kb + 64 * KP, VP_DF, lane);
            if (kt <= kd) {
                const float cl = slope2 * (float)(64 * kt + 4 * hh - t);
                f32x16 C0, C1;
#pragma unroll
                for (int i = 0; i < 16; ++i) { const float bi = slope2 * (float)((i & 3) + 8 * (i >> 2)); C0[i] = cl + bi; C1[i] = cl + (bi + 32.0f * slope2); }
                f32x16 S0 = C0, S1 = C1;
                { const LAS unsigned char* kp = kb + (lane & 31) * KP + (lane >> 5) * 16;
#pragma unroll
                  for (int s4 = 0; s4 < 4; ++s4) { const bf16x8 a0 = *(const LAS bf16x8*)(kp + s4 * 32), a1 = *(const LAS bf16x8*)(kp + 32 * KP + s4 * 32);
                      S0 = __builtin_amdgcn_mfma_f32_32x32x16_bf16(a0, qf[s4], S0, 0, 0, 0); S1 = __builtin_amdgcn_mfma_f32_32x32x16_bf16(a1, qf[s4], S1, 0, 0, 0); } }
                float mx;
                if (kt == kd) {
#pragma unroll
                    for (int i = 0; i < 16; ++i) { const int k0 = kt * 64 + crow(i, hh);
                        S0[i] = (k0 <= t) ? S0[i] : -INFINITY; S1[i] = (k0 + 32 <= t) ? S1[i] : -INFINITY; }
                }
                mx = fmaxf(S0[0], S1[0]);
#pragma unroll
                for (int i = 1; i < 16; ++i) mx = fmaxf(mx, fmaxf(S0[i], S1[i]));
                mx = fmaxf(mx, __shfl_xor(mx, 32));
                if (kt == kd) mref = mx;
                else if (__ballot(mx > mref + 8.0f) != 0ull) {
                    const float mnew = fmaxf(mref, mx), al = fexp2(mref - mnew); mref = mnew; lrun *= al;
#pragma unroll
                    for (int c = 0; c < 4; ++c)
#pragma unroll
                        for (int i = 0; i < 16; ++i) O[c][i] *= al;
                }
                if (__ballot(mx > mref - 150.0f) != 0ull) {
                float ls = 0.f;
#pragma unroll
                for (int i = 0; i < 16; ++i) { S0[i] = fexp2(S0[i] - mref); S1[i] = fexp2(S1[i] - mref); ls += S0[i] + S1[i]; }
                lrun += ls;
                const bf16x8 p0 = pack8(S0, 0), p1 = pack8(S0, 1), p2 = pack8(S1, 0), p3 = pack8(S1, 1);
#define DF_PVSTEP(row_, p_) do { const bf16x8 f0_ = vtfrag(vb, VP_DF, 0, (row_)), f1_ = vtfrag(vb, VP_DF, 1, (row_)), f2_ = vtfrag(vb, VP_DF, 2, (row_)), f3_ = vtfrag(vb, VP_DF, 3, (row_)); \
                    O[0] = __builtin_amdgcn_mfma_f32_32x32x16_bf16(f0_, (p_), O[0], 0, 0, 0); O[1] = __builtin_amdgcn_mfma_f32_32x32x16_bf16(f1_, (p_), O[1], 0, 0, 0); \
                    O[2] = __builtin_amdgcn_mfma_f32_32x32x16_bf16(f2_, (p_), O[2], 0, 0, 0); O[3] = __builtin_amdgcn_mfma_f32_32x32x16_bf16(f3_, (p_), O[3], 0, 0, 0); __builtin_amdgcn_sched_barrier(0); } while (0)
                DF_PVSTEP(0, p0); DF_PVSTEP(16, p1); DF_PVSTEP(32, p2); DF_PVSTEP(48, p3);
#undef DF_PVSTEP
                }
            }
            if (more) stage_write<128>(sr, lds + ((it + 1) & 1) * BUF, tid);
            __syncthreads();
        }
        const float ltot = lrun + __shfl_xor(lrun, 32);
        const float inv = 1.0f / ltot;
        LAS unsigned char* stash = lds + 2 * BUF + w * 8192 + lane * 16;
        if (cm == 0) {
#pragma unroll
            for (int c = 0; c < 4; ++c)
#pragma unroll
                for (int hf = 0; hf < 2; ++hf) { u32x4 pw;
                    pw.x = pk_bf16(O[c][8 * hf] * inv, O[c][8 * hf + 1] * inv); pw.y = pk_bf16(O[c][8 * hf + 2] * inv, O[c][8 * hf + 3] * inv);
                    pw.z = pk_bf16(O[c][8 * hf + 4] * inv, O[c][8 * hf + 5] * inv); pw.w = pk_bf16(O[c][8 * hf + 6] * inv, O[c][8 * hf + 7] * inv);
                    *(LAS u32x4*)(stash + (2 * c + hf) * 1024) = pw; }
        } else {
            const float li = lam * inv; float ss = 0.f;
#pragma unroll
            for (int c = 0; c < 4; ++c)
#pragma unroll
                for (int hf = 0; hf < 2; ++hf) { const u32x4 pw = *(const LAS u32x4*)(stash + (2 * c + hf) * 1024);
#pragma unroll
                    for (int q = 0; q < 4; ++q) { const float r0 = bflo(pw[q]) - li * O[c][8 * hf + 2 * q], r1 = bfhi(pw[q]) - li * O[c][8 * hf + 2 * q + 1]; ss += r0 * r0 + r1 * r1; } }
            ss += __shfl_xor(ss, 32);
            const float rs = 0.8f / sqrtf(ss * (1.0f / 128.0f) + RMS_EPS);
            bf16_t* op = mix + (size_t)(b * SEQ + t) * D + 512 + hb * 128;
#pragma unroll
            for (int c = 0; c < 4; ++c)
#pragma unroll
                for (int hf = 0; hf < 2; ++hf) { const u32x4 pw = *(const LAS u32x4*)(stash + (2 * c + hf) * 1024);
#pragma unroll
                    for (int mm = 0; mm < 2; ++mm) { const int m = 2 * hf + mm, d0 = 32 * c + 8 * m + 4 * hh; const f32x4 g = *(const f32x4*)(subln + d0);
                        const float r0 = bflo(pw[2 * mm]) - li * O[c][4 * m], r1 = bfhi(pw[2 * mm]) - li * O[c][4 * m + 1], r2 = bflo(pw[2 * mm + 1]) - li * O[c][4 * m + 2], r3 = bfhi(pw[2 * mm + 1]) - li * O[c][4 * m + 3];
                        if (PLAIN_FP8) *(unsigned*)((unsigned char*)mix + (size_t)(b * SEQ + t) * D + 512 + hb * 128 + d0) = pk_fp8x4(r0 * rs * g[0] * MSCALE, r1 * rs * g[1] * MSCALE, r2 * rs * g[2] * MSCALE, r3 * rs * g[3] * MSCALE);
                        else { u32x2 wv; wv.x = pk_bf16(r0 * rs * g[0], r1 * rs * g[1]); wv.y = pk_bf16(r2 * rs * g[2], r3 * rs * g[3]); *(u32x2*)(op + d0) = wv; } } }
        }
    }
}

DI void phase(Frame& F) {
    const bf16_t* proj = WSP(bf16_t, WS_R1); bf16_t* mix = WSP(bf16_t, WS_R2);
    float lam;
    { const float a = F.in[3][F.lane] * F.in[4][F.lane], c = F.in[5][F.lane] * F.in[6][F.lane];
      lam = expf(wave_sum(a)) - expf(wave_sum(c)) + 0.2f; }
    const float* subln = F.in[7];
    const int j = F.vcu;
#ifndef NO_DIFF
    for (int L = j; L < 256; L += F.G) {
#pragma unroll 1
        for (int rep = 0; rep < 2; ++rep) { const int L2 = rep ? 511 - L : L, qt = 7 - (L2 >> 6), bh = L2 & 63; diff_unit(F, bh >> 2, bh & 3, qt, proj, mix, lam, subln); }
    }
#endif
#ifndef NO_SB
    for (int L = j; L < 1024; L += F.G) {
        const int qt = 7 - (L >> 7), bh = L & 127;
        __syncthreads();
        sb_unit(F, bh >> 3, bh & 7, qt, proj, mix);
    }
#endif
    __syncthreads();
}
}

namespace lnr {
constexpr int WP = 2064;
DI void phase(Frame& F, int layer) {
    const int lane = F.lane, w = F.wave, tid = F.tid;
    const bf16_t* pre = WSP(bf16_t, WS_PRE); bf16_t* h1 = WSP(bf16_t, WS_H1); bf16_t* hb = WSP(bf16_t, WS_HB);
    const float* g = F.in[12] + layer * D; const float* bta = F.in[13] + layer * D; const float* rb = F.in[15] + layer * NEXP;
    const bf16_t* wr = WSP(bf16_t, WS_WR) + (size_t)layer * NEXP * D;
    unsigned* cnt = (unsigned*)(F.ctl + (layer ? CW_CNT1 : CW_CNT0));
    int* perm = WSP(int, WS_PERM); int* toker = WSP(int, WS_TOKER); float* tokg = WSP(float, WS_TOKG);
    LAS unsigned char* wl = F.lds;
    LAS float* gl = (LAS float*)(F.lds + 32 * WP);
    LAS int* ints = (LAS int*)(F.lds + LDS_INTS);
    LAS int* hist = ints + 96; LAS int* base = ints + 128;
    for (int i = tid; i < 32 * 128; i += NTHR) { const int r = i >> 7, c = i & 127; *(LAS u32x4*)(wl + r * WP + c * 16) = *(const u32x4*)(wr + (size_t)r * D + c * 8); }
    for (int i = tid; i < D; i += NTHR) { gl[i] = g[i]; gl[D + i] = bta[i]; }
    for (int ub = F.vcu; ub < T / 128; ub += F.G) {
        if (tid < 32) hist[tid] = 0;
        __syncthreads();
        const int r0 = ub * 128 + w * 16;
        float mean_l, rstd_l;
        { const bf16_t* rp = pre + (size_t)(r0 + (lane & 15)) * D + 8 * (lane >> 4);
          float s1 = 0.f, s2 = 0.f;
#pragma unroll 8
          for (int s = 0; s < 32; ++s) { const u32x4 xx = *(const u32x4*)(rp + 32 * s);
#pragma unroll
              for (int e = 0; e < 4; ++e) { const float a = bflo(xx[e]), c = bfhi(xx[e]); s1 += a + c; s2 += a * a + c * c; } }
          s1 += __shfl_xor(s1, 16); s2 += __shfl_xor(s2, 16); s1 += __shfl_xor(s1, 32); s2 += __shfl_xor(s2, 32);
          mean_l = s1 * (1.0f / D);
          const float var = fmaxf(s2 * (1.0f / D) - mean_l * mean_l, 0.0f);
          rstd_l = 1.0f / sqrtf(var + LN_EPS); }
        const int tok = lane & 15, q = lane >> 4; const size_t row = (size_t)(r0 + tok);
        f32x4 acc0 = {0.f, 0.f, 0.f, 0.f}, acc1 = {0.f, 0.f, 0.f, 0.f};
#pragma unroll 2
        for (int s = 0; s < 32; ++s) {
            const int k0 = 32 * s + 8 * q;
            const u32x4 xx = *(const u32x4*)(pre + row * D + k0);
            const f32x4 xa = {bflo(xx.x), bfhi(xx.x), bflo(xx.y), bfhi(xx.y)}, xb = {bflo(xx.z), bfhi(xx.z), bflo(xx.w), bfhi(xx.w)};
            const f32x4 ga = *(const LAS f32x4*)(gl + k0), gb = *(const LAS f32x4*)(gl + k0 + 4), ba = *(const LAS f32x4*)(gl + D + k0), bb = *(const LAS f32x4*)(gl + D + k0 + 4);
            const f32x4 ya = (xa - mean_l) * rstd_l * ga + ba, yb = (xb - mean_l) * rstd_l * gb + bb;
            u32x4 pw; pw.x = pk_bf16(ya[0], ya[1]); pw.y = pk_bf16(ya[2], ya[3]); pw.z = pk_bf16(yb[0], yb[1]); pw.w = pk_bf16(yb[2], yb[3]);
            *(u32x4*)(h1 + row * D + k0) = pw;
            if (!MOE_FP8) *(u32x4*)(hb + row * D + k0) = pw;
            else { u32x2 w8; const f32x4 za = ya * XSCALE, zb = yb * XSCALE;
                int p = __builtin_amdgcn_cvt_pk_fp8_f32(fminf(fmaxf(za[0], -440.f), 440.f), fminf(fmaxf(za[1], -440.f), 440.f), 0, false); p = __builtin_amdgcn_cvt_pk_fp8_f32(fminf(fmaxf(za[2], -440.f), 440.f), fminf(fmaxf(za[3], -440.f), 440.f), p, true); w8.x = (unsigned)p;
                p = __builtin_amdgcn_cvt_pk_fp8_f32(fminf(fmaxf(zb[0], -440.f), 440.f), fminf(fmaxf(zb[1], -440.f), 440.f), 0, false); p = __builtin_amdgcn_cvt_pk_fp8_f32(fminf(fmaxf(zb[2], -440.f), 440.f), fminf(fmaxf(zb[3], -440.f), 440.f), p, true); w8.y = (unsigned)p;
                *(u32x2*)((unsigned char*)hb + row * D + k0) = w8; }
            const bf16x8 bfrag = __builtin_bit_cast(bf16x8, pw);
            const bf16x8 a0 = *(const LAS bf16x8*)(wl + tok * WP + k0 * 2), a1 = *(const LAS bf16x8*)(wl + (16 + tok) * WP + k0 * 2);
            acc0 = __builtin_amdgcn_mfma_f32_16x16x32_bf16(a0, bfrag, acc0, 0, 0, 0);
            acc1 = __builtin_amdgcn_mfma_f32_16x16x32_bf16(a1, bfrag, acc1, 0, 0, 0);
        }
        float v[8];
#pragma unroll
        for (int i = 0; i < 4; ++i) { v[i] = acc0[i] + rb[4 * q + i]; v[4 + i] = acc1[i] + rb[16 + 4 * q + i]; }
        float tv[4]; int te[4];
#pragma unroll
        for (int k = 0; k < 4; ++k) {
            float bv = v[0]; int be = 4 * q;
#pragma unroll
            for (int i = 1; i < 8; ++i) { const int ee = (i < 4) ? 4 * q + i : 16 + 4 * q + (i - 4); if (v[i] > bv) { bv = v[i]; be = ee; } }
#pragma unroll
            for (int o = 16; o <= 32; o <<= 1) { const float ov = __shfl_xor(bv, o); const int oe = __shfl_xor(be, o); if (ov > bv || (ov == bv && oe < be)) { bv = ov; be = oe; } }
            tv[k] = bv; te[k] = be;
#pragma unroll
            for (int i = 0; i < 8; ++i) { const int ee = (i < 4) ? 4 * q + i : 16 + 4 * q + (i - 4); if (ee == be) v[i] = -INFINITY; }
        }
        float ge[4], gs = 0.f;
#pragma unroll
        for (int k = 0; k < 4; ++k) { ge[k] = __expf(tv[k] - tv[0]); gs += ge[k]; }
        const float ginv = 1.0f / gs;
        const int my_e = q == 0 ? te[0] : q == 1 ? te[1] : q == 2 ? te[2] : te[3];
        const float my_g = (q == 0 ? ge[0] : q == 1 ? ge[1] : q == 2 ? ge[2] : ge[3]) * ginv;
        const int rloc = __hip_atomic_fetch_add(hist + my_e, 1, __ATOMIC_RELAXED, __HIP_MEMORY_SCOPE_WORKGROUP);
        __syncthreads();
        if (tid < 32) base[tid] = (int)__hip_atomic_fetch_add(cnt + tid, (unsigned)hist[tid], RLX_AGENT);
        __syncthreads();
        const int rank = base[my_e] + rloc;
        perm[(size_t)my_e * T + rank] = (int)row;
        toker[row * 4 + q] = (my_e << 16) | rank;
        tokg[row * 4 + q] = my_g;
        __syncthreads();
    }
}
}

DI int moe_tileoff(Frame& F, int layer) {
    LAS int* ints = (LAS int*)(F.lds + LDS_INTS);
    unsigned* cnt = (unsigned*)(F.ctl + (layer ? CW_CNT1 : CW_CNT0));
    __syncthreads();
    if (F.tid < 32) ints[F.tid] = (int)__hip_atomic_load(cnt + F.tid, RLX_AGENT);
    __syncthreads();
    if (F.tid < 64) {
        const int tl = (F.tid < 32) ? (ints[F.tid] + 255) >> 8 : 0; int inc = tl;
#pragma unroll
        for (int o = 1; o < 32; o <<= 1) { const int up = __shfl_up(inc, o); if ((F.tid & 63) >= o) inc += up; }
        if (F.tid < 32) ints[32 + F.tid] = inc - tl;
        if (F.tid == 31) ints[64] = inc;
    }
    __syncthreads();
    return ints[64];
}

DI void cmb_phase(Frame& F, int layer, float* outf, bf16_t* outb) {
    const int ntile = moe_tileoff(F, layer); (void)ntile;
    const LAS int* ints = (const LAS int*)(F.lds + LDS_INTS);
    const bf16_t* h1 = WSP(bf16_t, WS_H1); const unsigned char* y = WSP(unsigned char, WS_R1);
    const int* toker = WSP(int, WS_TOKER); const float* tokg = WSP(float, WS_TOKG);
    const float* g = F.in[20] + layer * D; const float* bta = F.in[21] + layer * D;
    const int gw = F.vcu * NWAVES + F.wave, NGW = F.G * NWAVES, lane = F.lane;
    struct RowLd { u32x2 h[4]; int yv[4][4]; f32x4 gg; };
    auto issue = [&](int row, const i32x4& er, const f32x4& gg, RowLd& L) {
        L.gg = gg;
#pragma unroll
        for (int k = 0; k < 4; ++k) { const int e = er[k] >> 16, rank = er[k] & 0xffff; const size_t pos = (size_t)ints[32 + e] * 256 + rank;
#pragma unroll
            for (int j = 0; j < 4; ++j) L.yv[k][j] = __builtin_nontemporal_load((const int*)(y + pos * D) + lane + 64 * j); }
#pragma unroll
        for (int j = 0; j < 4; ++j) L.h[j] = *((const u32x2*)(h1 + (size_t)row * D) + lane + 64 * j);
    };
    i32x4 er1 = {0, 0, 0, 0}; f32x4 gg1 = {0.f, 0.f, 0.f, 0.f}; RowLd L0, L1;
    if (gw < T) { const i32x4 er0 = *(const i32x4*)(toker + (size_t)gw * 4); const f32x4 gg0 = *(const f32x4*)(tokg + (size_t)gw * 4); issue(gw, er0, gg0, L0); }
    if (gw + NGW < T) { er1 = *(const i32x4*)(toker + (size_t)(gw + NGW) * 4); gg1 = *(const f32x4*)(tokg + (size_t)(gw + NGW) * 4); }
    for (int row = gw; row < T; row += NGW) {
        const int rown = row + NGW, rownn = row + 2 * NGW;
        i32x4 er2 = {0, 0, 0, 0}; f32x4 gg2 = {0.f, 0.f, 0.f, 0.f};
        if (rownn < T) { er2 = *(const i32x4*)(toker + (size_t)rownn * 4); gg2 = *(const f32x4*)(tokg + (size_t)rownn * 4); }
        if (rown < T) issue(rown, er1, gg1, L1);
        f32x4 v[4]; float s = 0.f;
#pragma unroll
        for (int j = 0; j < 4; ++j) {
            f32x4 a = (f32x4){bflo(L0.h[j].x), bfhi(L0.h[j].x), bflo(L0.h[j].y), bfhi(L0.h[j].y)} * ALPHA;
#pragma unroll
            for (int k = 0; k < 4; ++k) { const int yy = L0.yv[k][j]; const float gk = L0.gg[k] * (1.0f / YSCALE);
                const f32x2 ylo = __builtin_amdgcn_cvt_pk_f32_fp8(yy, false), yhi = __builtin_amdgcn_cvt_pk_f32_fp8(yy, true);
                a[0] += gk * ylo[0]; a[1] += gk * ylo[1]; a[2] += gk * yhi[0]; a[3] += gk * yhi[1]; }
            v[j] = a; s += (a[0] + a[1]) + (a[2] + a[3]);
        }
        const float mean = wave_sum(s) * (1.0f / D); float s2 = 0.f;
#pragma unroll
        for (int j = 0; j < 4; ++j) { v[j] = v[j] - mean; s2 += (v[j][0] * v[j][0] + v[j][1] * v[j][1]) + (v[j][2] * v[j][2] + v[j][3] * v[j][3]); }
        const float rstd = 1.0f / sqrtf(wave_sum(s2) * (1.0f / D) + LN_EPS);
#pragma unroll
        for (int j = 0; j < 4; ++j) { const f32x4 gv = *((const f32x4*)g + lane + 64 * j), bv = *((const f32x4*)bta + lane + 64 * j);
            const f32x4 o = v[j] * rstd * gv + bv;
            if (outf) __builtin_nontemporal_store(o, (f32x4*)(outf + (size_t)row * D) + lane + 64 * j);
            if (outb) { u32x2 wv; wv.x = pk_bf16(o[0], o[1]); wv.y = pk_bf16(o[2], o[3]); *((u32x2*)(outb + (size_t)row * D) + lane + 64 * j) = wv;
                if (IN1_FP8) *((unsigned*)(WSP(unsigned char, WS_X8) + (size_t)row * D) + lane + 64 * j) = pk_fp8x4(o[0] * XSCALE, o[1] * XSCALE, o[2] * XSCALE, o[3] * XSCALE); } }
        L0 = L1; er1 = er2; gg1 = gg2;
    }
}

DI void moe_up_phase(Frame& F, int layer) {
    const int ntile = moe_tileoff(F, layer);
    LAS int* ints = (LAS int*)(F.lds + LDS_INTS);
    LAS unsigned* tab = (LAS unsigned*)(F.lds + LDS_TAB);
    constexpr unsigned RB = 1024 * MOE_EB;
    pg8::MoeSched S; S.to_lane = (F.lane < 32) ? ints[33 + F.lane] : 0x7fffffff; S.total = ntile * 8; S.G = F.G; S.c = F.vcu; S.ntshift = 3; S.gather = true; S.tab = tab; S.rowb = RB;
    S.W = (const char*)(WSP(unsigned char, WS_WGU) + (size_t)layer * 32 * 2048 * RB); S.wexp = (size_t)2048 * RB; S.wpn = (size_t)128 * RB;
    const int* perm = WSP(int, WS_PERM);
    { int tk[18];
#pragma unroll
      for (int i = 0; i < 18; ++i) { pg8::Unit u; tk[i] = -1;
          if (S.next(i, u) && F.tid < 256) { const int mloc = u.pm - ints[32 + u.e], r = mloc * 256 + F.tid; tk[i] = (r < ints[u.e]) ? perm[(size_t)u.e * T + r] : 0; } }
#pragma unroll
      for (int i = 0; i < 18; ++i) if (tk[i] >= 0) tab[i * 256 + F.tid] = (unsigned)tk[i] * RB; }
    __syncthreads();
    pg8::EpiSwiglu E{WSP(unsigned char, WS_R2), F.in[17] + (size_t)layer * 32 * 2048, MOE_FP8 ? 1.0f / (XSCALE * WSCALE) : 1.0f};
    pg8::gemm_phase<pg8::EpiSwiglu, pg8::MoeSched, MOE_FP8>(F.lds + LDS_STAGE, (const char*)WSP(unsigned char, WS_HB), RB, (size_t)1024 * RB, S, E);
}
DI void moe_down_phase(Frame& F, int layer) {
    const int ntile = moe_tileoff(F, layer);
    LAS int* ints = (LAS int*)(F.lds + LDS_INTS);
    constexpr unsigned RB = 1024 * MOE_EB;
    pg8::MoeSched S; S.to_lane = (F.lane < 32) ? ints[33 + F.lane] : 0x7fffffff; S.total = ntile * 4; S.G = F.G; S.c = F.vcu; S.ntshift = 2; S.gather = false; S.tab = nullptr; S.rowb = RB;
    S.W = (const char*)(WSP(unsigned char, WS_WD) + (size_t)layer * 32 * 1024 * RB); S.wexp = (size_t)1024 * RB; S.wpn = (size_t)256 * RB;
    pg8::EpiDown E{WSP(unsigned char, WS_R1), F.in[19] + (size_t)layer * 32 * 1024, MOE_FP8 ? 1.0f / (ASCALE * WSCALE) : 1.0f};
    pg8::gemm_phase<pg8::EpiDown, pg8::MoeSched, MOE_FP8>(F.lds + LDS_STAGE, (const char*)WSP(unsigned char, WS_R2), RB, (size_t)128 * RB, S, E);
}

namespace idx1 {
constexpr int PITCH = OD_COLS_P;
DI unsigned f2key(float f) { const unsigned u = __float_as_uint(f + 0.0f); return u ^ ((u >> 31) ? 0xffffffffu : 0x80000000u); }
DI int mbcnt64(unsigned long long m) { return (int)__builtin_amdgcn_mbcnt_hi((unsigned)(m >> 32), __builtin_amdgcn_mbcnt_lo((unsigned)m, 0u)); }
DI int wsum6(int c) { int t = 0;
#pragma unroll
    for (int b = 0; b < 6; ++b) t += __builtin_popcountll(__ballot((c >> b) & 1)) << b;
    return t; }
template <int NJ> DI void select_finish(const unsigned (&key)[NJ], unsigned th, int* op, LAS unsigned* bnd, int lane);
template <int NJ> DI void select256x2(const LAS float* rowA, const LAS float* rowB, int nA, int nB, int* opA, int* opB, LAS unsigned* bnd, int lane) {
    static_assert(NJ % 2 == 0, "pairs of register slots");
    unsigned hA[NJ / 2], hB[NJ / 2];
#pragma unroll
    for (int j = 0; j < NJ / 2; ++j) { const int p0 = lane + 64 * (2 * j), p1 = p0 + 64;
        const unsigned a0 = (p0 < nA) ? f2key(rowA[p0]) : 0u, a1 = (p1 < nA) ? f2key(rowA[p1]) : 0u, b0 = (p0 < nB) ? f2key(rowB[p0]) : 0u, b1 = (p1 < nB) ? f2key(rowB[p1]) : 0u;
        hA[j] = (a0 >> 16) | (a1 & 0xffff0000u); hB[j] = (b0 >> 16) | (b1 & 0xffff0000u); }
    unsigned thA = 0u, thB = 0u;
    const unsigned one2 = 0x00010001u;
#pragma unroll 1
    for (int bit = 15; bit >= 0; --bit) {
        const unsigned cA1 = ((thA | (1u << bit)) - 1u) & 0xffffu, cB1 = ((thB | (1u << bit)) - 1u) & 0xffffu;
        const unsigned mA = cA1 | (cA1 << 16), mB = cB1 | (cB1 << 16);
        unsigned kA = 0u, kB = 0u;
#pragma unroll
        for (int j = 0; j < NJ / 2; ++j) { unsigned dA, dB;
            asm("v_pk_sub_u16 %0, %1, %2 clamp" : "=v"(dA) : "v"(hA[j]), "v"(mA)); asm("v_pk_min_u16 %0, %1, %2" : "=v"(dA) : "v"(dA), "v"(one2)); asm("v_pk_add_u16 %0, %1, %2" : "=v"(kA) : "v"(kA), "v"(dA));
            asm("v_pk_sub_u16 %0, %1, %2 clamp" : "=v"(dB) : "v"(hB[j]), "v"(mB)); asm("v_pk_min_u16 %0, %1, %2" : "=v"(dB) : "v"(dB), "v"(one2)); asm("v_pk_add_u16 %0, %1, %2" : "=v"(kB) : "v"(kB), "v"(dB)); }
        const int cA = (int)(kA & 0xffffu) + (int)(kA >> 16), cB = (int)(kB & 0xffffu) + (int)(kB >> 16);
        int tA = 0, tB = 0;
#pragma unroll
        for (int b = 0; b < 6; ++b) { tA += __builtin_popcountll(__ballot((cA >> b) & 1)) << b; tB += __builtin_popcountll(__ballot((cB >> b) & 1)) << b; }
        if (tA >= 256) thA |= (1u << bit);
        if (tB >= 256) thB |= (1u << bit);
    }
    { unsigned key[NJ];
#pragma unroll
      for (int j = 0; j < NJ; ++j) { const int p = lane + 64 * j; key[j] = (p < nA) ? f2key(rowA[p]) : 0u; }
      select_finish<NJ>(key, thA, opA, bnd, lane); }
    { unsigned key[NJ];
#pragma unroll
      for (int j = 0; j < NJ; ++j) { const int p = lane + 64 * j; key[j] = (p < nB) ? f2key(rowB[p]) : 0u; }
      select_finish<NJ>(key, thB, opB, bnd, lane); }
}
template <int NJ> DI void select_finish(const unsigned (&key)[NJ], unsigned th, int* op, LAS unsigned* bnd, int lane) {
    const unsigned lo32 = th << 16;
    int cg = 0, ce = 0;
#pragma unroll
    for (int j = 0; j < NJ; ++j) { const unsigned d = key[j] - lo32; cg += (key[j] >= lo32 && d > 0xffffu) ? 1 : 0; ce += (key[j] >= lo32 && d <= 0xffffu) ? 1 : 0; }
    int G = 0, pre = 0, B = 0, preE = 0;
#pragma unroll
    for (int b = 0; b < 6; ++b) { const unsigned long long m = __ballot((cg >> b) & 1); G += __builtin_popcountll(m) << b; pre += mbcnt64(m) << b;
        const unsigned long long me = __ballot((ce >> b) & 1); B += __builtin_popcountll(me) << b; preE += mbcnt64(me) << b; }
    {   int w = pre;
#pragma unroll
        for (int j = 0; j < NJ; ++j) { const unsigned d = key[j] - lo32; if (key[j] >= lo32 && d > 0xffffu) { op[w] = lane + 64 * j; ++w; } }
    }
    const int need = 256 - G;
    if (B <= 64) {
        {   int w = preE;
#pragma unroll
            for (int j = 0; j < NJ; ++j) { const unsigned d = key[j] - lo32; if (key[j] >= lo32 && d <= 0xffffu) { bnd[w] = (d << 11) | (unsigned)(2047 - (lane + 64 * j)); ++w; } }
        }
        LDS_WAIT(); asm volatile("" ::: "memory");
        const unsigned mine = (lane < B) ? bnd[lane] : 0u;
        int rank = 0;
#pragma unroll 1
        for (int i = 0; i < B; ++i) { const unsigned o = (unsigned)__builtin_amdgcn_readlane((int)mine, i); rank += (o > mine) ? 1 : 0; }
        if (lane < B && rank < need) op[G + rank] = 2047 - (int)(mine & 2047u);
        LDS_WAIT(); asm volatile("" ::: "memory");
    } else {
        unsigned tl = 0u;
#pragma unroll 1
        for (int bit = 15; bit >= 0; --bit) {
            const unsigned cand = lo32 | tl | (1u << bit); int c = 0;
#pragma unroll
            for (int j = 0; j < NJ; ++j) c += (key[j] >= cand) ? 1 : 0;
            if (wsum6(c) >= 256) tl |= (1u << bit);
        }
        const unsigned tau = lo32 | tl; int base = G;
#pragma unroll
        for (int j = 0; j < NJ; ++j) { const bool sel = key[j] > tau && (key[j] - lo32) <= 0xffffu; const unsigned long long m = __ballot(sel);
            if (sel) op[base + mbcnt64(m)] = lane + 64 * j; base += __builtin_popcountll(m); }
        const int need2 = 256 - base; int eb = 0;
#pragma unroll
        for (int j = 0; j < NJ; ++j) { const bool eq = key[j] == tau; const unsigned long long m = __ballot(eq); const int pos = eb + mbcnt64(m);
            if (eq && pos < need2) op[base + pos] = lane + 64 * j; eb += __builtin_popcountll(m); }
    }
}
DI void phase(Frame& F) {
    const int lane = F.lane, w = F.wave, tid = F.tid, hh = lane >> 5;
    const bf16_t* proj = WSP(bf16_t, WS_R1);
    { const float* kvw = F.in[9]; bf16_t* ckv = WSP(bf16_t, WS_CKV);
      const int gw = F.vcu * NWAVES + w, NGW = F.G * NWAVES;
      const float w0 = kvw[2 * lane], w1 = kvw[2 * lane + 1];
      for (int row = gw; row < T; row += 4 * NGW) {
          unsigned c[4];
#pragma unroll
          for (int u = 0; u < 4; ++u) c[u] = (row + u * NGW < T) ? *(const unsigned*)(proj + (size_t)(row + u * NGW) * PITCH + 2048 + 2 * lane) : 0u;
#pragma unroll
          for (int u = 0; u < 4; ++u) { if (row + u * NGW >= T) break;
              const float a = bflo(c[u]), b = bfhi(c[u]);
              const float ss = wave_sum(a * a + b * b);
              const float rs = 1.0f / sqrtf(ss * (1.0f / 128.0f) + RMS_EPS);
              *(unsigned*)(ckv + (size_t)(row + u * NGW) * 128 + 2 * lane) = pk_bf16(a * rs * w0, b * rs * w1); }
      } }
    LAS float* sc = (LAS float*)F.lds;
    LAS float* wq = (LAS float*)(F.lds + LDS_TAB);
    LAS unsigned* bnd = (LAS unsigned*)(F.lds + LDS_TAB + 1024) + w * 64;
    int* idxo = WSP(int, WS_IDX);
    for (int u = F.vcu; u < T / 16; u += F.G) {
        const int b = u >> 7, q0 = (((u & 127) + 16 * (b >> 1)) & 127) * 16;
        __syncthreads();
        if (tid < 128) wq[tid] = bf2f(proj[(size_t)(b * SEQ + q0 + (tid >> 3)) * PITCH + 2752 + (tid & 7)]);
        bf16x8 qf[4][4];
#pragma unroll
        for (int rg = 0; rg < 4; ++rg) { const bf16_t* qp = proj + (size_t)(b * SEQ + q0 + 4 * rg + ((lane & 31) >> 3)) * PITCH + 2176 + (lane & 7) * 64 + hh * 8;
#pragma unroll
            for (int s = 0; s < 4; ++s) qf[rg][s] = *(const bf16x8*)(qp + 16 * s); }
        const int nkb = (q0 + 15) / 32 + 1;
        const bf16_t* kbase = proj + (size_t)(b * SEQ + (lane & 31)) * PITCH + 2688 + hh * 8;
        bf16x8 kf[4], kn[4];
        if (w < nkb) {
#pragma unroll
            for (int s = 0; s < 4; ++s) kf[s] = *(const bf16x8*)(kbase + (size_t)(32 * w) * PITCH + 16 * s); }
        __syncthreads();
        for (int kb = w; kb < nkb; kb += NWAVES) {
            if (kb + NWAVES < nkb) {
#pragma unroll
                for (int s = 0; s < 4; ++s) kn[s] = *(const bf16x8*)(kbase + (size_t)(32 * (kb + NWAVES)) * PITCH + 16 * s); }
#pragma unroll
            for (int rg = 0; rg < 4; ++rg) {
                f32x16 dd = {};
#pragma unroll
                for (int s = 0; s < 4; ++s) dd = __builtin_amdgcn_mfma_f32_32x32x16_bf16(qf[rg][s], kf[s], dd, 0, 0, 0);
                float part[4];
#pragma unroll
                for (int q4 = 0; q4 < 4; ++q4) { const f32x4 wv = *(const LAS f32x4*)(wq + (4 * rg + q4) * 8 + 4 * hh);
                    part[q4] = wv[0] * fmaxf(dd[4 * q4], 0.f) + wv[1] * fmaxf(dd[4 * q4 + 1], 0.f) + wv[2] * fmaxf(dd[4 * q4 + 2], 0.f) + wv[3] * fmaxf(dd[4 * q4 + 3], 0.f); }
#pragma unroll
                for (int q4 = 0; q4 < 4; ++q4) part[q4] += __shfl_xor(part[q4], 32);
                const int key = 32 * kb + (lane & 31);
                if (hh == 0) { sc[(4 * rg + 0) * 2048 + key] = part[0]; sc[(4 * rg + 1) * 2048 + key] = part[1]; }
                else         { sc[(4 * rg + 2) * 2048 + key] = part[2]; sc[(4 * rg + 3) * 2048 + key] = part[3]; }
            }
#pragma unroll
            for (int s = 0; s < 4; ++s) kf[s] = kn[s];
        }
        __syncthreads();
        {
            const int qi = 2 * w, t = q0 + qi, n = t + 1;
            int* opA = idxo + (size_t)(b * SEQ + t) * 256; int* opB = opA + 256;
            if (n + 1 <= 256) {
#pragma unroll
                for (int j = 0; j < 4; ++j) { const int p = lane + 64 * j; opA[p] = (p < n) ? p : -1; opB[p] = (p < n + 1) ? p : -1; }
            } else {
                const LAS float* rowA = sc + qi * 2048; const LAS float* rowB = rowA + 2048;
                if (n + 1 <= 512) select256x2<8>(rowA, rowB, n, n + 1, opA, opB, bnd, lane);
                else if (n + 1 <= 1024) select256x2<16>(rowA, rowB, n, n + 1, opA, opB, bnd, lane);
                else if (n + 1 <= 1536) select256x2<24>(rowA, rowB, n, n + 1, opA, opB, bnd, lane);
                else select256x2<32>(rowA, rowB, n, n + 1, opA, opB, bnd, lane);
            }
        }
    }
    __syncthreads();
}
}

namespace spa1 {
constexpr int RP = 272;
constexpr int PITCH = OD_COLS_P;
DI s16x4 trrd(const LAS unsigned char* p) { typedef short v4i16_t __attribute__((ext_vector_type(4))); return __builtin_bit_cast(s16x4, __builtin_amdgcn_ds_read_tr16_b64_v4i16((LAS v4i16_t*)p)); }
DI void phase(Frame& F) {
    const int lane = F.lane, w = F.wave, hd = lane & 15, g = lane >> 4;
    const bf16_t* proj = WSP(bf16_t, WS_R1); const bf16_t* ckv = WSP(bf16_t, WS_CKV); const int* idx = WSP(int, WS_IDX); bf16_t* of = WSP(bf16_t, WS_R2);
    LAS unsigned char* buf = F.lds + w * (32 * RP + 2048);
    LAS float* dl = (LAS float*)(buf + 32 * RP);
    LAS unsigned* ofl = (LAS unsigned*)(buf + 32 * RP + 1024);
    const float slope2 = fexp2(-0.5f * (float)(hd + 1)) * LOG2E, sc2 = 0.08838834764831845f * LOG2E;
    const int gw = F.vcu * NWAVES + w, NGW = F.G * NWAVES;
#define SPA_Q(jj, b_, t_, row_) const int lin_##jj = gw + (jj) * NGW, b_ = lin_##jj / SEQ, t_ = (lin_##jj + 131 * b_) % SEQ; const size_t row_ = (size_t)(b_ * SEQ + t_)
    i32x4 idr; bf16x8 qn[4];
    if (gw < T) { SPA_Q(0, b0_, t0_, row0_); (void)t0_; idr = *(const i32x4*)(idx + row0_ * 256 + 4 * lane);
        const bf16_t* qp = proj + row0_ * PITCH + hd * 128 + g * 8;
#pragma unroll
        for (int s = 0; s < 4; ++s) qn[s] = *(const bf16x8*)(qp + 32 * s); }
    for (int j = 0; gw + j * NGW < T; ++j) {
        const int lin = gw + j * NGW, b = lin / SEQ, t = (lin + 131 * b) % SEQ;
        const size_t row = (size_t)(b * SEQ + t);
        const int nsel = (t + 1 < 256) ? t + 1 : 256, nch = (nsel + 31) >> 5;
        { f32x4 d4;
#pragma unroll
          for (int e = 0; e < 4; ++e) d4[e] = idr[e] < 0 ? 1.0e30f : (float)(t - idr[e]);
          *(LAS f32x4*)(dl + 4 * lane) = d4; }
        { u32x4 o4;
#pragma unroll
          for (int e = 0; e < 4; ++e) o4[e] = (unsigned)(idr[e] < 0 ? 0 : idr[e]) * 256u;
          *(LAS u32x4*)(ofl + 4 * lane) = o4; }
        const char* ckvb = (const char*)(ckv + (size_t)b * SEQ * 128) + 16 * hd;
        bf16x8 qf[4];
#pragma unroll
        for (int s = 0; s < 4; ++s) qf[s] = qn[s];
        if (gw + (j + 1) * NGW < T) {
            const int lin2 = gw + (j + 1) * NGW, b2 = lin2 / SEQ, t2 = (lin2 + 131 * b2) % SEQ; const size_t row2 = (size_t)(b2 * SEQ + t2);
            idr = *(const i32x4*)(idx + row2 * 256 + 4 * lane);
            const bf16_t* qp = proj + row2 * PITCH + hd * 128 + g * 8;
#pragma unroll
            for (int s = 0; s < 4; ++s) qn[s] = *(const bf16x8*)(qp + 32 * s);
        }
        f32x4 O[8];
#pragma unroll
        for (int c = 0; c < 8; ++c) O[c] = (f32x4){0.f, 0.f, 0.f, 0.f};
        float mrun = -1.0e30f, lrun = 0.f;
#define SPA_CORE             const f32x4 kd0 = *(const LAS f32x4*)(dl + 32 * c + 4 * g) * slope2, kd1 = *(const LAS f32x4*)(dl + 32 * c + 16 + 4 * g) * slope2; \
            f32x4 s0 = {0.f, 0.f, 0.f, 0.f}, s1 = {0.f, 0.f, 0.f, 0.f}; \
_Pragma("unroll") \
            for (int s = 0; s < 4; ++s) { \
                const bf16x8 a0 = *(const LAS bf16x8*)(buf + hd * RP + (32 * s + 8 * g) * 2), a1 = *(const LAS bf16x8*)(buf + (16 + hd) * RP + (32 * s + 8 * g) * 2); \
                s0 = __builtin_amdgcn_mfma_f32_16x16x32_bf16(a0, qf[s], s0, 0, 0, 0); \
                s1 = __builtin_amdgcn_mfma_f32_16x16x32_bf16(a1, qf[s], s1, 0, 0, 0); \
            } \
            float mx = -INFINITY; \
_Pragma("unroll") \
            for (int i = 0; i < 4; ++i) { \
                s0[i] = s0[i] * sc2 - kd0[i]; \
                s1[i] = s1[i] * sc2 - kd1[i]; \
                mx = fmaxf(mx, fmaxf(s0[i], s1[i])); \
            } \
            mx = fmaxf(mx, __shfl_xor(mx, 16)); mx = fmaxf(mx, __shfl_xor(mx, 32)); \
            if (__ballot(mx > mrun + 8.0f) != 0ull) { const float mnew = fmaxf(mrun, mx), al = fexp2(mrun - mnew); mrun = mnew; lrun *= al; \
                _Pragma("unroll") for (int c8 = 0; c8 < 8; ++c8) O[c8] = O[c8] * al; } \
            float ls = 0.f; \
_Pragma("unroll") \
            for (int i = 0; i < 4; ++i) { s0[i] = fexp2(s0[i] - mrun); s1[i] = fexp2(s1[i] - mrun); ls += s0[i] + s1[i]; } \
            lrun += ls; \
            u32x4 pw; pw.x = pk_bf16(s0[0], s0[1]); pw.y = pk_bf16(s0[2], s0[3]); pw.z = pk_bf16(s1[0], s1[1]); pw.w = pk_bf16(s1[2], s1[3]); \
            const bf16x8 pf = __builtin_bit_cast(bf16x8, pw); \
            const int q = hd >> 2, p = hd & 3; \
_Pragma("unroll") \
            for (int c8 = 0; c8 < 8; ++c8) { \
                const LAS unsigned char* a = buf + (4 * g + q) * RP + (16 * c8 + 4 * p) * 2; \
                const s16x4 lo = trrd(a), hi = trrd(a + 16 * RP); \
                const bf16x8 vf = __builtin_shufflevector(lo, hi, 0, 1, 2, 3, 4, 5, 6, 7); \
                O[c8] = __builtin_amdgcn_mfma_f32_16x16x32_bf16(vf, pf, O[c8], 0, 0, 0); \
            }
        u32x4 grA[8], grB[8];
#define SPA_GLOAD(gr_, cc) do { _Pragma("unroll") for (int i_ = 0; i_ < 8; ++i_) gr_[i_] = *(const u32x4*)(ckvb + ofl[32 * (cc) + g + 4 * i_]); } while (0)
#define SPA_CHUNK(gr_, cnext_) do { \
            _Pragma("unroll") for (int i = 0; i < 8; ++i) *(LAS u32x4*)(buf + (g + 4 * i) * RP + 16 * hd) = gr_[i]; \
            if ((cnext_) < nch) SPA_GLOAD(gr_, (cnext_)); \
            SPA_CORE } while (0)
        SPA_GLOAD(grA, 0);
        if (nch > 1) SPA_GLOAD(grB, 1);
#pragma unroll 1
        for (int c2 = 0; c2 < nch; c2 += 2) {
            { const int c = c2; SPA_CHUNK(grA, c2 + 2); }
            if (c2 + 1 < nch) { const int c = c2 + 1; SPA_CHUNK(grB, c2 + 3); }
        }
#undef SPA_CHUNK
#undef SPA_GLOAD
        float lt = lrun + __shfl_xor(lrun, 16); lt += __shfl_xor(lt, 32);
        const float inv = 1.0f / lt;
        if (PLAIN_FP8) { unsigned char* op = (unsigned char*)of + row * 2048 + hd * 128 + 4 * g; const float iv = inv * MSCALE;
#pragma unroll
            for (int c8 = 0; c8 < 8; ++c8) *(unsigned*)(op + 16 * c8) = pk_fp8x4(O[c8][0] * iv, O[c8][1] * iv, O[c8][2] * iv, O[c8][3] * iv);
        } else { bf16_t* op = of + row * 2048 + hd * 128 + 4 * g;
#pragma unroll
            for (int c8 = 0; c8 < 8; ++c8) { u32x2 wv; wv.x = pk_bf16(O[c8][0] * inv, O[c8][1] * inv); wv.y = pk_bf16(O[c8][2] * inv, O[c8][3] * inv); *(u32x2*)(op + 16 * c8) = wv; } }
    }
}
}

constexpr int NPHASE = 16;
struct Args { const float* in[22]; float* out; unsigned char* ws; int ph_lo, ph_hi, bar_region, pad; };
__global__ void __launch_bounds__(NTHR, 2) fwd(Args args) {
    extern __shared__ __attribute__((aligned(16))) unsigned char lds_raw[];
    Frame F;
    F.lds = (LAS unsigned char*)lds_raw;
    F.tid = threadIdx.x; F.lane = F.tid & 63; F.wave = __builtin_amdgcn_readfirstlane(F.tid >> 6);
    F.G = gridDim.x; { const int bx = blockIdx.x; F.vcu = (F.G % 8 == 0) ? (bx % 8) * (F.G / 8) + bx / 8 : bx; }
    F.ws = args.ws; F.ctl = (gu32*)(args.ws + WS_CTL); F.out = args.out;
#pragma unroll
    for (int i = 0; i < 22; ++i) F.in[i] = args.in[i];
    volatile LAS unsigned* MISC = (volatile LAS unsigned*)(F.lds + LDS_MISC);
    if (F.tid < 64) MISC[F.tid] = 0u;
    __syncthreads();
    const int lo = args.ph_lo, hi = args.ph_hi;
    XcdBarrier bar; bar.bar = (unsigned*)(F.ctl + CW_BAR) + args.bar_region * XCD_BAR_WORDS; bar.x = 0; bar.st = nullptr;
    if (hi - lo > 1) bar = xcd_barrier_post((unsigned*)(F.ctl + CW_BAR) + args.bar_region * XCD_BAR_WORDS, MISC + 8);
#ifndef REPEAT_MASK
#define REPEAT_MASK 0
#endif
#ifndef PHASE_MASK
#define PHASE_MASK 0xFFFF
#endif
#define IN(k) (((PHASE_MASK >> (k)) & 1) && lo <= (k) && (k) < hi)
#define REPEAT_LOOP(k)
#define SEAM(k) do { if (IN(k) && IN((k) + 1)) xcd_barrier(bar); } while (0)

    if (IN(0)) { REPEAT_LOOP(0) { p0_prologue(F); } } SEAM(0);
    if (IN(1)) { REPEAT_LOOP(1) { pg8::PlainSched S; S.init(T, EV_COLS, D, D, WSP(unsigned char, WS_WEVIN), F.G, (int)blockIdx.x, IN_EB);
        pg8::EpiProj E{WSP(bf16_t, WS_R1), EV_COLS, IN_FP8 ? 1.0f / (XSCALE * WSCALE) : 1.0f};
        pg8::gemm_phase<pg8::EpiProj, pg8::PlainSched, IN_FP8>(F.lds + LDS_STAGE, (const char*)(IN_FP8 ? WSP(unsigned char, WS_X8) : WSP(unsigned char, WS_XB)), D * IN_EB, (size_t)128 * D * IN_EB, S, E); } } SEAM(1);
    if (IN(2)) { REPEAT_LOOP(2) { att0::phase(F); } } SEAM(2);
    if (IN(3)) { REPEAT_LOOP(3) { pg8::PlainSched S; S.init(T, D, D, D, WSP(unsigned char, WS_WEVOUT), F.G, (int)blockIdx.x, PL_EB);
        pg8::EpiRes E{nullptr, WSP(bf16_t, WS_XB), WSP(bf16_t, WS_PRE), PLAIN_FP8 ? 1.0f / (MSCALE * WSCALE) : 1.0f};
        pg8::gemm_phase<pg8::EpiRes, pg8::PlainSched, PLAIN_FP8>(F.lds + LDS_STAGE, (const char*)WSP(unsigned char, WS_R2), D * PL_EB, (size_t)128 * D * PL_EB, S, E); } } SEAM(3);
    if (IN(4)) { REPEAT_LOOP(4) { lnr::phase(F, 0); } } SEAM(4);
    if (IN(5)) { REPEAT_LOOP(5) { moe_up_phase(F, 0); } } SEAM(5);
    if (IN(6)) { REPEAT_LOOP(6) { moe_down_phase(F, 0); } } SEAM(6);
    if (IN(7)) { REPEAT_LOOP(7) { cmb_phase(F, 0, nullptr, WSP(bf16_t, WS_XB)); } } SEAM(7);
    if (IN(8)) { REPEAT_LOOP(8) { pg8::PlainSched S; S.init(T, OD_COLS_P, D, D, WSP(unsigned char, WS_WODIN), F.G, (int)blockIdx.x, IN1_EB);
        pg8::EpiProj E{WSP(bf16_t, WS_R1), OD_COLS_P, IN1_FP8 ? 1.0f / (XSCALE * WSCALE) : 1.0f};
        pg8::gemm_phase<pg8::EpiProj, pg8::PlainSched, IN1_FP8>(F.lds + LDS_STAGE, (const char*)(IN1_FP8 ? WSP(unsigned char, WS_X8) : WSP(unsigned char, WS_XB)), D * IN1_EB, (size_t)128 * D * IN1_EB, S, E); } } SEAM(8);
    if (IN(9)) { REPEAT_LOOP(9) { idx1::phase(F); } } SEAM(9);
    if (IN(10)) { REPEAT_LOOP(10) { spa1::phase(F); } } SEAM(10);
    if (IN(11)) { REPEAT_LOOP(11) { pg8::PlainSched S; S.init(T, D, 2048, 2048, WSP(unsigned char, WS_WCOMB), F.G, (int)blockIdx.x, PL_EB);
        pg8::EpiRes E{nullptr, WSP(bf16_t, WS_XB), WSP(bf16_t, WS_PRE), PLAIN_FP8 ? 1.0f / (MSCALE * WCSCALE) : 1.0f};
        pg8::gemm_phase<pg8::EpiRes, pg8::PlainSched, PLAIN_FP8>(F.lds + LDS_STAGE, (const char*)WSP(unsigned char, WS_R2), 2048 * PL_EB, (size_t)128 * 2048 * PL_EB, S, E); } } SEAM(11);
    if (IN(12)) { REPEAT_LOOP(12) { lnr::phase(F, 1); } } SEAM(12);
    if (IN(13)) { REPEAT_LOOP(13) { moe_up_phase(F, 1); } } SEAM(13);
    if (IN(14)) { REPEAT_LOOP(14) { moe_down_phase(F, 1); } } SEAM(14);
    if (IN(15)) { REPEAT_LOOP(15) { cmb_phase(F, 1, F.out, nullptr); } } SEAM(15);
#undef IN
#undef SEAM
}

extern "C" void kernel_launch(void* const* d_in, const int* in_sizes, int n_in, void* d_out, int out_size, void* d_ws, size_t ws_size, hipStream_t stream) {
    static int grid = 0;
    if (grid == 0) {
        if (n_in != 22 || out_size != T * D || ws_size < WS_END) { fprintf(stderr, "kernel_launch: unexpected shapes (n_in %d out %d ws %zu need %zu)\n", n_in, out_size, ws_size, (size_t)WS_END); grid = -1; return; }
        int dev = 0, cus = 0;
        if (hipGetDevice(&dev) != hipSuccess || hipDeviceGetAttribute(&cus, hipDeviceAttributeMultiprocessorCount, dev) != hipSuccess) { grid = -1; return; }
        if (hipFuncSetAttribute((const void*)fwd, hipFuncAttributeMaxDynamicSharedMemorySize, LDS_BYTES) != hipSuccess) { fprintf(stderr, "kernel_launch: hipFuncSetAttribute failed\n"); grid = -1; return; }
        int per_cu = 0;
        if (hipOccupancyMaxActiveBlocksPerMultiprocessor(&per_cu, (const void*)fwd, NTHR, LDS_BYTES) != hipSuccess || per_cu < 1) fprintf(stderr, "kernel_launch: occupancy query reports %d\n", per_cu);
        (void)hipGetLastError();
        grid = cus;
    }
    if (grid < 0) return;
    if (hipMemsetAsync((char*)d_ws + WS_CTL, 0, CTL_ZERO_BYTES, stream) != hipSuccess) return;
    Args a{};
    for (int i = 0; i < 22; ++i) a.in[i] = (const float*)d_in[i];
    a.out = (float*)d_out; a.ws = (unsigned char*)d_ws;
#if MK_PER_PHASE
    for (int p = 0; p < NPHASE; ++p) { a.ph_lo = p; a.ph_hi = p + 1; hipLaunchKernelGGL(fwd, dim3(grid), dim3(NTHR), LDS_BYTES, stream, a); }
#elif REPEAT_MASK
    { int lo = 0, reg = 0;
      for (int k = 0; k < NPHASE; ++k) if ((REPEAT_MASK >> k) & 1) {
          a.ph_lo = lo; a.ph_hi = k + 1; a.bar_region = reg++; hipLaunchKernelGGL(fwd, dim3(grid), dim3(NTHR), LDS_BYTES, stream, a);
          a.ph_lo = k; a.ph_hi = k + 1; a.bar_region = reg++; hipLaunchKernelGGL(fwd, dim3(grid), dim3(NTHR), LDS_BYTES, stream, a);
          lo = k + 1; }
      if (lo < NPHASE) { a.ph_lo = lo; a.ph_hi = NPHASE; a.bar_region = reg++; hipLaunchKernelGGL(fwd, dim3(grid), dim3(NTHR), LDS_BYTES, stream, a); } }
#else
    a.ph_lo = 0; a.ph_hi = NPHASE; hipLaunchKernelGGL(fwd, dim3(grid), dim3(NTHR), LDS_BYTES, stream, a);
#endif
}
```

```cpp
#include <hip/hip_runtime.h>
#include <cstdio>
#include <cstdint>

#ifndef MK_PER_PHASE
#define MK_PER_PHASE 0
#endif

#define GAS __attribute__((address_space(1)))
#define LAS __attribute__((address_space(3)))
typedef unsigned short bf16_t;
typedef short bf16x8 __attribute__((ext_vector_type(8)));
typedef short s16x4 __attribute__((ext_vector_type(4)));
typedef float f32x2 __attribute__((ext_vector_type(2)));
typedef float f32x4 __attribute__((ext_vector_type(4)));
typedef float f32x16 __attribute__((ext_vector_type(16)));
typedef unsigned u32x2 __attribute__((ext_vector_type(2)));
typedef unsigned u32x4 __attribute__((ext_vector_type(4)));
typedef int i32x4 __attribute__((ext_vector_type(4)));
typedef GAS unsigned gu32;
#define RLX_AGENT __ATOMIC_RELAXED, __HIP_MEMORY_SCOPE_AGENT
#define DI __device__ __forceinline__

constexpr int BATCH = 16, SEQ = 2048, T = BATCH * SEQ, D = 1024;
constexpr int NEXP = 32, DFF = 1024;
constexpr int EV_COLS = 3072, OD_COLS = 2760, OD_COLS_P = 2816;
constexpr float ALPHA = 1.41421356237309515f;
constexpr float LN_EPS = 1e-5f, RMS_EPS = 1e-5f;
constexpr float LOG2E = 1.4426950408889634f;
constexpr int MAXROWS = 131072 + 32 * 256;
constexpr int NWAVES = 8, NTHR = 512;
#ifndef MOE_FP8_ON
#define MOE_FP8_ON 1
#endif
constexpr bool MOE_FP8 = MOE_FP8_ON != 0;
constexpr int MOE_EB = MOE_FP8 ? 1 : 2;
#ifndef PLAIN_FP8_ON
#define PLAIN_FP8_ON 1
#endif
constexpr bool PLAIN_FP8 = PLAIN_FP8_ON != 0;
#ifndef IN_FP8_ON
#define IN_FP8_ON 0
#endif
constexpr bool IN_FP8 = IN_FP8_ON != 0;
#ifndef IN1_FP8_ON
#define IN1_FP8_ON 0
#endif
constexpr bool IN1_FP8 = IN1_FP8_ON != 0;
constexpr int PL_EB = PLAIN_FP8 ? 1 : 2, IN_EB = IN_FP8 ? 1 : 2, IN1_EB = IN1_FP8 ? 1 : 2;
constexpr float YSCALE = 64.0f;
constexpr float MSCALE = 32.0f, WCSCALE = 1024.0f;
constexpr float WSCALE = 256.0f, XSCALE = 16.0f, ASCALE = 4.0f;

constexpr size_t MiB = 1u << 20;
constexpr size_t WS_CTL = 0, CTL_ZERO_BYTES = 1 * MiB;
constexpr size_t WS_WEVIN = 1 * MiB;
constexpr size_t WS_WEVOUT = 7 * MiB;
constexpr size_t WS_WODIN = 9 * MiB;
constexpr size_t WS_WCOMB = 15 * MiB;
constexpr size_t WS_WR = 19 * MiB;
constexpr size_t WS_WGU = 20 * MiB;
constexpr size_t WS_WD = 276 * MiB;
constexpr size_t WS_XB = 404 * MiB;
constexpr size_t WS_HB = 468 * MiB;
constexpr size_t WS_R1 = 532 * MiB;
constexpr size_t WS_R2 = 804 * MiB;
constexpr size_t WS_PRE = 1076 * MiB;
constexpr size_t WS_H1 = 1204 * MiB;
constexpr size_t WS_X8 = 1332 * MiB;
constexpr size_t WS_PERM = 1460 * MiB;
constexpr size_t WS_TOKER = 1464 * MiB;
constexpr size_t WS_TOKG = 1465 * MiB;
constexpr size_t WS_CKV = 1466 * MiB;
constexpr size_t WS_IDX = 1474 * MiB;
constexpr size_t WS_END = 1506 * MiB;
constexpr int CW_CNT0 = 64, CW_CNT1 = 128;
constexpr int CW_BAR = 4096;

constexpr int LDS_STAGE = 0, LDS_TAB = 131072, LDS_BIAS = 131072 + 18 * 1024, LDS_INTS = 151552, LDS_MISC = 152576, LDS_BYTES = 153600;

DI unsigned pk_bf16(float lo, float hi) { typedef __bf16 b2 __attribute__((ext_vector_type(2))); f32x2 v = {lo, hi}; b2 b = __builtin_convertvector(v, b2); return __builtin_bit_cast(unsigned, b); }
DI unsigned pk_fp8x4(float a, float b, float c, float d) {
    a = fminf(fmaxf(a, -440.f), 440.f); b = fminf(fmaxf(b, -440.f), 440.f); c = fminf(fmaxf(c, -440.f), 440.f); d = fminf(fmaxf(d, -440.f), 440.f);
    int p = __builtin_amdgcn_cvt_pk_fp8_f32(a, b, 0, false); p = __builtin_amdgcn_cvt_pk_fp8_f32(c, d, p, true); return (unsigned)p; }
DI float bf2f(unsigned short b) { return __uint_as_float(((unsigned)b) << 16); }
DI float bflo(unsigned u) { return __uint_as_float(u << 16); }
DI float bfhi(unsigned u) { return __uint_as_float(u & 0xffff0000u); }
DI float wave_sum(float v) {
#pragma unroll
    for (int o = 1; o < 64; o <<= 1) v += __shfl_xor(v, o);
    return v;
}
DI float fexp2(float x) { return __builtin_amdgcn_exp2f(x); }
DI float frcp(float x) { return __builtin_amdgcn_rcpf(x); }
#define LDS_WAIT() asm volatile("s_waitcnt lgkmcnt(0)" ::: "memory")
#define VM_WAIT() asm volatile("s_waitcnt vmcnt(0)" ::: "memory")

#define XB_TMO      128
#define XB_XCNT(j)  (256  + 64 * (j))
#define XB_XSUB(j)  (1280 + 64 * (j))
#define XB_XGEN(j)  (2304 + 64 * (j))
#define XB_TOP      3328
#define XB_TOPGEN   3392
#define XCD_BAR_WORDS 3456
#define XB_SPIN_CAP (1u << 22)
DI unsigned xb_ld(unsigned* p)              { return __hip_atomic_load(p, __ATOMIC_RELAXED, __HIP_MEMORY_SCOPE_AGENT); }
DI unsigned xb_add(unsigned* p, unsigned v) { return __hip_atomic_fetch_add(p, v, __ATOMIC_RELAXED, __HIP_MEMORY_SCOPE_AGENT); }
DI unsigned xb_xcc_id() { return (unsigned)__builtin_amdgcn_s_getreg((3 << 11) | 20) & 0xFu; }
#define XB_SPIN(cond, bar) do { unsigned _sp = 0; while (cond) { __builtin_amdgcn_s_sleep(1); \
    if ((++_sp & 255u) == 0u) { if (xb_ld(&(bar)[XB_TMO])) break; if (_sp > XB_SPIN_CAP) { atomicAdd(&(bar)[XB_TMO], 1u); break; } } } } while (0)
struct XcdBarrier { unsigned* bar; unsigned x; volatile LAS unsigned* st; };
DI XcdBarrier xcd_barrier_post(unsigned* bar, volatile LAS unsigned* st) {
    XcdBarrier b; b.bar = bar; b.x = xb_xcc_id(); b.st = st;
    if (threadIdx.x == 0) (void)xb_add(&bar[XB_XCNT(b.x)], 1u);
    return b;
}
DI void xcd_barrier_complete(unsigned* bar, unsigned x, unsigned& nloc, unsigned& nx) {
    const unsigned G = gridDim.x * gridDim.y * gridDim.z;
    unsigned sum, cnt, mine, sp = 0u;
    for (;;) {
        sum = 0u; cnt = 0u; mine = 0u;
#pragma unroll
        for (unsigned j = 0; j < 16; ++j) { const unsigned c = xb_ld(&bar[XB_XCNT(j)]); sum += c; cnt += (c > 0u) ? 1u : 0u; mine = (j == x) ? c : mine; }
        if (sum == G) break;
        __builtin_amdgcn_s_sleep(1);
        if ((++sp & 255u) == 0u) { if (xb_ld(&bar[XB_TMO])) break; if (sp > XB_SPIN_CAP) { atomicAdd(&bar[XB_TMO], 1u); break; } }
    }
    nloc = mine > 0u ? mine : 1u; nx = cnt > 0u ? cnt : 1u;
}
DI void xcd_barrier(const XcdBarrier& b) {
    asm volatile("s_waitcnt vmcnt(0)" ::: "memory");
    __syncthreads();
    if (threadIdx.x == 0) {
        unsigned* bar = b.bar;
        __builtin_amdgcn_s_waitcnt(0);
        unsigned nloc = b.st[0], nx = b.st[1];
        if (nloc == 0u) { xcd_barrier_complete(bar, b.x, nloc, nx); b.st[0] = nloc; b.st[1] = nx; }
        const unsigned old = xb_add(&bar[XB_XSUB(b.x)], 1u);
        const unsigned gen = old / nloc;
        if (old + 1u == (gen + 1u) * nloc) {
            __builtin_amdgcn_fence(__ATOMIC_RELEASE, "agent");
            asm volatile("s_waitcnt vmcnt(0)" ::: "memory");
            const unsigned og = xb_add(&bar[XB_TOP], 1u);
            const unsigned tg = og / nx;
            if (og + 1u == (tg + 1u) * nx) xb_add(&bar[XB_TOPGEN], 1u);
            else XB_SPIN(xb_ld(&bar[XB_TOPGEN]) == tg, bar);
            __builtin_amdgcn_fence(__ATOMIC_ACQUIRE, "agent");
            xb_add(&bar[XB_XGEN(b.x)], 1u);
            asm volatile("s_waitcnt vmcnt(0)" ::: "memory");
        } else {
            XB_SPIN(xb_ld(&bar[XB_XGEN(b.x)]) == gen, bar);
            __builtin_amdgcn_fence(__ATOMIC_ACQUIRE, "agent");
            asm volatile("s_waitcnt vmcnt(0)" ::: "memory");
        }
    }
    __syncthreads();
}

namespace pg8 {
constexpr int BM = 256, BK = 64, HALF = 128, HTB = HALF * BK * 2, STAGE_BYTES = 8 * HTB, NXCD = 8, WGM = 8;
__host__ __device__ __forceinline__ int lds_byte(int r, int c) { const int st = (r >> 4) * 2 + (c >> 5), rr = r & 15, cc = c & 31, ob = rr * 64 + cc * 2; return st * 1024 + (ob ^ (((ob >> 9) & 1) << 5)); }
__host__ __device__ __forceinline__ void stage_rc(int b, int& R, int& C) { const int st = b / 1024, sb = b % 1024, swz = sb ^ (((sb >> 9) & 1) << 5); R = (st >> 1) * 16 + swz / 64; C = (st & 1) * 32 + (swz % 64) / 2; }
__host__ __device__ __forceinline__ int perm32(int rho) { const int n = rho >> 4, i = rho & 15; return 8 * (i >> 2) + 4 * n + (i & 3); }

struct Unit { int pm, pn, e, slot; const char* Bp; };

typedef int v4i_t __attribute__((ext_vector_type(4)));
typedef int v8i_t __attribute__((ext_vector_type(8)));
template <class Epi, class Sched, bool FP8 = false>
DI void gemm_phase(LAS unsigned char* lds, const char* Abase, const int RB, const size_t hstepB, const Sched& S, const Epi& E) {
    const int tid = threadIdx.x, wid = __builtin_amdgcn_readfirstlane(tid >> 6), lane = tid & 63, wr = wid >> 2, wc = wid & 3, fr = lane & 15, fq = lane >> 4;
    const int nt = RB / 128;
    int RA[2], CA[2]; unsigned voffB[2];
#pragma unroll
    for (int i = 0; i < 2; ++i) { int R, C; stage_rc(tid * 16 + i * 8192, R, C); const int Rb = Epi::PERM ? ((R & ~31) + perm32(R & 31)) : R;
        RA[i] = R; CA[i] = C; voffB[i] = (unsigned)(Rb * RB + C * 2); }
    const size_t kstep = (size_t)(BK * 2);
    const unsigned ldsw = (unsigned)wid * 1024u;
    const int aoff = lds_byte(wr * 64 + fr, fq * 8), boff = lds_byte(wc * 32 + fr, fq * 8);
#define PG8_SA(b, h) (((b) * 2 + (h)) * HTB)
#define PG8_SB(b, h) ((4 + (b) * 2 + (h)) * HTB)
#define PG8_STAGE(bufoff, gbase, voff) do { _Pragma("unroll") for (int _i = 0; _i < 2; ++_i) \
        __builtin_amdgcn_global_load_lds((const unsigned*)((const char*)(gbase) + (voff)[_i]), (LAS unsigned*)(lds + (bufoff) + ldsw + _i * 8192), 16, 0, 0); } while (0)
#define PG8_LDA(dst, b, h) do { _Pragma("unroll") for (int m = 0; m < 4; ++m) { const v4i_t lo_ = *(const LAS v4i_t*)(lds + PG8_SA(b, h) + aoff + m * 2048), hi_ = *(const LAS v4i_t*)(lds + PG8_SA(b, h) + aoff + m * 2048 + 1024); \
        dst[m] = __builtin_shufflevector(lo_, hi_, 0, 1, 2, 3, 4, 5, 6, 7); } } while (0)
#define PG8_LDB(dst, b, h) do { _Pragma("unroll") for (int n = 0; n < 2; ++n) { const v4i_t lo_ = *(const LAS v4i_t*)(lds + PG8_SB(b, h) + boff + n * 2048), hi_ = *(const LAS v4i_t*)(lds + PG8_SB(b, h) + boff + n * 2048 + 1024); \
        dst[n] = __builtin_shufflevector(lo_, hi_, 0, 1, 2, 3, 4, 5, 6, 7); } } while (0)
#define PG8_LO(x) __builtin_bit_cast(bf16x8, __builtin_shufflevector(x, x, 0, 1, 2, 3))
#define PG8_HI(x) __builtin_bit_cast(bf16x8, __builtin_shufflevector(x, x, 4, 5, 6, 7))
#define PG8_MMA(ai, bj, At, Bt) do { __builtin_amdgcn_s_setprio(1); if constexpr (FP8) asm volatile("s_nop 1"); _Pragma("unroll") for (int m = 0; m < 4; ++m) _Pragma("unroll") for (int n = 0; n < 2; ++n) { \
        if constexpr (!FP8) { acc[ai][bj][m][n] = __builtin_amdgcn_mfma_f32_16x16x32_bf16(PG8_LO(Bt[n]), PG8_LO(At[m]), acc[ai][bj][m][n], 0, 0, 0); \
                              acc[ai][bj][m][n] = __builtin_amdgcn_mfma_f32_16x16x32_bf16(PG8_HI(Bt[n]), PG8_HI(At[m]), acc[ai][bj][m][n], 0, 0, 0); } \
        else asm volatile("v_mfma_f32_16x16x128_f8f6f4 %0, %1, %2, %0" : "+v"(acc[ai][bj][m][n]) : "v"(Bt[n]), "v"(At[m])); } __builtin_amdgcn_s_setprio(0); } while (0)
#define PG8_WAIT_V(n) asm volatile("s_waitcnt vmcnt(" #n ")" ::: "memory")
#define PG8_WAIT_L(n) asm volatile("s_waitcnt lgkmcnt(" #n ")" ::: "memory")
#define PG8_BAR __builtin_amdgcn_s_barrier()
#define PG8_SCHED __builtin_amdgcn_sched_barrier(0)
    Unit cur, nxt; int ui = 0;
    if (!S.next(0, cur)) return;
    f32x4 acc[2][2][4][2];
#pragma unroll
    for (int a = 0; a < 2; ++a)
#pragma unroll
        for (int b = 0; b < 2; ++b)
#pragma unroll
            for (int m = 0; m < 4; ++m)
#pragma unroll
                for (int n = 0; n < 2; ++n) acc[a][b][m][n] = (f32x4){0.f, 0.f, 0.f, 0.f};
    v8i_t At[4], B0[2], B1[2];
    unsigned vC0[2], vC1[2], vN0[2], vN1[2];
    S.arows(cur, RA, CA, vC0, vC1);
    const char* cB = cur.Bp;
    LAS unsigned char* bring = lds + (LDS_BIAS - LDS_STAGE);
    if constexpr (Epi::HAS_BIAS) { if (wid == 0) __builtin_amdgcn_global_load_lds((const unsigned*)E.bias_src(cur, lane), (LAS unsigned*)bring, 16, 0, 0); }
    PG8_STAGE(PG8_SB(0, 0), cB, voffB); PG8_STAGE(PG8_SB(0, 1), cB + hstepB, voffB); PG8_STAGE(PG8_SA(0, 0), Abase, vC0); PG8_STAGE(PG8_SA(0, 1), Abase, vC1);
    if (wr == 1) PG8_BAR;
    PG8_WAIT_V(2); PG8_BAR;
    PG8_STAGE(PG8_SB(1, 0), cB + kstep, voffB); PG8_STAGE(PG8_SA(1, 0), Abase + kstep, vC0); PG8_STAGE(PG8_SB(1, 1), cB + hstepB + kstep, voffB);
    PG8_WAIT_V(6); PG8_BAR;
    for (;;) {
        const bool has_next = S.next(ui + 1, nxt);
        if (has_next) S.arows(nxt, RA, CA, vN0, vN1); else { vN0[0] = vC0[0]; vN0[1] = vC0[1]; vN1[0] = vC1[0]; vN1[1] = vC1[1]; }
        const char* nB = has_next ? nxt.Bp : cB;
#pragma unroll 1
        for (int t = 0; t < nt; t += 2) {
            const bool last = (t == nt - 2);
            if constexpr (Epi::HAS_BIAS) { if (last && has_next && wid == 0) __builtin_amdgcn_global_load_lds((const unsigned*)E.bias_src(nxt, lane), (LAS unsigned*)(bring + ((ui + 1) & 1) * 1024), 16, 0, 0); }
            const char* a1 = Abase + (size_t)(t + 1) * kstep;
            const char* a2 = last ? Abase : Abase + (size_t)(t + 2) * kstep; const char* b2 = last ? nB : cB + (size_t)(t + 2) * kstep;
            const char* a3 = a2 + kstep; const char* b3 = b2 + kstep;
            unsigned v20[2], v21[2];
            v20[0] = last ? vN0[0] : vC0[0]; v20[1] = last ? vN0[1] : vC0[1]; v21[0] = last ? vN1[0] : vC1[0]; v21[1] = last ? vN1[1] : vC1[1];
            PG8_LDB(B0, 0, 0); PG8_LDB(B1, 0, 1); PG8_SCHED; PG8_LDA(At, 0, 0); PG8_STAGE(PG8_SA(1, 1), a1, vC1);
            PG8_WAIT_V(8); PG8_WAIT_L(0); PG8_BAR; PG8_MMA(0, 0, At, B0); PG8_MMA(0, 1, At, B1); PG8_BAR; PG8_SCHED;
            PG8_LDA(At, 0, 1); PG8_STAGE(PG8_SB(0, 0), b2, voffB); PG8_STAGE(PG8_SB(0, 1), b2 + hstepB, voffB); PG8_STAGE(PG8_SA(0, 0), a2, v20);
            PG8_WAIT_V(8); PG8_WAIT_L(0); PG8_BAR; PG8_MMA(1, 0, At, B0); PG8_MMA(1, 1, At, B1); PG8_BAR; PG8_SCHED;
            PG8_LDB(B0, 1, 0); PG8_LDB(B1, 1, 1); PG8_SCHED; PG8_LDA(At, 1, 0); PG8_STAGE(PG8_SA(0, 1), a2, v21);
            PG8_WAIT_V(8); PG8_WAIT_L(0); PG8_BAR; PG8_MMA(0, 0, At, B0); PG8_MMA(0, 1, At, B1); PG8_BAR; PG8_SCHED;
            PG8_LDA(At, 1, 1); PG8_STAGE(PG8_SB(1, 0), b3, voffB); PG8_STAGE(PG8_SB(1, 1), b3 + hstepB, voffB); PG8_STAGE(PG8_SA(1, 0), a3, v20);
            PG8_WAIT_V(8); PG8_WAIT_L(0); PG8_BAR; PG8_MMA(1, 0, At, B0); PG8_MMA(1, 1, At, B1); PG8_BAR; PG8_SCHED;
        }
        if (wr == 0) PG8_BAR;
        if constexpr (FP8) asm volatile("s_nop 15\n\ts_nop 15" ::: "memory");
        E(acc, cur, wr, wc, fr, fq, (const LAS float*)(bring + (ui & 1) * 1024));
#ifdef EPI_TWICE
        asm volatile("" ::: "memory"); E(acc, cur, wr, wc, fr, fq, (const LAS float*)(bring + (ui & 1) * 1024));
#endif
        if (!has_next) break;
#pragma unroll
        for (int a = 0; a < 2; ++a)
#pragma unroll
            for (int b = 0; b < 2; ++b)
#pragma unroll
                for (int m = 0; m < 4; ++m)
#pragma unroll
                    for (int n = 0; n < 2; ++n) acc[a][b][m][n] = (f32x4){0.f, 0.f, 0.f, 0.f};
        cur = nxt; cB = nB; vC0[0] = vN0[0]; vC0[1] = vN0[1]; vC1[0] = vN1[0]; vC1[1] = vN1[1]; ++ui;
        if (wr == 1) PG8_BAR;
    }
    PG8_WAIT_V(0);
    PG8_BAR;
#undef PG8_SA
#undef PG8_SB
#undef PG8_STAGE
#undef PG8_LDA
#undef PG8_LDB
#undef PG8_MMA
#undef PG8_LO
#undef PG8_HI
#undef PG8_WAIT_V
#undef PG8_WAIT_L
#undef PG8_BAR
#undef PG8_SCHED
}

struct PlainSched {
    int nM, nN, nwg, G, c; unsigned lda2; const char* Bt; size_t tstepB;
    DI void init(int M, int N, int K, int lda, const void* Bt_, int G_, int c_, int eb = 2) { nM = M / BM; nN = N / BM; nwg = nM * nN; G = G_; c = c_; lda2 = (unsigned)(lda * eb); Bt = (const char*)Bt_; tstepB = (size_t)BM * K * eb; }
    DI bool next(int i, Unit& u) const {
        const long L = (long)i * G + c; if (L >= nwg) return false;
        int wgid = (int)L; { const int q = nwg / NXCD, r = nwg % NXCD, xcd = wgid % NXCD, off = wgid / NXCD; wgid = (xcd < r ? xcd * (q + 1) : r * (q + 1) + (xcd - r) * q) + off; }
        const int nig = WGM * nN, gid = wgid / nig, fm = gid * WGM, gsz = (nM - fm) < WGM ? (nM - fm) : WGM;
        u.pm = fm + ((wgid % nig) % gsz); u.pn = (wgid % nig) / gsz; u.e = 0; u.slot = i; u.Bp = Bt + (size_t)u.pn * tstepB; return true;
    }
    DI void arows(const Unit& u, const int (&R)[2], const int (&C)[2], unsigned (&v0)[2], unsigned (&v1)[2]) const {
#pragma unroll
        for (int i = 0; i < 2; ++i) { v0[i] = (unsigned)(u.pm * BM + R[i]) * lda2 + (unsigned)C[i] * 2u; v1[i] = (unsigned)(u.pm * BM + HALF + R[i]) * lda2 + (unsigned)C[i] * 2u; }
    }
};
struct MoeSched {
    int to_lane;
    int total, G, c, ntshift; bool gather;
    const LAS unsigned* tab;
    const char* W; size_t wexp, wpn; unsigned rowb;
    DI bool next(int i, Unit& u) const {
        const int per = G >> 3, x = c / per, j = c - x * per, ntile = total >> ntshift, tpx = (ntile + 7) >> 3, tpr = per >> ntshift;
        const int loc = i * tpr + (j >> ntshift), mtg = x * tpx + loc, pn = j & ((1 << ntshift) - 1);
        if (loc >= tpx || mtg >= ntile) return false;
        const int e = __builtin_popcountll(__ballot(to_lane <= mtg));
        u.pm = mtg; u.pn = pn; u.e = e; u.slot = i; u.Bp = W + (size_t)e * wexp + (size_t)pn * wpn; return true;
    }
    DI void arows(const Unit& u, const int (&R)[2], const int (&C)[2], unsigned (&v0)[2], unsigned (&v1)[2]) const {
        if (gather) {
#pragma unroll
            for (int i = 0; i < 2; ++i) { v0[i] = tab[u.slot * 256 + R[i]] + (unsigned)C[i] * 2u; v1[i] = tab[u.slot * 256 + HALF + R[i]] + (unsigned)C[i] * 2u; }
        } else {
#pragma unroll
            for (int i = 0; i < 2; ++i) { v0[i] = (unsigned)(u.pm * BM + R[i]) * rowb + (unsigned)C[i] * 2u; v1[i] = (unsigned)(u.pm * BM + HALF + R[i]) * rowb + (unsigned)C[i] * 2u; }
        }
    }
};

struct EpiProj {
    static constexpr bool PERM = true, HAS_BIAS = false; bf16_t* O; int ldc; float ascale;
    DI void operator()(const f32x4 (&acc)[2][2][4][2], const Unit& u, int wr, int wc, int fr, int fq, const LAS float*) const {
        const int row0 = u.pm * BM + wr * 64 + fr, col0 = u.pn * BM + wc * 32 + 8 * fq;
#pragma unroll
        for (int ai = 0; ai < 2; ++ai)
#pragma unroll
            for (int m = 0; m < 4; ++m) { bf16_t* rowp = O + (size_t)(row0 + ai * HALF + m * 16) * ldc + col0;
#pragma unroll
                for (int bj = 0; bj < 2; ++bj) { const f32x4 v0 = acc[ai][bj][m][0] * ascale, v1 = acc[ai][bj][m][1] * ascale;
                    u32x4 w; w.x = pk_bf16(v0[0], v0[1]); w.y = pk_bf16(v0[2], v0[3]); w.z = pk_bf16(v1[0], v1[1]); w.w = pk_bf16(v1[2], v1[3]);
                    *(u32x4*)(rowp + bj * HALF) = w; } }
    }
};
struct EpiRes {
    static constexpr bool PERM = false, HAS_BIAS = false; const float* res; const bf16_t* resb; bf16_t* out; float ascale;
    DI void operator()(const f32x4 (&acc)[2][2][4][2], const Unit& u, int wr, int wc, int fr, int fq, const LAS float*) const {
        const int row0 = u.pm * BM + wr * 64 + fr, col0 = u.pn * BM + wc * 32 + 4 * fq;
#pragma unroll
        for (int ai = 0; ai < 2; ++ai)
#pragma unroll
            for (int m = 0; m < 4; ++m) { const size_t off = (size_t)(row0 + ai * HALF + m * 16) * D + col0;
#pragma unroll
                for (int bj = 0; bj < 2; ++bj)
#pragma unroll
                    for (int n = 0; n < 2; ++n) { f32x4 r;
                        if (resb) { const u32x2 rb = *(const u32x2*)(resb + off + bj * HALF + n * 16); r = (f32x4){bflo(rb.x), bfhi(rb.x), bflo(rb.y), bfhi(rb.y)}; }
                        else r = *(const f32x4*)(res + off + bj * HALF + n * 16);
                        const f32x4 o = acc[ai][bj][m][n] * ascale + r * ALPHA; u32x2 w; w.x = pk_bf16(o[0], o[1]); w.y = pk_bf16(o[2], o[3]);
                        *(u32x2*)(out + off + bj * HALF + n * 16) = w; } }
    }
};
struct EpiSwiglu {
    static constexpr bool PERM = true, HAS_BIAS = true; unsigned char* O; const float* bgu; float ascale;
    DI const float* bias_src(const Unit& u, int lane) const { return bgu + (size_t)u.e * 2048 + u.pn * HALF + (lane >> 5) * 1024 + 4 * (lane & 31); }
    DI void operator()(const f32x4 (&acc)[2][2][4][2], const Unit& u, int wr, int wc, int fr, int fq, const LAS float* bias) const {
        const int row0 = u.pm * BM + wr * 64 + fr, col0 = u.pn * HALF + wc * 32 + 8 * fq;
        f32x4 bgv[2], buv[2];
#pragma unroll
        for (int n = 0; n < 2; ++n) { bgv[n] = *(const LAS f32x4*)(bias + wc * 32 + 8 * fq + 4 * n); buv[n] = *(const LAS f32x4*)(bias + 128 + wc * 32 + 8 * fq + 4 * n); }
#pragma unroll
        for (int ai = 0; ai < 2; ++ai)
#pragma unroll
            for (int m = 0; m < 4; ++m) { float o[8];
#pragma unroll
                for (int n = 0; n < 2; ++n)
#pragma unroll
                    for (int jj = 0; jj < 2; ++jj) {
                        const f32x2 ag = {acc[ai][0][m][n][2 * jj], acc[ai][0][m][n][2 * jj + 1]}, au = {acc[ai][1][m][n][2 * jj], acc[ai][1][m][n][2 * jj + 1]};
                        const f32x2 bg2 = {bgv[n][2 * jj], bgv[n][2 * jj + 1]}, bu2 = {buv[n][2 * jj], buv[n][2 * jj + 1]};
                        f32x2 g = ag * ascale + bg2, up = au * ascale + bu2;
                        g = __builtin_elementwise_min(g, (f32x2){7.0f, 7.0f});
                        up = __builtin_elementwise_min(__builtin_elementwise_max(up, (f32x2){-7.0f, -7.0f}), (f32x2){7.0f, 7.0f});
                        const f32x2 ex = g * (-1.702f * LOG2E);
                        f32x2 e2; e2.x = fexp2(ex.x); e2.y = fexp2(ex.y);
                        const f32x2 den = e2 + 1.0f;
                        f32x2 sg; sg.x = frcp(den.x); sg.y = frcp(den.y);
                        const f32x2 r = (g * sg) * (up + 1.0f);
                        o[4 * n + 2 * jj] = r.x; o[4 * n + 2 * jj + 1] = r.y; }
                if (!MOE_FP8) { u32x4 w; w.x = pk_bf16(o[0], o[1]); w.y = pk_bf16(o[2], o[3]); w.z = pk_bf16(o[4], o[5]); w.w = pk_bf16(o[6], o[7]);
                    *(u32x4*)(O + ((size_t)(row0 + ai * HALF + m * 16) * DFF + col0) * 2) = w; }
                else { u32x2 w;
                    int p = __builtin_amdgcn_cvt_pk_fp8_f32(o[0] * ASCALE, o[1] * ASCALE, 0, false); p = __builtin_amdgcn_cvt_pk_fp8_f32(o[2] * ASCALE, o[3] * ASCALE, p, true); w.x = (unsigned)p;
                    p = __builtin_amdgcn_cvt_pk_fp8_f32(o[4] * ASCALE, o[5] * ASCALE, 0, false); p = __builtin_amdgcn_cvt_pk_fp8_f32(o[6] * ASCALE, o[7] * ASCALE, p, true); w.y = (unsigned)p;
                    *(u32x2*)(O + (size_t)(row0 + ai * HALF + m * 16) * DFF + col0) = w; } }
    }
};
struct EpiDown {
    static constexpr bool PERM = true, HAS_BIAS = true; unsigned char* O; const float* bd; float ascale;
    DI const float* bias_src(const Unit& u, int lane) const { return bd + (size_t)u.e * 1024 + u.pn * BM + 4 * lane; }
    DI void operator()(const f32x4 (&acc)[2][2][4][2], const Unit& u, int wr, int wc, int fr, int fq, const LAS float* bias) const {
        const int row0 = u.pm * BM + wr * 64 + fr, col0 = u.pn * BM + wc * 32 + 8 * fq;
        f32x4 bv[2][2];
#pragma unroll
        for (int bj = 0; bj < 2; ++bj)
#pragma unroll
            for (int n = 0; n < 2; ++n) bv[bj][n] = *(const LAS f32x4*)(bias + bj * HALF + wc * 32 + 8 * fq + 4 * n) * YSCALE;
        const float as = ascale * YSCALE;
#pragma unroll
        for (int ai = 0; ai < 2; ++ai)
#pragma unroll
            for (int m = 0; m < 4; ++m) { unsigned char* rowp = O + (size_t)(row0 + ai * HALF + m * 16) * D + col0;
#pragma unroll
                for (int bj = 0; bj < 2; ++bj) { const f32x4 v0 = acc[ai][bj][m][0] * as + bv[bj][0], v1 = acc[ai][bj][m][1] * as + bv[bj][1];
                    u32x2 w; w.x = pk_fp8x4(v0[0], v0[1], v0[2], v0[3]); w.y = pk_fp8x4(v1[0], v1[1], v1[2], v1[3]);
                    *(u32x2*)(rowp + bj * HALF) = w; } }
    }
};
}

struct Frame {
    LAS unsigned char* lds;
    gu32* ctl;
    int tid, lane, wave, vcu, G;
    unsigned char* ws;
    const float* in[22];
    float* out;
};
#define WSP(T_, off) ((T_*)(F.ws + (off)))

DI void p0_transpose_item(const float* W, int K, int N, int Nvalid, bf16_t* WT, LAS float* scr, int item, int lane) {
    const int nblk = N / 32, kb = item / nblk, nb = item % nblk, k0 = 64 * kb, n0 = 32 * nb;
    const int n = n0 + (lane & 31); const bool ok = n < Nvalid;
#pragma unroll 8
    for (int i = 0; i < 32; ++i) { const int kk = 2 * i + (lane >> 5); scr[kk * 33 + (lane & 31)] = ok ? W[(size_t)(k0 + kk) * Nvalid + n] : 0.f; }
    LDS_WAIT(); asm volatile("" ::: "memory");
    const int c = lane & 7;
#pragma unroll
    for (int j = 0; j < 4; ++j) { const int nn = (lane >> 3) + 8 * j; const LAS float* s = scr + (8 * c) * 33 + nn;
        u32x4 o; o.x = pk_bf16(s[0 * 33], s[1 * 33]); o.y = pk_bf16(s[2 * 33], s[3 * 33]); o.z = pk_bf16(s[4 * 33], s[5 * 33]); o.w = pk_bf16(s[6 * 33], s[7 * 33]);
        *(GAS u32x4*)(WT + (size_t)(n0 + nn) * K + k0 + 8 * c) = o; }
    LDS_WAIT(); asm volatile("" ::: "memory");
}
struct P0Desc { const float* W; unsigned char* WT; int N, Nvalid, sub, fp8; float scale; };
DI void p0_load(const P0Desc& d, f32x4 (&v)[16], int lane) {
    const int nblk = d.N / 64, kb = d.sub / nblk, nb = d.sub % nblk, k0 = 64 * kb, n0 = 64 * nb;
    const int nn = n0 + 4 * (lane & 15); const bool ok = nn < d.Nvalid;
#pragma unroll
    for (int i = 0; i < 16; ++i) { const int kk = 4 * i + (lane >> 4); v[i] = ok ? __builtin_nontemporal_load((const f32x4*)(d.W + (size_t)(k0 + kk) * d.Nvalid + nn)) : (f32x4){0.f, 0.f, 0.f, 0.f}; }
}
DI void p0_finish(const P0Desc& d, const f32x4 (&v)[16], LAS float* scr, int lane) {
    constexpr int K = 1024;
    const int nblk = d.N / 64, kb = d.sub / nblk, nb = d.sub % nblk, k0 = 64 * kb, n0 = 64 * nb;
#pragma unroll
    for (int i = 0; i < 16; ++i) { const int kk = 4 * i + (lane >> 4); LAS float* p = scr + kk * 65 + 4 * (lane & 15); p[0] = v[i][0]; p[1] = v[i][1]; p[2] = v[i][2]; p[3] = v[i][3]; }
    LDS_WAIT(); asm volatile("" ::: "memory");
    if (!d.fp8) {
        const int c = lane & 7;
#pragma unroll
        for (int j = 0; j < 8; ++j) { const int n = (lane >> 3) + 8 * j; const LAS float* sp = scr + (8 * c) * 65 + n;
            u32x4 o; o.x = pk_bf16(sp[0], sp[65]); o.y = pk_bf16(sp[2 * 65], sp[3 * 65]); o.z = pk_bf16(sp[4 * 65], sp[5 * 65]); o.w = pk_bf16(sp[6 * 65], sp[7 * 65]);
            *(GAS u32x4*)(d.WT + ((size_t)(n0 + n) * K + k0 + 8 * c) * 2) = o; }
    } else {
        const int c = lane & 3; const float ws = d.scale;
#pragma unroll
        for (int j = 0; j < 4; ++j) { const int n = (lane >> 2) + 16 * j; const LAS float* sp = scr + (16 * c) * 65 + n;
            u32x4 o;
#pragma unroll
            for (int q = 0; q < 4; ++q) { int p = __builtin_amdgcn_cvt_pk_fp8_f32(sp[(4 * q) * 65] * ws, sp[(4 * q + 1) * 65] * ws, 0, false);
                p = __builtin_amdgcn_cvt_pk_fp8_f32(sp[(4 * q + 2) * 65] * ws, sp[(4 * q + 3) * 65] * ws, p, true); o[q] = (unsigned)p; }
            *(GAS u32x4*)(d.WT + (size_t)(n0 + n) * K + k0 + 16 * c) = o; }
    }
    LDS_WAIT(); asm volatile("" ::: "memory");
}
DI void p0_prologue(Frame& F) {
    LAS float* scr = (LAS float*)(F.lds + F.wave * 16896);
    const int gw = F.vcu * NWAVES + F.wave, NGW = F.G * NWAVES;
    constexpr int I_GU = 16 * 32, I_DN = 16 * 16, I_EVIN = 16 * 48, I_EVOUT = 16 * 16, I_ODIN = 16 * 44;
    constexpr int N_GU = 64 * I_GU, N_DN = 64 * I_DN;
    constexpr int NITEMS = N_GU + N_DN + I_EVIN + I_EVOUT + I_ODIN;
    auto desc = [&](int it) -> P0Desc { P0Desc d; int r = it;
        if (r < N_GU) { const int mtx = r / I_GU; d.W = F.in[16] + (size_t)mtx * 1024 * 2048; d.WT = WSP(unsigned char, WS_WGU) + (size_t)mtx * 2048 * 1024 * MOE_EB; d.N = 2048; d.Nvalid = 2048; d.sub = r % I_GU; d.fp8 = MOE_FP8; d.scale = WSCALE; return d; } r -= N_GU;
        if (r < N_DN) { const int mtx = r / I_DN; d.W = F.in[18] + (size_t)mtx * 1024 * 1024; d.WT = WSP(unsigned char, WS_WD) + (size_t)mtx * 1024 * 1024 * MOE_EB; d.N = 1024; d.Nvalid = 1024; d.sub = r % I_DN; d.fp8 = MOE_FP8; d.scale = WSCALE; return d; } r -= N_DN;
        if (r < I_EVIN) { d.W = F.in[1]; d.WT = WSP(unsigned char, WS_WEVIN); d.N = EV_COLS; d.Nvalid = EV_COLS; d.sub = r; d.fp8 = IN_FP8; d.scale = WSCALE; return d; } r -= I_EVIN;
        if (r < I_EVOUT) { d.W = F.in[2]; d.WT = WSP(unsigned char, WS_WEVOUT); d.N = 1024; d.Nvalid = 1024; d.sub = r; d.fp8 = PLAIN_FP8; d.scale = WSCALE; return d; } r -= I_EVOUT;
        d.W = F.in[8]; d.WT = WSP(unsigned char, WS_WODIN); d.N = OD_COLS_P; d.Nvalid = OD_COLS; d.sub = r; d.fp8 = IN1_FP8; d.scale = WSCALE; return d; };
    {
        int it = gw; P0Desc d0, d1; f32x4 v0[16], v1[16];
        if (it < NITEMS) { d0 = desc(it); p0_load(d0, v0, F.lane); }
        while (it < NITEMS) {
            const int itn = it + NGW; const bool more = itn < NITEMS;
            if (more) { d1 = desc(itn); p0_load(d1, v1, F.lane); }
            p0_finish(d0, v0, scr, F.lane);
            if (more) { d0 = d1;
#pragma unroll
                for (int i = 0; i < 16; ++i) v0[i] = v1[i]; }
            it = itn;
        }
    }
    for (int it = gw; it < 32; it += NGW) { const int l = it >> 4; p0_transpose_item(F.in[14] + (size_t)l * 1024 * 32, 1024, 32, 32, WSP(bf16_t, WS_WR) + (size_t)l * 32 * 1024, scr, it & 15, F.lane); }
    {
        const float* wuv = F.in[10]; const float* wout = F.in[11]; bf16_t* wc = WSP(bf16_t, WS_WCOMB); unsigned char* wc8 = WSP(unsigned char, WS_WCOMB);
        for (int it = gw; it < 16 * 512; it += NGW) {
            const int nb = it & 15, kq = __builtin_amdgcn_readfirstlane(it >> 4), k0 = 4 * kq, h = k0 >> 7, n = 64 * nb + F.lane;
            const float* b = wout + (size_t)(h * 64) * 1024 + n; const float* a = wuv + (size_t)k0 * 64;
            float sv[4] = {0.f, 0.f, 0.f, 0.f};
#pragma unroll 32
            for (int d = 0; d < 64; ++d) { const float bv = b[(size_t)d * 1024];
#pragma unroll
                for (int q = 0; q < 4; ++q) sv[q] += a[q * 64 + d] * bv; }
            if (PLAIN_FP8) *(unsigned*)(wc8 + (size_t)n * 2048 + k0) = pk_fp8x4(sv[0] * WCSCALE, sv[1] * WCSCALE, sv[2] * WCSCALE, sv[3] * WCSCALE);
            else { u32x2 w2; w2.x = pk_bf16(sv[0], sv[1]); w2.y = pk_bf16(sv[2], sv[3]); *(u32x2*)(wc + (size_t)n * 2048 + k0) = w2; }
        }
    }
    {
        const float* x = F.in[0]; bf16_t* xb = WSP(bf16_t, WS_XB); unsigned char* x8 = WSP(unsigned char, WS_X8);
        const size_t gt = (size_t)F.vcu * NTHR + F.tid, NGT = (size_t)F.G * NTHR;
        for (size_t o = gt; o < (size_t)T * D / 8; o += 4 * NGT) {
            f32x4 a[4], b[4];
#pragma unroll
            for (int u = 0; u < 4; ++u) { const size_t oo = o + u * NGT; if (oo < (size_t)T * D / 8) { a[u] = __builtin_nontemporal_load((const f32x4*)(x + oo * 8)); b[u] = __builtin_nontemporal_load((const f32x4*)(x + oo * 8 + 4)); } }
#pragma unroll
            for (int u = 0; u < 4; ++u) { const size_t oo = o + u * NGT; if (oo >= (size_t)T * D / 8) break;
                if (IN_FP8) { u32x2 w; w.x = pk_fp8x4(a[u][0] * XSCALE, a[u][1] * XSCALE, a[u][2] * XSCALE, a[u][3] * XSCALE); w.y = pk_fp8x4(b[u][0] * XSCALE, b[u][1] * XSCALE, b[u][2] * XSCALE, b[u][3] * XSCALE); *(u32x2*)(x8 + oo * 8) = w; }
                else { u32x4 w; w.x = pk_bf16(a[u][0], a[u][1]); w.y = pk_bf16(a[u][2], a[u][3]); w.z = pk_bf16(b[u][0], b[u][1]); w.w = pk_bf16(b[u][2], b[u][3]); *(u32x4*)(xb + oo * 8) = w; } }
        }
    }
}

namespace att0 {
constexpr int KP = 144, VP_SB = 144, VP_DF = 288;
constexpr int BUF = 64 * KP + 64 * VP_DF;
constexpr int PITCH = EV_COLS;
DI int crow(int i, int hh) { return (i & 3) + 8 * (i >> 2) + 4 * hh; }
DI bf16x8 pack8(const f32x16& p, int s) {
    u32x4 w; w.x = pk_bf16(p[8 * s], p[8 * s + 1]); w.y = pk_bf16(p[8 * s + 2], p[8 * s + 3]); w.z = pk_bf16(p[8 * s + 4], p[8 * s + 5]); w.w = pk_bf16(p[8 * s + 6], p[8 * s + 7]);
    return __builtin_bit_cast(bf16x8, w);
}
DI s16x4 trrd(const LAS unsigned char* p) { typedef short v4i16_t __attribute__((ext_vector_type(4))); return __builtin_bit_cast(s16x4, __builtin_amdgcn_ds_read_tr16_b64_v4i16((LAS v4i16_t*)p)); }
DI f32x16 qk32(const LAS unsigned char* kb, const bf16x8 (&qf)[4], int lane, f32x16 p = f32x16{}) {
    const LAS unsigned char* kp = kb + (lane & 31) * KP + (lane >> 5) * 16;
#pragma unroll
    for (int s = 0; s < 4; ++s) { const bf16x8 a = *(const LAS bf16x8*)(kp + s * 32); p = __builtin_amdgcn_mfma_f32_32x32x16_bf16(a, qf[s], p, 0, 0, 0); }
    return p;
}
DI const LAS unsigned char* vtlane(const LAS unsigned char* vb, int pitch, int lane) {
    const int hh = lane >> 5, blk = (lane >> 4) & 1, q = (lane & 15) >> 2, p = lane & 3;
    return vb + (4 * hh + q) * pitch + (16 * blk + 4 * p) * 2;
}
DI bf16x8 vtfrag(const LAS unsigned char* vl, int pitch, int c, int rbase) {
    const s16x4 lo = trrd(vl + rbase * pitch + 64 * c), hi = trrd(vl + (rbase + 8) * pitch + 64 * c);
    return __builtin_shufflevector(lo, hi, 0, 1, 2, 3, 4, 5, 6, 7);
}
template <int VD> struct StageRegs { u32x4 k; u32x4 v[VD / 64]; };
template <int VD> DI void stage_load(StageRegs<VD>& r, const bf16_t* proj, int b, int kt, int colK, int colV, int tid) {
    const size_t rowb = (size_t)(b * SEQ + kt * 64);
    r.k = *(const u32x4*)(proj + (rowb + (tid >> 3)) * PITCH + colK + (tid & 7) * 8);
    if (VD == 64) r.v[0] = *(const u32x4*)(proj + (rowb + (tid >> 3)) * PITCH + colV + (tid & 7) * 8);
    else {
#pragma unroll
        for (int j = 0; j < VD / 64; ++j) { const int idx = tid + 512 * j; r.v[j] = *(const u32x4*)(proj + (rowb + (idx >> 4)) * PITCH + colV + (idx & 15) * 8); }
    }
}
template <int VD> DI void stage_write(const StageRegs<VD>& r, LAS unsigned char* buf, int tid) {
    constexpr int VP = VD == 64 ? VP_SB : VP_DF;
    *(LAS u32x4*)(buf + (tid >> 3) * KP + (tid & 7) * 16) = r.k;
    if (VD == 64) *(LAS u32x4*)(buf + 64 * KP + (tid >> 3) * VP + (tid & 7) * 16) = r.v[0];
    else {
#pragma unroll
        for (int j = 0; j < VD / 64; ++j) { const int idx = tid + 512 * j; *(LAS u32x4*)(buf + 64 * KP + (idx >> 4) * VP + (idx & 15) * 16) = r.v[j]; }
    }
}

DI void sb_unit(Frame& F, int b, int h, int qt, const bf16_t* proj, bf16_t* mix) {
    const int tid = F.tid, lane = F.lane, w = F.wave, hh = lane >> 5;
    LAS unsigned char* lds = F.lds;
    volatile LAS int* votes = (volatile LAS int*)(F.lds + LDS_INTS) + 160;
    const int q0 = qt * 256, tw = q0 + 32 * w, t = tw + (lane & 31);
    const int colQ = h * 64, colK = 512 + h * 64, colV = 1024 + h * 64;
    bf16x8 qf[4];
    { const bf16_t* qp = proj + (size_t)(b * SEQ + t) * PITCH + colQ + hh * 8;
#pragma unroll
      for (int s = 0; s < 4; ++s) qf[s] = *(const bf16x8*)(qp + 16 * s); }
    f32x16 O[2]; O[0] = f32x16{}; O[1] = f32x16{};
    float carry = 1.0f;
    int kt = qt * 4 + 3, it = 0;
    StageRegs<64> sr, sn;
    stage_load<64>(sr, proj, b, kt, colK, colV, tid);
    stage_write<64>(sr, lds, tid);
    if (kt > 0) stage_load<64>(sr, proj, b, kt - 1, colK, colV, tid);
    __syncthreads();
    for (;;) {
        const bool more = kt > 0;
        if (kt > 1) stage_load<64>(sn, proj, b, kt - 2, colK, colV, tid);
        const LAS unsigned char* kb = lds + (it & 1) * BUF; const LAS unsigned char* vb = vtlane(kb + 64 * KP, VP_SB, lane);
#pragma unroll
        for (int kbi = 1; kbi >= 0; --kbi) {
            const int key0 = kt * 64 + kbi * 32;
            if (key0 < tw + 31 && __ballot(carry > 0.0f) != 0ull) {
                f32x16 S = qk32(kb + kbi * 32 * KP, qf, lane);
                f32x16 beta, kp;
#pragma unroll
                for (int i = 0; i < 16; ++i) {
                    const int key = key0 + crow(i, hh);
                    float z = fmaxf(S[i] * 0.125f, -30.0f);
                    const float e = fexp2(-z * LOG2E), r = frcp(1.0f + e);
                    const bool valid = key < t;
                    beta[i] = valid ? r : 0.0f; kp[i] = valid ? e * r : 1.0f;
                }
                float a[4], bb[4], wgt[16];
#pragma unroll
                for (int m = 0; m < 4; ++m) { const float k0 = kp[4 * m], k1 = kp[4 * m + 1], k2 = kp[4 * m + 2], k3 = kp[4 * m + 3];
                    wgt[4 * m + 3] = 1.0f; wgt[4 * m + 2] = k3; wgt[4 * m + 1] = k3 * k2; wgt[4 * m] = wgt[4 * m + 1] * k1; a[m] = wgt[4 * m] * k0; }
#pragma unroll
                for (int m = 0; m < 4; ++m) bb[m] = __shfl_xor(a[m], 32);
                float run = carry; f32x16 P;
#pragma unroll
                for (int m = 3; m >= 0; --m) { const float SG = hh ? run : run * bb[m];
#pragma unroll
                    for (int j = 0; j < 4; ++j) P[4 * m + j] = beta[4 * m + j] * (SG * wgt[4 * m + j]);
                    run = run * (a[m] * bb[m]); }
                carry = run;
                const bf16x8 p0 = pack8(P, 0), p1 = pack8(P, 1);
                { const bf16x8 v00 = vtfrag(vb, VP_SB, 0, kbi * 32), v10 = vtfrag(vb, VP_SB, 1, kbi * 32), v01 = vtfrag(vb, VP_SB, 0, kbi * 32 + 16), v11 = vtfrag(vb, VP_SB, 1, kbi * 32 + 16);
                  O[0] = __builtin_amdgcn_mfma_f32_32x32x16_bf16(v00, p0, O[0], 0, 0, 0); O[1] = __builtin_amdgcn_mfma_f32_32x32x16_bf16(v10, p0, O[1], 0, 0, 0);
                  O[0] = __builtin_amdgcn_mfma_f32_32x32x16_bf16(v01, p1, O[0], 0, 0, 0); O[1] = __builtin_amdgcn_mfma_f32_32x32x16_bf16(v11, p1, O[1], 0, 0, 0); }
            }
        }
        if (more) stage_write<64>(sr, lds + ((it + 1) & 1) * BUF, tid);
        const bool act = __ballot(carry > 0.0f) != 0ull;
        if (lane == 0) votes[(it & 1) * 8 + w] = act ? 1 : 0;
        __syncthreads();
        if (!more) break;
        int any = 0;
#pragma unroll
        for (int j = 0; j < 8; ++j) any |= votes[(it & 1) * 8 + j];
        if (!any) break;
        --kt; ++it; sr = sn;
    }
    if (PLAIN_FP8) { unsigned char* op = (unsigned char*)mix + (size_t)(b * SEQ + t) * D + h * 64;
#pragma unroll
        for (int c = 0; c < 2; ++c)
#pragma unroll
            for (int m = 0; m < 4; ++m) *(unsigned*)(op + 32 * c + 8 * m + 4 * hh) = pk_fp8x4(O[c][4 * m] * MSCALE, O[c][4 * m + 1] * MSCALE, O[c][4 * m + 2] * MSCALE, O[c][4 * m + 3] * MSCALE);
    } else { bf16_t* op = mix + (size_t)(b * SEQ + t) * D + h * 64;
#pragma unroll
        for (int c = 0; c < 2; ++c)
#pragma unroll
            for (int m = 0; m < 4; ++m) { u32x2 wv; wv.x = pk_bf16(O[c][4 * m], O[c][4 * m + 1]); wv.y = pk_bf16(O[c][4 * m + 2], O[c][4 * m + 3]);
                *(u32x2*)(op + 32 * c + 8 * m + 4 * hh) = wv; } }
}

DI void diff_unit(Frame& F, int b, int hb, int qt, const bf16_t* proj, bf16_t* mix, float lam, const float* subln) {
    const int tid = F.tid, lane = F.lane, w = F.wave, hh = lane >> 5;
    LAS unsigned char* lds = F.lds;
    const int q0 = qt * 256, tw = q0 + 32 * w, t = tw + (lane & 31);
    const int colV = 2560 + hb * 128;
    const float slope2 = fexp2(-2.0f * (float)(hb + 1)) * LOG2E, sc2 = 0.125f * LOG2E;
    const int ntiles = qt * 4 + 4;
#pragma unroll 1
    for (int cm = 0; cm < 2; ++cm) {
        const int colQ = 1536 + hb * 128 + cm * 64, colK = 2048 + hb * 128 + cm * 64;
        bf16x8 qf[4];
        { const bf16_t* qp = proj + (size_t)(b * SEQ + t) * PITCH + colQ + hh * 8;
#pragma unroll
          for (int s = 0; s < 4; ++s) { const u32x4 raw = *(const u32x4*)(qp + 16 * s); u32x4 sc;
#pragma unroll
              for (int e = 0; e < 4; ++e) sc[e] = pk_bf16(bflo(raw[e]) * sc2, bfhi(raw[e]) * sc2);
              qf[s] = __builtin_bit_cast(bf16x8, sc); } }
        f32x16 O[4];
#pragma unroll
        for (int c = 0; c < 4; ++c) O[c] = f32x16{};
        float mref = 0.0f, lrun = 0.0f;
        StageRegs<128> sr;
        __syncthreads();
        stage_load<128>(sr, proj, b, ntiles - 1, colK, colV, tid);
        stage_write<128>(sr, lds, tid);
        __syncthreads();
        const int kd = tw >> 6;
#pragma unroll 1
        for (int it = 0; it < ntiles; ++it) {
            const int kt = ntiles - 1 - it;
            const bool more = kt > 0;
            if (more) stage_load<128>(sr, proj, b, kt - 1, colK, colV, tid);
            const LAS unsigned char* kb = lds + (it & 1) * BUF; const LAS unsigned char* vb = vtlane(kb + 64 * KP, VP_DF, lane);
            if (kt <= kd) {
                const float cl = slope2 * (float)(64 * kt + 4 * hh - t);
                f32x16 C0, C1;
#pragma unroll
                for (int i = 0; i < 16; ++i) { const float bi = slope2 * (float)((i & 3) + 8 * (i >> 2)); C0[i] = cl + bi; C1[i] = cl + (bi + 32.0f * slope2); }
                f32x16 S0 = C0, S1 = C1;
                { const LAS unsigned char* kp = kb + (lane & 31) * KP + (lane >> 5) * 16;
#pragma unroll
                  for (int s4 = 0; s4 < 4; ++s4) { const bf16x8 a0 = *(const LAS bf16x8*)(kp + s4 * 32), a1 = *(const LAS bf16x8*)(kp + 32 * KP + s4 * 32);
                      S0 = __builtin_amdgcn_mfma_f32_32x32x16_bf16(a0, qf[s4], S0, 0, 0, 0); S1 = __builtin_amdgcn_mfma_f32_32x32x16_bf16(a1, qf[s4], S1, 0, 0, 0); } }
                float mx;
                if (kt == kd) {
#pragma unroll
                    for (int i = 0; i < 16; ++i) { const int k0 = kt * 64 + crow(i, hh);
                        S0[i] = (k0 <= t) ? S0[i] : -INFINITY; S1[i] = (k0 + 32 <= t) ? S1[i] : -INFINITY; }
                }
                mx = fmaxf(S0[0], S1[0]);
#pragma unroll
                for (int i = 1; i < 16; ++i) mx = fmaxf(mx, fmaxf(S0[i], S1[i]));
                mx = fmaxf(mx, __shfl_xor(mx, 32));
                if (kt == kd) mref = mx;
                else if (__ballot(mx > mref + 8.0f) != 0ull) {
                    const float mnew = fmaxf(mref, mx), al = fexp2(mref - mnew); mref = mnew; lrun *= al;
#pragma unroll
                    for (int c = 0; c < 4; ++c)
#pragma unroll
                        for (int i = 0; i < 16; ++i) O[c][i] *= al;
                }
                if (__ballot(mx > mref - 150.0f) != 0ull) {
                float ls = 0.f;
#pragma unroll
                for (int i = 0; i < 16; ++i) { S0[i] = fexp2(S0[i] - mref); S1[i] = fexp2(S1[i] - mref); ls += S0[i] + S1[i]; }
                lrun += ls;
                const bf16x8 p0 = pack8(S0, 0), p1 = pack8(S0, 1), p2 = pack8(S1, 0), p3 = pack8(S1, 1);
#define DF_PVSTEP(row_, p_) do { const bf16x8 f0_ = vtfrag(vb, VP_DF, 0, (row_)), f1_ = vtfrag(vb, VP_DF, 1, (row_)), f2_ = vtfrag(vb, VP_DF, 2, (row_)), f3_ = vtfrag(vb, VP_DF, 3, (row_)); \
                    O[0] = __builtin_amdgcn_mfma_f32_32x32x16_bf16(f0_, (p_), O[0], 0, 0, 0); O[1] = __builtin_amdgcn_mfma_f32_32x32x16_bf16(f1_, (p_), O[1], 0, 0, 0); \
                    O[2] = __builtin_amdgcn_mfma_f32_32x32x16_bf16(f2_, (p_), O[2], 0, 0, 0); O[3] = __builtin_amdgcn_mfma_f32_32x32x16_bf16(f3_, (p_), O[3], 0, 0, 0); __builtin_amdgcn_sched_barrier(0); } while (0)
                DF_PVSTEP(0, p0); DF_PVSTEP(16, p1); DF_PVSTEP(32, p2); DF_PVSTEP(48, p3);
#undef DF_PVSTEP
                }
            }
            if (more) stage_write<128>(sr, lds + ((it + 1) & 1) * BUF, tid);
            __syncthreads();
        }
        const float ltot = lrun + __shfl_xor(lrun, 32);
        const float inv = 1.0f / ltot;
        LAS unsigned char* stash = lds + 2 * BUF + w * 8192 + lane * 16;
        if (cm == 0) {
#pragma unroll
            for (int c = 0; c < 4; ++c)
#pragma unroll
                for (int hf = 0; hf < 2; ++hf) { u32x4 pw;
                    pw.x = pk_bf16(O[c][8 * hf] * inv, O[c][8 * hf + 1] * inv); pw.y = pk_bf16(O[c][8 * hf + 2] * inv, O[c][8 * hf + 3] * inv);
                    pw.z = pk_bf16(O[c][8 * hf + 4] * inv, O[c][8 * hf + 5] * inv); pw.w = pk_bf16(O[c][8 * hf + 6] * inv, O[c][8 * hf + 7] * inv);
                    *(LAS u32x4*)(stash + (2 * c + hf) * 1024) = pw; }
        } else {
            const float li = lam * inv; float ss = 0.f;
#pragma unroll
            for (int c = 0; c < 4; ++c)
#pragma unroll
                for (int hf = 0; hf < 2; ++hf) { const u32x4 pw = *(const LAS u32x4*)(stash + (2 * c + hf) * 1024);
#pragma unroll
                    for (int q = 0; q < 4; ++q) { const float r0 = bflo(pw[q]) - li * O[c][8 * hf + 2 * q], r1 = bfhi(pw[q]) - li * O[c][8 * hf + 2 * q + 1]; ss += r0 * r0 + r1 * r1; } }
            ss += __shfl_xor(ss, 32);
            const float rs = 0.8f / sqrtf(ss * (1.0f / 128.0f) + RMS_EPS);
            bf16_t* op = mix + (size_t)(b * SEQ + t) * D + 512 + hb * 128;
#pragma unroll
            for (int c = 0; c < 4; ++c)
#pragma unroll
                for (int hf = 0; hf < 2; ++hf) { const u32x4 pw = *(const LAS u32x4*)(stash + (2 * c + hf) * 1024);
#pragma unroll
                    for (int mm = 0; mm < 2; ++mm) { const int m = 2 * hf + mm, d0 = 32 * c + 8 * m + 4 * hh; const f32x4 g = *(const f32x4*)(subln + d0);
                        const float r0 = bflo(pw[2 * mm]) - li * O[c][4 * m], r1 = bfhi(pw[2 * mm]) - li * O[c][4 * m + 1], r2 = bflo(pw[2 * mm + 1]) - li * O[c][4 * m + 2], r3 = bfhi(pw[2 * mm + 1]) - li * O[c][4 * m + 3];
                        if (PLAIN_FP8) *(unsigned*)((unsigned char*)mix + (size_t)(b * SEQ + t) * D + 512 + hb * 128 + d0) = pk_fp8x4(r0 * rs * g[0] * MSCALE, r1 * rs * g[1] * MSCALE, r2 * rs * g[2] * MSCALE, r3 * rs * g[3] * MSCALE);
                        else { u32x2 wv; wv.x = pk_bf16(r0 * rs * g[0], r1 * rs * g[1]); wv.y = pk_bf16(r2 * rs * g[2], r3 * rs * g[3]); *(u32x2*)(op + d0) = wv; } } }
        }
    }
}

DI void phase(Frame& F) {
    const bf16_t* proj = WSP(bf16_t, WS_R1); bf16_t* mix = WSP(bf16_t, WS_R2);
    float lam;
    { const float a = F.in[3][F.lane] * F.in[4][F.lane], c = F.in[5][F.lane] * F.in[6][F.lane];
      lam = expf(wave_sum(a)) - expf(wave_sum(c)) + 0.2f; }
    const float* subln = F.in[7];
    const int j = F.vcu;
#ifndef NO_DIFF
    for (int L = j; L < 256; L += F.G) {
#pragma unroll 1
        for (int rep = 0; rep < 2; ++rep) { const int L2 = rep ? 511 - L : L, qt = 7 - (L2 >> 6), bh = L2 & 63; diff_unit(F, bh >> 2, bh & 3, qt, proj, mix, lam, subln); }
    }
#endif
#ifndef NO_SB
    for (int L = j; L < 1024; L += F.G) {
        const int qt = 7 - (L >> 7), bh = L & 127;
        __syncthreads();
        sb_unit(F, bh >> 3, bh & 7, qt, proj, mix);
    }
#endif
    __syncthreads();
}
}

namespace lnr {
constexpr int WP = 2064;
DI void phase(Frame& F, int layer) {
    const int lane = F.lane, w = F.wave, tid = F.tid;
    const bf16_t* pre = WSP(bf16_t, WS_PRE); bf16_t* h1 = WSP(bf16_t, WS_H1); bf16_t* hb = WSP(bf16_t, WS_HB);
    const float* g = F.in[12] + layer * D; const float* bta = F.in[13] + layer * D; const float* rb = F.in[15] + layer * NEXP;
    const bf16_t* wr = WSP(bf16_t, WS_WR) + (size_t)layer * NEXP * D;
    unsigned* cnt = (unsigned*)(F.ctl + (layer ? CW_CNT1 : CW_CNT0));
    int* perm = WSP(int, WS_PERM); int* toker = WSP(int, WS_TOKER); float* tokg = WSP(float, WS_TOKG);
    LAS unsigned char* wl = F.lds;
    LAS float* gl = (LAS float*)(F.lds + 32 * WP);
    LAS int* ints = (LAS int*)(F.lds + LDS_INTS);
    LAS int* hist = ints + 96; LAS int* base = ints + 128;
    for (int i = tid; i < 32 * 128; i += NTHR) { const int r = i >> 7, c = i & 127; *(LAS u32x4*)(wl + r * WP + c * 16) = *(const u32x4*)(wr + (size_t)r * D + c * 8); }
    for (int i = tid; i < D; i += NTHR) { gl[i] = g[i]; gl[D + i] = bta[i]; }
    for (int ub = F.vcu; ub < T / 128; ub += F.G) {
        if (tid < 32) hist[tid] = 0;
        __syncthreads();
        const int r0 = ub * 128 + w * 16;
        float mean_l, rstd_l;
        { const bf16_t* rp = pre + (size_t)(r0 + (lane & 15)) * D + 8 * (lane >> 4);
          float s1 = 0.f, s2 = 0.f;
#pragma unroll 8
          for (int s = 0; s < 32; ++s) { const u32x4 xx = *(const u32x4*)(rp + 32 * s);
#pragma unroll
              for (int e = 0; e < 4; ++e) { const float a = bflo(xx[e]), c = bfhi(xx[e]); s1 += a + c; s2 += a * a + c * c; } }
          s1 += __shfl_xor(s1, 16); s2 += __shfl_xor(s2, 16); s1 += __shfl_xor(s1, 32); s2 += __shfl_xor(s2, 32);
          mean_l = s1 * (1.0f / D);
          const float var = fmaxf(s2 * (1.0f / D) - mean_l * mean_l, 0.0f);
          rstd_l = 1.0f / sqrtf(var + LN_EPS); }
        const int tok = lane & 15, q = lane >> 4; const size_t row = (size_t)(r0 + tok);
        f32x4 acc0 = {0.f, 0.f, 0.f, 0.f}, acc1 = {0.f, 0.f, 0.f, 0.f};
#pragma unroll 2
        for (int s = 0; s < 32; ++s) {
            const int k0 = 32 * s + 8 * q;
            const u32x4 xx = *(const u32x4*)(pre + row * D + k0);
            const f32x4 xa = {bflo(xx.x), bfhi(xx.x), bflo(xx.y), bfhi(xx.y)}, xb = {bflo(xx.z), bfhi(xx.z), bflo(xx.w), bfhi(xx.w)};
            const f32x4 ga = *(const LAS f32x4*)(gl + k0), gb = *(const LAS f32x4*)(gl + k0 + 4), ba = *(const LAS f32x4*)(gl + D + k0), bb = *(const LAS f32x4*)(gl + D + k0 + 4);
            const f32x4 ya = (xa - mean_l) * rstd_l * ga + ba, yb = (xb - mean_l) * rstd_l * gb + bb;
            u32x4 pw; pw.x = pk_bf16(ya[0], ya[1]); pw.y = pk_bf16(ya[2], ya[3]); pw.z = pk_bf16(yb[0], yb[1]); pw.w = pk_bf16(yb[2], yb[3]);
            *(u32x4*)(h1 + row * D + k0) = pw;
            if (!MOE_FP8) *(u32x4*)(hb + row * D + k0) = pw;
            else { u32x2 w8; const f32x4 za = ya * XSCALE, zb = yb * XSCALE;
                int p = __builtin_amdgcn_cvt_pk_fp8_f32(fminf(fmaxf(za[0], -440.f), 440.f), fminf(fmaxf(za[1], -440.f), 440.f), 0, false); p = __builtin_amdgcn_cvt_pk_fp8_f32(fminf(fmaxf(za[2], -440.f), 440.f), fminf(fmaxf(za[3], -440.f), 440.f), p, true); w8.x = (unsigned)p;
                p = __builtin_amdgcn_cvt_pk_fp8_f32(fminf(fmaxf(zb[0], -440.f), 440.f), fminf(fmaxf(zb[1], -440.f), 440.f), 0, false); p = __builtin_amdgcn_cvt_pk_fp8_f32(fminf(fmaxf(zb[2], -440.f), 440.f), fminf(fmaxf(zb[3], -440.f), 440.f), p, true); w8.y = (unsigned)p;
                *(u32x2*)((unsigned char*)hb + row * D + k0) = w8; }
            const bf16x8 bfrag = __builtin_bit_cast(bf16x8, pw);
            const bf16x8 a0 = *(const LAS bf16x8*)(wl + tok * WP + k0 * 2), a1 = *(const LAS bf16x8*)(wl + (16 + tok) * WP + k0 * 2);
            acc0 = __builtin_amdgcn_mfma_f32_16x16x32_bf16(a0, bfrag, acc0, 0, 0, 0);
            acc1 = __builtin_amdgcn_mfma_f32_16x16x32_bf16(a1, bfrag, acc1, 0, 0, 0);
        }
        float v[8];
#pragma unroll
        for (int i = 0; i < 4; ++i) { v[i] = acc0[i] + rb[4 * q + i]; v[4 + i] = acc1[i] + rb[16 + 4 * q + i]; }
        float tv[4]; int te[4];
#pragma unroll
        for (int k = 0; k < 4; ++k) {
            float bv = v[0]; int be = 4 * q;
#pragma unroll
            for (int i = 1; i < 8; ++i) { const int ee = (i < 4) ? 4 * q + i : 16 + 4 * q + (i - 4); if (v[i] > bv) { bv = v[i]; be = ee; } }
#pragma unroll
            for (int o = 16; o <= 32; o <<= 1) { const float ov = __shfl_xor(bv, o); const int oe = __shfl_xor(be, o); if (ov > bv || (ov == bv && oe < be)) { bv = ov; be = oe; } }
            tv[k] = bv; te[k] = be;
#pragma unroll
            for (int i = 0; i < 8; ++i) { const int ee = (i < 4) ? 4 * q + i : 16 + 4 * q + (i - 4); if (ee == be) v[i] = -INFINITY; }
        }
        float ge[4], gs = 0.f;
#pragma unroll
        for (int k = 0; k < 4; ++k) { ge[k] = __expf(tv[k] - tv[0]); gs += ge[k]; }
        const float ginv = 1.0f / gs;
        const int my_e = q == 0 ? te[0] : q == 1 ? te[1] : q == 2 ? te[2] : te[3];
        const float my_g = (q == 0 ? ge[0] : q == 1 ? ge[1] : q == 2 ? ge[2] : ge[3]) * ginv;
        const int rloc = __hip_atomic_fetch_add(hist + my_e, 1, __ATOMIC_RELAXED, __HIP_MEMORY_SCOPE_WORKGROUP);
        __syncthreads();
        if (tid < 32) base[tid] = (int)__hip_atomic_fetch_add(cnt + tid, (unsigned)hist[tid], RLX_AGENT);
        __syncthreads();
        const int rank = base[my_e] + rloc;
        perm[(size_t)my_e * T + rank] = (int)row;
        toker[row * 4 + q] = (my_e << 16) | rank;
        tokg[row * 4 + q] = my_g;
        __syncthreads();
    }
}
}

DI int moe_tileoff(Frame& F, int layer) {
    LAS int* ints = (LAS int*)(F.lds + LDS_INTS);
    unsigned* cnt = (unsigned*)(F.ctl + (layer ? CW_CNT1 : CW_CNT0));
    __syncthreads();
    if (F.tid < 32) ints[F.tid] = (int)__hip_atomic_load(cnt + F.tid, RLX_AGENT);
    __syncthreads();
    if (F.tid < 64) {
        const int tl = (F.tid < 32) ? (ints[F.tid] + 255) >> 8 : 0; int inc = tl;
#pragma unroll
        for (int o = 1; o < 32; o <<= 1) { const int up = __shfl_up(inc, o); if ((F.tid & 63) >= o) inc += up; }
        if (F.tid < 32) ints[32 + F.tid] = inc - tl;
        if (F.tid == 31) ints[64] = inc;
    }
    __syncthreads();
    return ints[64];
}

DI void cmb_phase(Frame& F, int layer, float* outf, bf16_t* outb) {
    const int ntile = moe_tileoff(F, layer); (void)ntile;
    const LAS int* ints = (const LAS int*)(F.lds + LDS_INTS);
    const bf16_t* h1 = WSP(bf16_t, WS_H1); const unsigned char* y = WSP(unsigned char, WS_R1);
    const int* toker = WSP(int, WS_TOKER); const float* tokg = WSP(float, WS_TOKG);
    const float* g = F.in[20] + layer * D; const float* bta = F.in[21] + layer * D;
    const int gw = F.vcu * NWAVES + F.wave, NGW = F.G * NWAVES, lane = F.lane;
    struct RowLd { u32x2 h[4]; int yv[4][4]; f32x4 gg; };
    auto issue = [&](int row, const i32x4& er, const f32x4& gg, RowLd& L) {
        L.gg = gg;
#pragma unroll
        for (int k = 0; k < 4; ++k) { const int e = er[k] >> 16, rank = er[k] & 0xffff; const size_t pos = (size_t)ints[32 + e] * 256 + rank;
#pragma unroll
            for (int j = 0; j < 4; ++j) L.yv[k][j] = __builtin_nontemporal_load((const int*)(y + pos * D) + lane + 64 * j); }
#pragma unroll
        for (int j = 0; j < 4; ++j) L.h[j] = *((const u32x2*)(h1 + (size_t)row * D) + lane + 64 * j);
    };
    i32x4 er1 = {0, 0, 0, 0}; f32x4 gg1 = {0.f, 0.f, 0.f, 0.f}; RowLd L0, L1;
    if (gw < T) { const i32x4 er0 = *(const i32x4*)(toker + (size_t)gw * 4); const f32x4 gg0 = *(const f32x4*)(tokg + (size_t)gw * 4); issue(gw, er0, gg0, L0); }
    if (gw + NGW < T) { er1 = *(const i32x4*)(toker + (size_t)(gw + NGW) * 4); gg1 = *(const f32x4*)(tokg + (size_t)(gw + NGW) * 4); }
    for (int row = gw; row < T; row += NGW) {
        const int rown = row + NGW, rownn = row + 2 * NGW;
        i32x4 er2 = {0, 0, 0, 0}; f32x4 gg2 = {0.f, 0.f, 0.f, 0.f};
        if (rownn < T) { er2 = *(const i32x4*)(toker + (size_t)rownn * 4); gg2 = *(const f32x4*)(tokg + (size_t)rownn * 4); }
        if (rown < T) issue(rown, er1, gg1, L1);
        f32x4 v[4]; float s = 0.f;
#pragma unroll
        for (int j = 0; j < 4; ++j) {
            f32x4 a = (f32x4){bflo(L0.h[j].x), bfhi(L0.h[j].x), bflo(L0.h[j].y), bfhi(L0.h[j].y)} * ALPHA;
#pragma unroll
            for (int k = 0; k < 4; ++k) { const int yy = L0.yv[k][j]; const float gk = L0.gg[k] * (1.0f / YSCALE);
                const f32x2 ylo = __builtin_amdgcn_cvt_pk_f32_fp8(yy, false), yhi = __builtin_amdgcn_cvt_pk_f32_fp8(yy, true);
                a[0] += gk * ylo[0]; a[1] += gk * ylo[1]; a[2] += gk * yhi[0]; a[3] += gk * yhi[1]; }
            v[j] = a; s += (a[0] + a[1]) + (a[2] + a[3]);
        }
        const float mean = wave_sum(s) * (1.0f / D); float s2 = 0.f;
#pragma unroll
        for (int j = 0; j < 4; ++j) { v[j] = v[j] - mean; s2 += (v[j][0] * v[j][0] + v[j][1] * v[j][1]) + (v[j][2] * v[j][2] + v[j][3] * v[j][3]); }
        const float rstd = 1.0f / sqrtf(wave_sum(s2) * (1.0f / D) + LN_EPS);
#pragma unroll
        for (int j = 0; j < 4; ++j) { const f32x4 gv = *((const f32x4*)g + lane + 64 * j), bv = *((const f32x4*)bta + lane + 64 * j);
            const f32x4 o = v[j] * rstd * gv + bv;
            if (outf) __builtin_nontemporal_store(o, (f32x4*)(outf + (size_t)row * D) + lane + 64 * j);
            if (outb) { u32x2 wv; wv.x = pk_bf16(o[0], o[1]); wv.y = pk_bf16(o[2], o[3]); *((u32x2*)(outb + (size_t)row * D) + lane + 64 * j) = wv;
                if (IN1_FP8) *((unsigned*)(WSP(unsigned char, WS_X8) + (size_t)row * D) + lane + 64 * j) = pk_fp8x4(o[0] * XSCALE, o[1] * XSCALE, o[2] * XSCALE, o[3] * XSCALE); } }
        L0 = L1; er1 = er2; gg1 = gg2;
    }
}

DI void moe_up_phase(Frame& F, int layer) {
    const int ntile = moe_tileoff(F, layer);
    LAS int* ints = (LAS int*)(F.lds + LDS_INTS);
    LAS unsigned* tab = (LAS unsigned*)(F.lds + LDS_TAB);
    constexpr unsigned RB = 1024 * MOE_EB;
    pg8::MoeSched S; S.to_lane = (F.lane < 32) ? ints[33 + F.lane] : 0x7fffffff; S.total = ntile * 8; S.G = F.G; S.c = F.vcu; S.ntshift = 3; S.gather = true; S.tab = tab; S.rowb = RB;
    S.W = (const char*)(WSP(unsigned char, WS_WGU) + (size_t)layer * 32 * 2048 * RB); S.wexp = (size_t)2048 * RB; S.wpn = (size_t)128 * RB;
    const int* perm = WSP(int, WS_PERM);
    { int tk[18];
#pragma unroll
      for (int i = 0; i < 18; ++i) { pg8::Unit u; tk[i] = -1;
          if (S.next(i, u) && F.tid < 256) { const int mloc = u.pm - ints[32 + u.e], r = mloc * 256 + F.tid; tk[i] = (r < ints[u.e]) ? perm[(size_t)u.e * T + r] : 0; } }
#pragma unroll
      for (int i = 0; i < 18; ++i) if (tk[i] >= 0) tab[i * 256 + F.tid] = (unsigned)tk[i] * RB; }
    __syncthreads();
    pg8::EpiSwiglu E{WSP(unsigned char, WS_R2), F.in[17] + (size_t)layer * 32 * 2048, MOE_FP8 ? 1.0f / (XSCALE * WSCALE) : 1.0f};
    pg8::gemm_phase<pg8::EpiSwiglu, pg8::MoeSched, MOE_FP8>(F.lds + LDS_STAGE, (const char*)WSP(unsigned char, WS_HB), RB, (size_t)1024 * RB, S, E);
}
DI void moe_down_phase(Frame& F, int layer) {
    const int ntile = moe_tileoff(F, layer);
    LAS int* ints = (LAS int*)(F.lds + LDS_INTS);
    constexpr unsigned RB = 1024 * MOE_EB;
    pg8::MoeSched S; S.to_lane = (F.lane < 32) ? ints[33 + F.lane] : 0x7fffffff; S.total = ntile * 4; S.G = F.G; S.c = F.vcu; S.ntshift = 2; S.gather = false; S.tab = nullptr; S.rowb = RB;
    S.W = (const char*)(WSP(unsigned char, WS_WD) + (size_t)layer * 32 * 1024 * RB); S.wexp = (size_t)1024 * RB; S.wpn = (size_t)256 * RB;
    pg8::EpiDown E{WSP(unsigned char, WS_R1), F.in[19] + (size_t)layer * 32 * 1024, MOE_FP8 ? 1.0f / (ASCALE * WSCALE) : 1.0f};
    pg8::gemm_phase<pg8::EpiDown, pg8::MoeSched, MOE_FP8>(F.lds + LDS_STAGE, (const char*)WSP(unsigned char, WS_R2), RB, (size_t)128 * RB, S, E);
}

namespace idx1 {
constexpr int PITCH = OD_COLS_P;
DI unsigned f2key(float f) { const unsigned u = __float_as_uint(f + 0.0f); return u ^ ((u >> 31) ? 0xffffffffu : 0x80000000u); }
DI int mbcnt64(unsigned long long m) { return (int)__builtin_amdgcn_mbcnt_hi((unsigned)(m >> 32), __builtin_amdgcn_mbcnt_lo((unsigned)m, 0u)); }
DI int wsum6(int c) { int t = 0;
#pragma unroll
    for (int b = 0; b < 6; ++b) t += __builtin_popcountll(__ballot((c >> b) & 1)) << b;
    return t; }
template <int NJ> DI void select_finish(const unsigned (&key)[NJ], unsigned th, int* op, LAS unsigned* bnd, int lane);
template <int NJ> DI void select256x2(const LAS float* rowA, const LAS float* rowB, int nA, int nB, int* opA, int* opB, LAS unsigned* bnd, int lane) {
    static_assert(NJ % 2 == 0, "pairs of register slots");
    unsigned hA[NJ / 2], hB[NJ / 2];
#pragma unroll
    for (int j = 0; j < NJ / 2; ++j) { const int p0 = lane + 64 * (2 * j), p1 = p0 + 64;
        const unsigned a0 = (p0 < nA) ? f2key(rowA[p0]) : 0u, a1 = (p1 < nA) ? f2key(rowA[p1]) : 0u, b0 = (p0 < nB) ? f2key(rowB[p0]) : 0u, b1 = (p1 < nB) ? f2key(rowB[p1]) : 0u;
        hA[j] = (a0 >> 16) | (a1 & 0xffff0000u); hB[j] = (b0 >> 16) | (b1 & 0xffff0000u); }
    unsigned thA = 0u, thB = 0u;
    const unsigned one2 = 0x00010001u;
#pragma unroll 1
    for (int bit = 15; bit >= 0; --bit) {
        const unsigned cA1 = ((thA | (1u << bit)) - 1u) & 0xffffu, cB1 = ((thB | (1u << bit)) - 1u) & 0xffffu;
        const unsigned mA = cA1 | (cA1 << 16), mB = cB1 | (cB1 << 16);
        unsigned dA[NJ / 2], dB[NJ / 2];
#pragma unroll
        for (int j = 0; j < NJ / 2; ++j) { asm("v_pk_sub_u16 %0, %1, %2 clamp" : "=v"(dA[j]) : "v"(hA[j]), "v"(mA)); asm("v_pk_sub_u16 %0, %1, %2 clamp" : "=v"(dB[j]) : "v"(hB[j]), "v"(mB)); }
#pragma unroll
        for (int j = 0; j < NJ / 2; ++j) { asm("v_pk_min_u16 %0, %1, %2" : "=v"(dA[j]) : "v"(dA[j]), "v"(one2)); asm("v_pk_min_u16 %0, %1, %2" : "=v"(dB[j]) : "v"(dB[j]), "v"(one2)); }
        unsigned kA2[2] = {0u, 0u}, kB2[2] = {0u, 0u};
#pragma unroll
        for (int j = 0; j < NJ / 2; ++j) { asm("v_pk_add_u16 %0, %1, %2" : "=v"(kA2[j & 1]) : "v"(kA2[j & 1]), "v"(dA[j])); asm("v_pk_add_u16 %0, %1, %2" : "=v"(kB2[j & 1]) : "v"(kB2[j & 1]), "v"(dB[j])); }
        unsigned kA, kB; asm("v_pk_add_u16 %0, %1, %2" : "=v"(kA) : "v"(kA2[0]), "v"(kA2[1])); asm("v_pk_add_u16 %0, %1, %2" : "=v"(kB) : "v"(kB2[0]), "v"(kB2[1]));
        const int cA = (int)(kA & 0xffffu) + (int)(kA >> 16), cB = (int)(kB & 0xffffu) + (int)(kB >> 16);
        int tA = 0, tB = 0;
#pragma unroll
        for (int b = 0; b < 6; ++b) { tA += __builtin_popcountll(__ballot((cA >> b) & 1)) << b; tB += __builtin_popcountll(__ballot((cB >> b) & 1)) << b; }
        if (tA >= 256) thA |= (1u << bit);
        if (tB >= 256) thB |= (1u << bit);
    }
    { unsigned key[NJ];
#pragma unroll
      for (int j = 0; j < NJ; ++j) { const int p = lane + 64 * j; key[j] = (p < nA) ? f2key(rowA[p]) : 0u; }
      select_finish<NJ>(key, thA, opA, bnd, lane); }
    { unsigned key[NJ];
#pragma unroll
      for (int j = 0; j < NJ; ++j) { const int p = lane + 64 * j; key[j] = (p < nB) ? f2key(rowB[p]) : 0u; }
      select_finish<NJ>(key, thB, opB, bnd, lane); }
}
template <int NJ> DI void select_finish(const unsigned (&key)[NJ], unsigned th, int* op, LAS unsigned* bnd, int lane) {
    const unsigned lo32 = th << 16;
    int cg = 0, ce = 0;
#pragma unroll
    for (int j = 0; j < NJ; ++j) { const unsigned d = key[j] - lo32; cg += (key[j] >= lo32 && d > 0xffffu) ? 1 : 0; ce += (key[j] >= lo32 && d <= 0xffffu) ? 1 : 0; }
    int G = 0, pre = 0, B = 0, preE = 0;
#pragma unroll
    for (int b = 0; b < 6; ++b) { const unsigned long long m = __ballot((cg >> b) & 1); G += __builtin_popcountll(m) << b; pre += mbcnt64(m) << b;
        const unsigned long long me = __ballot((ce >> b) & 1); B += __builtin_popcountll(me) << b; preE += mbcnt64(me) << b; }
    {   int w = pre;
#pragma unroll
        for (int j = 0; j < NJ; ++j) { const unsigned d = key[j] - lo32; if (key[j] >= lo32 && d > 0xffffu) { op[w] = lane + 64 * j; ++w; } }
    }
    const int need = 256 - G;
    if (B <= 64) {
        {   int w = preE;
#pragma unroll
            for (int j = 0; j < NJ; ++j) { const unsigned d = key[j] - lo32; if (key[j] >= lo32 && d <= 0xffffu) { bnd[w] = (d << 11) | (unsigned)(2047 - (lane + 64 * j)); ++w; } }
        }
        LDS_WAIT(); asm volatile("" ::: "memory");
        const unsigned mine = (lane < B) ? bnd[lane] : 0u;
        int rank = 0;
#pragma unroll 1
        for (int i = 0; i < B; ++i) { const unsigned o = (unsigned)__builtin_amdgcn_readlane((int)mine, i); rank += (o > mine) ? 1 : 0; }
        if (lane < B && rank < need) op[G + rank] = 2047 - (int)(mine & 2047u);
        LDS_WAIT(); asm volatile("" ::: "memory");
    } else {
        unsigned tl = 0u;
#pragma unroll 1
        for (int bit = 15; bit >= 0; --bit) {
            const unsigned cand = lo32 | tl | (1u << bit); int c = 0;
#pragma unroll
            for (int j = 0; j < NJ; ++j) c += (key[j] >= cand) ? 1 : 0;
            if (wsum6(c) >= 256) tl |= (1u << bit);
        }
        const unsigned tau = lo32 | tl; int base = G;
#pragma unroll
        for (int j = 0; j < NJ; ++j) { const bool sel = key[j] > tau && (key[j] - lo32) <= 0xffffu; const unsigned long long m = __ballot(sel);
            if (sel) op[base + mbcnt64(m)] = lane + 64 * j; base += __builtin_popcountll(m); }
        const int need2 = 256 - base; int eb = 0;
#pragma unroll
        for (int j = 0; j < NJ; ++j) { const bool eq = key[j] == tau; const unsigned long long m = __ballot(eq); const int pos = eb + mbcnt64(m);
            if (eq && pos < need2) op[base + pos] = lane + 64 * j; eb += __builtin_popcountll(m); }
    }
}
DI void phase(Frame& F) {
    const int lane = F.lane, w = F.wave, tid = F.tid, hh = lane >> 5;
    const bf16_t* proj = WSP(bf16_t, WS_R1);
    { const float* kvw = F.in[9]; bf16_t* ckv = WSP(bf16_t, WS_CKV);
      const int gw = F.vcu * NWAVES + w, NGW = F.G * NWAVES;
      const float w0 = kvw[2 * lane], w1 = kvw[2 * lane + 1];
      for (int row = gw; row < T; row += 4 * NGW) {
          unsigned c[4];
#pragma unroll
          for (int u = 0; u < 4; ++u) c[u] = (row + u * NGW < T) ? *(const unsigned*)(proj + (size_t)(row + u * NGW) * PITCH + 2048 + 2 * lane) : 0u;
#pragma unroll
          for (int u = 0; u < 4; ++u) { if (row + u * NGW >= T) break;
              const float a = bflo(c[u]), b = bfhi(c[u]);
              const float ss = wave_sum(a * a + b * b);
              const float rs = 1.0f / sqrtf(ss * (1.0f / 128.0f) + RMS_EPS);
              *(unsigned*)(ckv + (size_t)(row + u * NGW) * 128 + 2 * lane) = pk_bf16(a * rs * w0, b * rs * w1); }
      } }
    LAS float* sc = (LAS float*)F.lds;
    LAS float* wq = (LAS float*)(F.lds + LDS_TAB);
    LAS unsigned* bnd = (LAS unsigned*)(F.lds + LDS_TAB + 1024) + w * 64;
    int* idxo = WSP(int, WS_IDX);
    for (int u = F.vcu; u < T / 16; u += F.G) {
        const int b = u >> 7, q0 = (((u & 127) + 16 * (b >> 1)) & 127) * 16;
        __syncthreads();
        if (tid < 128) wq[tid] = bf2f(proj[(size_t)(b * SEQ + q0 + (tid >> 3)) * PITCH + 2752 + (tid & 7)]);
        bf16x8 qf[4][4];
#pragma unroll
        for (int rg = 0; rg < 4; ++rg) { const bf16_t* qp = proj + (size_t)(b * SEQ + q0 + 4 * rg + ((lane & 31) >> 3)) * PITCH + 2176 + (lane & 7) * 64 + hh * 8;
#pragma unroll
            for (int s = 0; s < 4; ++s) qf[rg][s] = *(const bf16x8*)(qp + 16 * s); }
        const int nkb = (q0 + 15) / 32 + 1;
        const bf16_t* kbase = proj + (size_t)(b * SEQ + (lane & 31)) * PITCH + 2688 + hh * 8;
        bf16x8 kf[4], kn[4];
        if (w < nkb) {
#pragma unroll
            for (int s = 0; s < 4; ++s) kf[s] = *(const bf16x8*)(kbase + (size_t)(32 * w) * PITCH + 16 * s); }
        __syncthreads();
        for (int kb = w; kb < nkb; kb += NWAVES) {
            if (kb + NWAVES < nkb) {
#pragma unroll
                for (int s = 0; s < 4; ++s) kn[s] = *(const bf16x8*)(kbase + (size_t)(32 * (kb + NWAVES)) * PITCH + 16 * s); }
#pragma unroll
            for (int rg = 0; rg < 4; ++rg) {
                f32x16 dd = {};
#pragma unroll
                for (int s = 0; s < 4; ++s) dd = __builtin_amdgcn_mfma_f32_32x32x16_bf16(qf[rg][s], kf[s], dd, 0, 0, 0);
                float part[4];
#pragma unroll
                for (int q4 = 0; q4 < 4; ++q4) { const f32x4 wv = *(const LAS f32x4*)(wq + (4 * rg + q4) * 8 + 4 * hh);
                    part[q4] = wv[0] * fmaxf(dd[4 * q4], 0.f) + wv[1] * fmaxf(dd[4 * q4 + 1], 0.f) + wv[2] * fmaxf(dd[4 * q4 + 2], 0.f) + wv[3] * fmaxf(dd[4 * q4 + 3], 0.f); }
#pragma unroll
                for (int q4 = 0; q4 < 4; ++q4) part[q4] += __shfl_xor(part[q4], 32);
                const int key = 32 * kb + (lane & 31);
                if (hh == 0) { sc[(4 * rg + 0) * 2048 + key] = part[0]; sc[(4 * rg + 1) * 2048 + key] = part[1]; }
                else         { sc[(4 * rg + 2) * 2048 + key] = part[2]; sc[(4 * rg + 3) * 2048 + key] = part[3]; }
            }
#pragma unroll
            for (int s = 0; s < 4; ++s) kf[s] = kn[s];
        }
        __syncthreads();
        {
            const int qi = 2 * w, t = q0 + qi, n = t + 1;
            int* opA = idxo + (size_t)(b * SEQ + t) * 256; int* opB = opA + 256;
            if (n + 1 <= 256) {
#pragma unroll
                for (int j = 0; j < 4; ++j) { const int p = lane + 64 * j; opA[p] = (p < n) ? p : -1; opB[p] = (p < n + 1) ? p : -1; }
            } else {
                const LAS float* rowA = sc + qi * 2048; const LAS float* rowB = rowA + 2048;
                if (n + 1 <= 512) select256x2<8>(rowA, rowB, n, n + 1, opA, opB, bnd, lane);
                else if (n + 1 <= 1024) select256x2<16>(rowA, rowB, n, n + 1, opA, opB, bnd, lane);
                else if (n + 1 <= 1536) select256x2<24>(rowA, rowB, n, n + 1, opA, opB, bnd, lane);
                else select256x2<32>(rowA, rowB, n, n + 1, opA, opB, bnd, lane);
            }
        }
    }
    __syncthreads();
}
}

namespace spa1 {
constexpr int RP = 272;
constexpr int PITCH = OD_COLS_P;
DI s16x4 trrd(const LAS unsigned char* p) { typedef short v4i16_t __attribute__((ext_vector_type(4))); return __builtin_bit_cast(s16x4, __builtin_amdgcn_ds_read_tr16_b64_v4i16((LAS v4i16_t*)p)); }
DI void phase(Frame& F) {
    const int lane = F.lane, w = F.wave, hd = lane & 15, g = lane >> 4;
    const bf16_t* proj = WSP(bf16_t, WS_R1); const bf16_t* ckv = WSP(bf16_t, WS_CKV); const int* idx = WSP(int, WS_IDX); bf16_t* of = WSP(bf16_t, WS_R2);
    LAS unsigned char* buf = F.lds + w * (32 * RP + 2048);
    LAS float* dl = (LAS float*)(buf + 32 * RP);
    LAS unsigned* ofl = (LAS unsigned*)(buf + 32 * RP + 1024);
    const float slope2 = fexp2(-0.5f * (float)(hd + 1)) * LOG2E, sc2 = 0.08838834764831845f * LOG2E;
    const int gw = F.vcu * NWAVES + w, NGW = F.G * NWAVES;
#define SPA_Q(jj, b_, t_, row_) const int lin_##jj = gw + (jj) * NGW, b_ = lin_##jj / SEQ, t_ = (lin_##jj + 131 * b_) % SEQ; const size_t row_ = (size_t)(b_ * SEQ + t_)
    i32x4 idr; bf16x8 qn[4];
    if (gw < T) { SPA_Q(0, b0_, t0_, row0_); (void)t0_; idr = *(const i32x4*)(idx + row0_ * 256 + 4 * lane);
        const bf16_t* qp = proj + row0_ * PITCH + hd * 128 + g * 8;
#pragma unroll
        for (int s = 0; s < 4; ++s) qn[s] = *(const bf16x8*)(qp + 32 * s); }
    for (int j = 0; gw + j * NGW < T; ++j) {
        const int lin = gw + j * NGW, b = lin / SEQ, t = (lin + 131 * b) % SEQ;
        const size_t row = (size_t)(b * SEQ + t);
        const int nsel = (t + 1 < 256) ? t + 1 : 256, nch = (nsel + 31) >> 5;
        { f32x4 d4;
#pragma unroll
          for (int e = 0; e < 4; ++e) d4[e] = idr[e] < 0 ? 1.0e30f : (float)(t - idr[e]);
          *(LAS f32x4*)(dl + 4 * lane) = d4; }
        { u32x4 o4;
#pragma unroll
          for (int e = 0; e < 4; ++e) o4[e] = (unsigned)(idr[e] < 0 ? 0 : idr[e]) * 256u;
          *(LAS u32x4*)(ofl + 4 * lane) = o4; }
        const char* ckvb = (const char*)(ckv + (size_t)b * SEQ * 128) + 16 * hd;
        bf16x8 qf[4];
#pragma unroll
        for (int s = 0; s < 4; ++s) qf[s] = qn[s];
        if (gw + (j + 1) * NGW < T) {
            const int lin2 = gw + (j + 1) * NGW, b2 = lin2 / SEQ, t2 = (lin2 + 131 * b2) % SEQ; const size_t row2 = (size_t)(b2 * SEQ + t2);
            idr = *(const i32x4*)(idx + row2 * 256 + 4 * lane);
            const bf16_t* qp = proj + row2 * PITCH + hd * 128 + g * 8;
#pragma unroll
            for (int s = 0; s < 4; ++s) qn[s] = *(const bf16x8*)(qp + 32 * s);
        }
        f32x4 O[8];
#pragma unroll
        for (int c = 0; c < 8; ++c) O[c] = (f32x4){0.f, 0.f, 0.f, 0.f};
        float mrun = -1.0e30f, lrun = 0.f;
#define SPA_CORE             const f32x4 kd0 = *(const LAS f32x4*)(dl + 32 * c + 4 * g) * slope2, kd1 = *(const LAS f32x4*)(dl + 32 * c + 16 + 4 * g) * slope2; \
            f32x4 s0 = {0.f, 0.f, 0.f, 0.f}, s1 = {0.f, 0.f, 0.f, 0.f}; \
_Pragma("unroll") \
            for (int s = 0; s < 4; ++s) { \
                const bf16x8 a0 = *(const LAS bf16x8*)(buf + hd * RP + (32 * s + 8 * g) * 2), a1 = *(const LAS bf16x8*)(buf + (16 + hd) * RP + (32 * s + 8 * g) * 2); \
                s0 = __builtin_amdgcn_mfma_f32_16x16x32_bf16(a0, qf[s], s0, 0, 0, 0); \
                s1 = __builtin_amdgcn_mfma_f32_16x16x32_bf16(a1, qf[s], s1, 0, 0, 0); \
            } \
            float mx = -INFINITY; \
_Pragma("unroll") \
            for (int i = 0; i < 4; ++i) { \
                s0[i] = s0[i] * sc2 - kd0[i]; \
                s1[i] = s1[i] * sc2 - kd1[i]; \
                mx = fmaxf(mx, fmaxf(s0[i], s1[i])); \
            } \
            mx = fmaxf(mx, __shfl_xor(mx, 16)); mx = fmaxf(mx, __shfl_xor(mx, 32)); \
            if (__ballot(mx > mrun + 8.0f) != 0ull) { const float mnew = fmaxf(mrun, mx), al = fexp2(mrun - mnew); mrun = mnew; lrun *= al; \
                _Pragma("unroll") for (int c8 = 0; c8 < 8; ++c8) O[c8] = O[c8] * al; } \
            float ls = 0.f; \
_Pragma("unroll") \
            for (int i = 0; i < 4; ++i) { s0[i] = fexp2(s0[i] - mrun); s1[i] = fexp2(s1[i] - mrun); ls += s0[i] + s1[i]; } \
            lrun += ls; \
            u32x4 pw; pw.x = pk_bf16(s0[0], s0[1]); pw.y = pk_bf16(s0[2], s0[3]); pw.z = pk_bf16(s1[0], s1[1]); pw.w = pk_bf16(s1[2], s1[3]); \
            const bf16x8 pf = __builtin_bit_cast(bf16x8, pw); \
            const int q = hd >> 2, p = hd & 3; \
_Pragma("unroll") \
            for (int c8 = 0; c8 < 8; ++c8) { \
                const LAS unsigned char* a = buf + (4 * g + q) * RP + (16 * c8 + 4 * p) * 2; \
                const s16x4 lo = trrd(a), hi = trrd(a + 16 * RP); \
                const bf16x8 vf = __builtin_shufflevector(lo, hi, 0, 1, 2, 3, 4, 5, 6, 7); \
                O[c8] = __builtin_amdgcn_mfma_f32_16x16x32_bf16(vf, pf, O[c8], 0, 0, 0); \
            }
        u32x4 grA[8], grB[8];
#define SPA_GLOAD(gr_, cc) do { _Pragma("unroll") for (int i_ = 0; i_ < 8; ++i_) gr_[i_] = *(const u32x4*)(ckvb + ofl[32 * (cc) + g + 4 * i_]); } while (0)
#define SPA_CHUNK(gr_, cnext_) do { \
            _Pragma("unroll") for (int i = 0; i < 8; ++i) *(LAS u32x4*)(buf + (g + 4 * i) * RP + 16 * hd) = gr_[i]; \
            if ((cnext_) < nch) SPA_GLOAD(gr_, (cnext_)); \
            SPA_CORE } while (0)
        SPA_GLOAD(grA, 0);
        if (nch > 1) SPA_GLOAD(grB, 1);
#pragma unroll 1
        for (int c2 = 0; c2 < nch; c2 += 2) {
            { const int c = c2; SPA_CHUNK(grA, c2 + 2); }
            if (c2 + 1 < nch) { const int c = c2 + 1; SPA_CHUNK(grB, c2 + 3); }
        }
#undef SPA_CHUNK
#undef SPA_GLOAD
        float lt = lrun + __shfl_xor(lrun, 16); lt += __shfl_xor(lt, 32);
        const float inv = 1.0f / lt;
        if (PLAIN_FP8) { unsigned char* op = (unsigned char*)of + row * 2048 + hd * 128 + 4 * g; const float iv = inv * MSCALE;
#pragma unroll
            for (int c8 = 0; c8 < 8; ++c8) *(unsigned*)(op + 16 * c8) = pk_fp8x4(O[c8][0] * iv, O[c8][1] * iv, O[c8][2] * iv, O[c8][3] * iv);
        } else { bf16_t* op = of + row * 2048 + hd * 128 + 4 * g;
#pragma unroll
            for (int c8 = 0; c8 < 8; ++c8) { u32x2 wv; wv.x = pk_bf16(O[c8][0] * inv, O[c8][1] * inv); wv.y = pk_bf16(O[c8][2] * inv, O[c8][3] * inv); *(u32x2*)(op + 16 * c8) = wv; } }
    }
}
}

constexpr int NPHASE = 16;
struct Args { const float* in[22]; float* out; unsigned char* ws; int ph_lo, ph_hi, bar_region, pad; };
__global__ void __launch_bounds__(NTHR, 2) fwd(Args args) {
    extern __shared__ __attribute__((aligned(16))) unsigned char lds_raw[];
    Frame F;
    F.lds = (LAS unsigned char*)lds_raw;
    F.tid = threadIdx.x; F.lane = F.tid & 63; F.wave = __builtin_amdgcn_readfirstlane(F.tid >> 6);
    F.G = gridDim.x; { const int bx = blockIdx.x; F.vcu = (F.G % 8 == 0) ? (bx % 8) * (F.G / 8) + bx / 8 : bx; }
    F.ws = args.ws; F.ctl = (gu32*)(args.ws + WS_CTL); F.out = args.out;
#pragma unroll
    for (int i = 0; i < 22; ++i) F.in[i] = args.in[i];
    volatile LAS unsigned* MISC = (volatile LAS unsigned*)(F.lds + LDS_MISC);
    if (F.tid < 64) MISC[F.tid] = 0u;
    __syncthreads();
    const int lo = args.ph_lo, hi = args.ph_hi;
    XcdBarrier bar; bar.bar = (unsigned*)(F.ctl + CW_BAR) + args.bar_region * XCD_BAR_WORDS; bar.x = 0; bar.st = nullptr;
    if (hi - lo > 1) bar = xcd_barrier_post((unsigned*)(F.ctl + CW_BAR) + args.bar_region * XCD_BAR_WORDS, MISC + 8);
#ifndef REPEAT_MASK
#define REPEAT_MASK 0
#endif
#ifndef PHASE_MASK
#define PHASE_MASK 0xFFFF
#endif
#define IN(k) (((PHASE_MASK >> (k)) & 1) && lo <= (k) && (k) < hi)
#define REPEAT_LOOP(k)
#define SEAM(k) do { if (IN(k) && IN((k) + 1)) xcd_barrier(bar); } while (0)

    if (IN(0)) { REPEAT_LOOP(0) { p0_prologue(F); } } SEAM(0);
    if (IN(1)) { REPEAT_LOOP(1) { pg8::PlainSched S; S.init(T, EV_COLS, D, D, WSP(unsigned char, WS_WEVIN), F.G, (int)blockIdx.x, IN_EB);
        pg8::EpiProj E{WSP(bf16_t, WS_R1), EV_COLS, IN_FP8 ? 1.0f / (XSCALE * WSCALE) : 1.0f};
        pg8::gemm_phase<pg8::EpiProj, pg8::PlainSched, IN_FP8>(F.lds + LDS_STAGE, (const char*)(IN_FP8 ? WSP(unsigned char, WS_X8) : WSP(unsigned char, WS_XB)), D * IN_EB, (size_t)128 * D * IN_EB, S, E); } } SEAM(1);
    if (IN(2)) { REPEAT_LOOP(2) { att0::phase(F); } } SEAM(2);
    if (IN(3)) { REPEAT_LOOP(3) { pg8::PlainSched S; S.init(T, D, D, D, WSP(unsigned char, WS_WEVOUT), F.G, (int)blockIdx.x, PL_EB);
        pg8::EpiRes E{nullptr, WSP(bf16_t, WS_XB), WSP(bf16_t, WS_PRE), PLAIN_FP8 ? 1.0f / (MSCALE * WSCALE) : 1.0f};
        pg8::gemm_phase<pg8::EpiRes, pg8::PlainSched, PLAIN_FP8>(F.lds + LDS_STAGE, (const char*)WSP(unsigned char, WS_R2), D * PL_EB, (size_t)128 * D * PL_EB, S, E); } } SEAM(3);
    if (IN(4)) { REPEAT_LOOP(4) { lnr::phase(F, 0); } } SEAM(4);
    if (IN(5)) { REPEAT_LOOP(5) { moe_up_phase(F, 0); } } SEAM(5);
    if (IN(6)) { REPEAT_LOOP(6) { moe_down_phase(F, 0); } } SEAM(6);
    if (IN(7)) { REPEAT_LOOP(7) { cmb_phase(F, 0, nullptr, WSP(bf16_t, WS_XB)); } } SEAM(7);
    if (IN(8)) { REPEAT_LOOP(8) { pg8::PlainSched S; S.init(T, OD_COLS_P, D, D, WSP(unsigned char, WS_WODIN), F.G, (int)blockIdx.x, IN1_EB);
        pg8::EpiProj E{WSP(bf16_t, WS_R1), OD_COLS_P, IN1_FP8 ? 1.0f / (XSCALE * WSCALE) : 1.0f};
        pg8::gemm_phase<pg8::EpiProj, pg8::PlainSched, IN1_FP8>(F.lds + LDS_STAGE, (const char*)(IN1_FP8 ? WSP(unsigned char, WS_X8) : WSP(unsigned char, WS_XB)), D * IN1_EB, (size_t)128 * D * IN1_EB, S, E); } } SEAM(8);
    if (IN(9)) { REPEAT_LOOP(9) { idx1::phase(F); } } SEAM(9);
    if (IN(10)) { REPEAT_LOOP(10) { spa1::phase(F); } } SEAM(10);
    if (IN(11)) { REPEAT_LOOP(11) { pg8::PlainSched S; S.init(T, D, 2048, 2048, WSP(unsigned char, WS_WCOMB), F.G, (int)blockIdx.x, PL_EB);
        pg8::EpiRes E{nullptr, WSP(bf16_t, WS_XB), WSP(bf16_t, WS_PRE), PLAIN_FP8 ? 1.0f / (MSCALE * WCSCALE) : 1.0f};
        pg8::gemm_phase<pg8::EpiRes, pg8::PlainSched, PLAIN_FP8>(F.lds + LDS_STAGE, (const char*)WSP(unsigned char, WS_R2), 2048 * PL_EB, (size_t)128 * 2048 * PL_EB, S, E); } } SEAM(11);
    if (IN(12)) { REPEAT_LOOP(12) { lnr::phase(F, 1); } } SEAM(12);
    if (IN(13)) { REPEAT_LOOP(13) { moe_up_phase(F, 1); } } SEAM(13);
    if (IN(14)) { REPEAT_LOOP(14) { moe_down_phase(F, 1); } } SEAM(14);
    if (IN(15)) { REPEAT_LOOP(15) { cmb_phase(F, 1, F.out, nullptr); } } SEAM(15);
#undef IN
#undef SEAM
}

extern "C" void kernel_launch(void* const* d_in, const int* in_sizes, int n_in, void* d_out, int out_size, void* d_ws, size_t ws_size, hipStream_t stream) {
    static int grid = 0;
    if (grid == 0) {
        if (n_in != 22 || out_size != T * D || ws_size < WS_END) { fprintf(stderr, "kernel_launch: unexpected shapes (n_in %d out %d ws %zu need %zu)\n", n_in, out_size, ws_size, (size_t)WS_END); grid = -1; return; }
        int dev = 0, cus = 0;
        if (hipGetDevice(&dev) != hipSuccess || hipDeviceGetAttribute(&cus, hipDeviceAttributeMultiprocessorCount, dev) != hipSuccess) { grid = -1; return; }
        if (hipFuncSetAttribute((const void*)fwd, hipFuncAttributeMaxDynamicSharedMemorySize, LDS_BYTES) != hipSuccess) { fprintf(stderr, "kernel_launch: hipFuncSetAttribute failed\n"); grid = -1; return; }
        int per_cu = 0;
        if (hipOccupancyMaxActiveBlocksPerMultiprocessor(&per_cu, (const void*)fwd, NTHR, LDS_BYTES) != hipSuccess || per_cu < 1) fprintf(stderr, "kernel_launch: occupancy query reports %d\n", per_cu);
        (void)hipGetLastError();
        grid = cus;
    }
    if (grid < 0) return;
    if (hipMemsetAsync((char*)d_ws + WS_CTL, 0, CTL_ZERO_BYTES, stream) != hipSuccess) return;
    Args a{};
    for (int i = 0; i < 22; ++i) a.in[i] = (const float*)d_in[i];
    a.out = (float*)d_out; a.ws = (unsigned char*)d_ws;
#if MK_PER_PHASE
    for (int p = 0; p < NPHASE; ++p) { a.ph_lo = p; a.ph_hi = p + 1; hipLaunchKernelGGL(fwd, dim3(grid), dim3(NTHR), LDS_BYTES, stream, a); }
#elif REPEAT_MASK
    { int lo = 0, reg = 0;
      for (int k = 0; k < NPHASE; ++k) if ((REPEAT_MASK >> k) & 1) {
          a.ph_lo = lo; a.ph_hi = k + 1; a.bar_region = reg++; hipLaunchKernelGGL(fwd, dim3(grid), dim3(NTHR), LDS_BYTES, stream, a);
          a.ph_lo = k; a.ph_hi = k + 1; a.bar_region = reg++; hipLaunchKernelGGL(fwd, dim3(grid), dim3(NTHR), LDS_BYTES, stream, a);
          lo = k + 1; }
      if (lo < NPHASE) { a.ph_lo = lo; a.ph_hi = NPHASE; a.bar_region = reg++; hipLaunchKernelGGL(fwd, dim3(grid), dim3(NTHR), LDS_BYTES, stream, a); } }
#else
    a.ph_lo = 0; a.ph_hi = NPHASE; hipLaunchKernelGGL(fwd, dim3(grid), dim3(NTHR), LDS_BYTES, stream, a);
#endif
}
```

```cpp
#include <hip/hip_runtime.h>
#include <cstdio>
#include <cstdint>

#ifndef MK_PER_PHASE
#define MK_PER_PHASE 0
#endif

#define GAS __attribute__((address_space(1)))
#define LAS __attribute__((address_space(3)))
typedef unsigned short bf16_t;
typedef short bf16x8 __attribute__((ext_vector_type(8)));
typedef short s16x4 __attribute__((ext_vector_type(4)));
typedef float f32x2 __attribute__((ext_vector_type(2)));
typedef float f32x4 __attribute__((ext_vector_type(4)));
typedef float f32x16 __attribute__((ext_vector_type(16)));
typedef unsigned u32x2 __attribute__((ext_vector_type(2)));
typedef unsigned u32x4 __attribute__((ext_vector_type(4)));
typedef int i32x4 __attribute__((ext_vector_type(4)));
typedef GAS unsigned gu32;
#define RLX_AGENT __ATOMIC_RELAXED, __HIP_MEMORY_SCOPE_AGENT
#define DI __device__ __forceinline__

constexpr int BATCH = 16, SEQ = 2048, T = BATCH * SEQ, D = 1024;
constexpr int NEXP = 32, DFF = 1024;
constexpr int EV_COLS = 3072, OD_COLS = 2760, OD_COLS_P = 2816;
constexpr float ALPHA = 1.41421356237309515f;
constexpr float LN_EPS = 1e-5f, RMS_EPS = 1e-5f;
constexpr float LOG2E = 1.4426950408889634f;
constexpr int MAXROWS = 131072 + 32 * 256;
constexpr int NWAVES = 8, NTHR = 512;
#ifndef MOE_FP8_ON
#define MOE_FP8_ON 1
#endif
constexpr bool MOE_FP8 = MOE_FP8_ON != 0;
constexpr int MOE_EB = MOE_FP8 ? 1 : 2;
#ifndef PLAIN_FP8_ON
#define PLAIN_FP8_ON 1
#endif
constexpr bool PLAIN_FP8 = PLAIN_FP8_ON != 0;
#ifndef IN_FP8_ON
#define IN_FP8_ON 0
#endif
constexpr bool IN_FP8 = IN_FP8_ON != 0;
#ifndef IN1_FP8_ON
#define IN1_FP8_ON 0
#endif
constexpr bool IN1_FP8 = IN1_FP8_ON != 0;
constexpr int PL_EB = PLAIN_FP8 ? 1 : 2, IN_EB = IN_FP8 ? 1 : 2, IN1_EB = IN1_FP8 ? 1 : 2;
constexpr float YSCALE = 64.0f;
constexpr float MSCALE = 32.0f, WCSCALE = 1024.0f;
constexpr float WSCALE = 256.0f, XSCALE = 16.0f, ASCALE = 4.0f;

constexpr size_t MiB = 1u << 20;
constexpr size_t WS_CTL = 0, CTL_ZERO_BYTES = 1 * MiB;
constexpr size_t WS_WEVIN = 1 * MiB;
constexpr size_t WS_WEVOUT = 7 * MiB;
constexpr size_t WS_WODIN = 9 * MiB;
constexpr size_t WS_WCOMB = 15 * MiB;
constexpr size_t WS_WR = 19 * MiB;
constexpr size_t WS_WGU = 20 * MiB;
constexpr size_t WS_WD = 276 * MiB;
constexpr size_t WS_XB = 404 * MiB;
constexpr size_t WS_HB = 468 * MiB;
constexpr size_t WS_R1 = 532 * MiB;
constexpr size_t WS_R2 = 804 * MiB;
constexpr size_t WS_PRE = 1076 * MiB;
constexpr size_t WS_H1 = 1204 * MiB;
constexpr size_t WS_X8 = 1332 * MiB;
constexpr size_t WS_PERM = 1460 * MiB;
constexpr size_t WS_TOKER = 1464 * MiB;
constexpr size_t WS_TOKG = 1465 * MiB;
constexpr size_t WS_CKV = 1466 * MiB;
constexpr size_t WS_IDX = 1474 * MiB;
constexpr size_t WS_END = 1506 * MiB;
constexpr int CW_CNT0 = 64, CW_CNT1 = 128;
constexpr int CW_BAR = 4096;

constexpr int LDS_STAGE = 0, LDS_TAB = 131072, LDS_BIAS = 131072 + 18 * 1024, LDS_INTS = 151552, LDS_MISC = 152576, LDS_BYTES = 153600;

DI unsigned pk_bf16(float lo, float hi) { typedef __bf16 b2 __attribute__((ext_vector_type(2))); f32x2 v = {lo, hi}; b2 b = __builtin_convertvector(v, b2); return __builtin_bit_cast(unsigned, b); }
DI unsigned pk_fp8x4(float a, float b, float c, float d) {
    a = fminf(fmaxf(a, -440.f), 440.f); b = fminf(fmaxf(b, -440.f), 440.f); c = fminf(fmaxf(c, -440.f), 440.f); d = fminf(fmaxf(d, -440.f), 440.f);
    int p = __builtin_amdgcn_cvt_pk_fp8_f32(a, b, 0, false); p = __builtin_amdgcn_cvt_pk_fp8_f32(c, d, p, true); return (unsigned)p; }
DI float bf2f(unsigned short b) { return __uint_as_float(((unsigned)b) << 16); }
DI float bflo(unsigned u) { return __uint_as_float(u << 16); }
DI float bfhi(unsigned u) { return __uint_as_float(u & 0xffff0000u); }
DI float wave_sum(float v) {
#pragma unroll
    for (int o = 1; o < 64; o <<= 1) v += __shfl_xor(v, o);
    return v;
}
DI float fexp2(float x) { return __builtin_amdgcn_exp2f(x); }
DI float frcp(float x) { return __builtin_amdgcn_rcpf(x); }
#define LDS_WAIT() asm volatile("s_waitcnt lgkmcnt(0)" ::: "memory")
#define VM_WAIT() asm volatile("s_waitcnt vmcnt(0)" ::: "memory")

#define XB_TMO      128
#define XB_XCNT(j)  (256  + 64 * (j))
#define XB_XSUB(j)  (1280 + 64 * (j))
#define XB_XGEN(j)  (2304 + 64 * (j))
#define XB_TOP      3328
#define XB_TOPGEN   3392
#define XCD_BAR_WORDS 3456
#define XB_SPIN_CAP (1u << 22)
DI unsigned xb_ld(unsigned* p)              { return __hip_atomic_load(p, __ATOMIC_RELAXED, __HIP_MEMORY_SCOPE_AGENT); }
DI unsigned xb_add(unsigned* p, unsigned v) { return __hip_atomic_fetch_add(p, v, __ATOMIC_RELAXED, __HIP_MEMORY_SCOPE_AGENT); }
DI unsigned xb_xcc_id() { return (unsigned)__builtin_amdgcn_s_getreg((3 << 11) | 20) & 0xFu; }
#define XB_SPIN(cond, bar) do { unsigned _sp = 0; while (cond) { __builtin_amdgcn_s_sleep(1); \
    if ((++_sp & 255u) == 0u) { if (xb_ld(&(bar)[XB_TMO])) break; if (_sp > XB_SPIN_CAP) { atomicAdd(&(bar)[XB_TMO], 1u); break; } } } } while (0)
struct XcdBarrier { unsigned* bar; unsigned x; volatile LAS unsigned* st; };
DI XcdBarrier xcd_barrier_post(unsigned* bar, volatile LAS unsigned* st) {
    XcdBarrier b; b.bar = bar; b.x = xb_xcc_id(); b.st = st;
    if (threadIdx.x == 0) (void)xb_add(&bar[XB_XCNT(b.x)], 1u);
    return b;
}
DI void xcd_barrier_complete(unsigned* bar, unsigned x, unsigned& nloc, unsigned& nx) {
    const unsigned G = gridDim.x * gridDim.y * gridDim.z;
    unsigned sum, cnt, mine, sp = 0u;
    for (;;) {
        sum = 0u; cnt = 0u; mine = 0u;
#pragma unroll
        for (unsigned j = 0; j < 16; ++j) { const unsigned c = xb_ld(&bar[XB_XCNT(j)]); sum += c; cnt += (c > 0u) ? 1u : 0u; mine = (j == x) ? c : mine; }
        if (sum == G) break;
        __builtin_amdgcn_s_sleep(1);
        if ((++sp & 255u) == 0u) { if (xb_ld(&bar[XB_TMO])) break; if (sp > XB_SPIN_CAP) { atomicAdd(&bar[XB_TMO], 1u); break; } }
    }
    nloc = mine > 0u ? mine : 1u; nx = cnt > 0u ? cnt : 1u;
}
DI void xcd_barrier(const XcdBarrier& b) {
    asm volatile("s_waitcnt vmcnt(0)" ::: "memory");
    __syncthreads();
    if (threadIdx.x == 0) {
        unsigned* bar = b.bar;
        __builtin_amdgcn_s_waitcnt(0);
        unsigned nloc = b.st[0], nx = b.st[1];
        if (nloc == 0u) { xcd_barrier_complete(bar, b.x, nloc, nx); b.st[0] = nloc; b.st[1] = nx; }
        const unsigned old = xb_add(&bar[XB_XSUB(b.x)], 1u);
        const unsigned gen = old / nloc;
        if (old + 1u == (gen + 1u) * nloc) {
            __builtin_amdgcn_fence(__ATOMIC_RELEASE, "agent");
            asm volatile("s_waitcnt vmcnt(0)" ::: "memory");
            const unsigned og = xb_add(&bar[XB_TOP], 1u);
            const unsigned tg = og / nx;
            if (og + 1u == (tg + 1u) * nx) xb_add(&bar[XB_TOPGEN], 1u);
            else XB_SPIN(xb_ld(&bar[XB_TOPGEN]) == tg, bar);
            __builtin_amdgcn_fence(__ATOMIC_ACQUIRE, "agent");
            xb_add(&bar[XB_XGEN(b.x)], 1u);
            asm volatile("s_waitcnt vmcnt(0)" ::: "memory");
        } else {
            XB_SPIN(xb_ld(&bar[XB_XGEN(b.x)]) == gen, bar);
            __builtin_amdgcn_fence(__ATOMIC_ACQUIRE, "agent");
            asm volatile("s_waitcnt vmcnt(0)" ::: "memory");
        }
    }
    __syncthreads();
}

namespace pg8 {
constexpr int BM = 256, BK = 64, HALF = 128, HTB = HALF * BK * 2, STAGE_BYTES = 8 * HTB, NXCD = 8, WGM = 8;
__host__ __device__ __forceinline__ int lds_byte(int r, int c) { const int st = (r >> 4) * 2 + (c >> 5), rr = r & 15, cc = c & 31, ob = rr * 64 + cc * 2; return st * 1024 + (ob ^ (((ob >> 9) & 1) << 5)); }
__host__ __device__ __forceinline__ void stage_rc(int b, int& R, int& C) { const int st = b / 1024, sb = b % 1024, swz = sb ^ (((sb >> 9) & 1) << 5); R = (st >> 1) * 16 + swz / 64; C = (st & 1) * 32 + (swz % 64) / 2; }
__host__ __device__ __forceinline__ int perm32(int rho) { const int n = rho >> 4, i = rho & 15; return 8 * (i >> 2) + 4 * n + (i & 3); }

struct Unit { int pm, pn, e, slot; const char* Bp; };

typedef int v4i_t __attribute__((ext_vector_type(4)));
typedef int v8i_t __attribute__((ext_vector_type(8)));
template <class Epi, class Sched, bool FP8 = false>
DI void gemm_phase(LAS unsigned char* lds, const char* Abase, const int RB, const size_t hstepB, const Sched& S, const Epi& E) {
    const int tid = threadIdx.x, wid = __builtin_amdgcn_readfirstlane(tid >> 6), lane = tid & 63, wr = wid >> 2, wc = wid & 3, fr = lane & 15, fq = lane >> 4;
    const int nt = RB / 128;
    int RA[2], CA[2]; unsigned voffB[2];
#pragma unroll
    for (int i = 0; i < 2; ++i) { int R, C; stage_rc(tid * 16 + i * 8192, R, C); const int Rb = Epi::PERM ? ((R & ~31) + perm32(R & 31)) : R;
        RA[i] = R; CA[i] = C; voffB[i] = (unsigned)(Rb * RB + C * 2); }
    const size_t kstep = (size_t)(BK * 2);
    const unsigned ldsw = (unsigned)wid * 1024u;
    const int aoff = lds_byte(wr * 64 + fr, fq * 8), boff = lds_byte(wc * 32 + fr, fq * 8);
#define PG8_SA(b, h) (((b) * 2 + (h)) * HTB)
#define PG8_SB(b, h) ((4 + (b) * 2 + (h)) * HTB)
#define PG8_STAGE(bufoff, gbase, voff) do { _Pragma("unroll") for (int _i = 0; _i < 2; ++_i) \
        __builtin_amdgcn_global_load_lds((const unsigned*)((const char*)(gbase) + (voff)[_i]), (LAS unsigned*)(lds + (bufoff) + ldsw + _i * 8192), 16, 0, 0); } while (0)
#define PG8_LDA(dst, b, h) do { _Pragma("unroll") for (int m = 0; m < 4; ++m) { const v4i_t lo_ = *(const LAS v4i_t*)(lds + PG8_SA(b, h) + aoff + m * 2048), hi_ = *(const LAS v4i_t*)(lds + PG8_SA(b, h) + aoff + m * 2048 + 1024); \
        dst[m] = __builtin_shufflevector(lo_, hi_, 0, 1, 2, 3, 4, 5, 6, 7); } } while (0)
#define PG8_LDB(dst, b, h) do { _Pragma("unroll") for (int n = 0; n < 2; ++n) { const v4i_t lo_ = *(const LAS v4i_t*)(lds + PG8_SB(b, h) + boff + n * 2048), hi_ = *(const LAS v4i_t*)(lds + PG8_SB(b, h) + boff + n * 2048 + 1024); \
        dst[n] = __builtin_shufflevector(lo_, hi_, 0, 1, 2, 3, 4, 5, 6, 7); } } while (0)
#define PG8_LO(x) __builtin_bit_cast(bf16x8, __builtin_shufflevector(x, x, 0, 1, 2, 3))
#define PG8_HI(x) __builtin_bit_cast(bf16x8, __builtin_shufflevector(x, x, 4, 5, 6, 7))
#define PG8_MMA(ai, bj, At, Bt) do { __builtin_amdgcn_s_setprio(1); if constexpr (FP8) asm volatile("s_nop 1"); _Pragma("unroll") for (int m = 0; m < 4; ++m) _Pragma("unroll") for (int n = 0; n < 2; ++n) { \
        if constexpr (!FP8) { acc[ai][bj][m][n] = __builtin_amdgcn_mfma_f32_16x16x32_bf16(PG8_LO(Bt[n]), PG8_LO(At[m]), acc[ai][bj][m][n], 0, 0, 0); \
                              acc[ai][bj][m][n] = __builtin_amdgcn_mfma_f32_16x16x32_bf16(PG8_HI(Bt[n]), PG8_HI(At[m]), acc[ai][bj][m][n], 0, 0, 0); } \
        else asm volatile("v_mfma_f32_16x16x128_f8f6f4 %0, %1, %2, %0" : "+v"(acc[ai][bj][m][n]) : "v"(Bt[n]), "v"(At[m])); } __builtin_amdgcn_s_setprio(0); } while (0)
#define PG8_WAIT_V(n) asm volatile("s_waitcnt vmcnt(" #n ")" ::: "memory")
#define PG8_WAIT_L(n) asm volatile("s_waitcnt lgkmcnt(" #n ")" ::: "memory")
#define PG8_BAR __builtin_amdgcn_s_barrier()
#define PG8_SCHED __builtin_amdgcn_sched_barrier(0)
    Unit cur, nxt; int ui = 0;
    if (!S.next(0, cur)) return;
    f32x4 acc[2][2][4][2];
#pragma unroll
    for (int a = 0; a < 2; ++a)
#pragma unroll
        for (int b = 0; b < 2; ++b)
#pragma unroll
            for (int m = 0; m < 4; ++m)
#pragma unroll
                for (int n = 0; n < 2; ++n) acc[a][b][m][n] = (f32x4){0.f, 0.f, 0.f, 0.f};
    v8i_t At[4], B0[2], B1[2];
    unsigned vC0[2], vC1[2], vN0[2], vN1[2];
    S.arows(cur, RA, CA, vC0, vC1);
    const char* cB = cur.Bp;
    LAS unsigned char* bring = lds + (LDS_BIAS - LDS_STAGE);
    if constexpr (Epi::HAS_BIAS) { if (wid == 0) __builtin_amdgcn_global_load_lds((const unsigned*)E.bias_src(cur, lane), (LAS unsigned*)bring, 16, 0, 0); }
    PG8_STAGE(PG8_SB(0, 0), cB, voffB); PG8_STAGE(PG8_SB(0, 1), cB + hstepB, voffB); PG8_STAGE(PG8_SA(0, 0), Abase, vC0); PG8_STAGE(PG8_SA(0, 1), Abase, vC1);
    if (wr == 1) PG8_BAR;
    PG8_WAIT_V(2); PG8_BAR;
    PG8_STAGE(PG8_SB(1, 0), cB + kstep, voffB); PG8_STAGE(PG8_SA(1, 0), Abase + kstep, vC0); PG8_STAGE(PG8_SB(1, 1), cB + hstepB + kstep, voffB);
    PG8_WAIT_V(6); PG8_BAR;
    for (;;) {
        const bool has_next = S.next(ui + 1, nxt);
        if (has_next) S.arows(nxt, RA, CA, vN0, vN1); else { vN0[0] = vC0[0]; vN0[1] = vC0[1]; vN1[0] = vC1[0]; vN1[1] = vC1[1]; }
        const char* nB = has_next ? nxt.Bp : cB;
#pragma unroll 1
        for (int t = 0; t < nt; t += 2) {
            const bool last = (t == nt - 2);
            if constexpr (Epi::HAS_BIAS) { if (last && has_next && wid == 0) __builtin_amdgcn_global_load_lds((const unsigned*)E.bias_src(nxt, lane), (LAS unsigned*)(bring + ((ui + 1) & 1) * 1024), 16, 0, 0); }
            const char* a1 = Abase + (size_t)(t + 1) * kstep;
            const char* a2 = last ? Abase : Abase + (size_t)(t + 2) * kstep; const char* b2 = last ? nB : cB + (size_t)(t + 2) * kstep;
            const char* a3 = a2 + kstep; const char* b3 = b2 + kstep;
            unsigned v20[2], v21[2];
            v20[0] = last ? vN0[0] : vC0[0]; v20[1] = last ? vN0[1] : vC0[1]; v21[0] = last ? vN1[0] : vC1[0]; v21[1] = last ? vN1[1] : vC1[1];
            PG8_LDB(B0, 0, 0); PG8_LDB(B1, 0, 1); PG8_SCHED; PG8_LDA(At, 0, 0); PG8_STAGE(PG8_SA(1, 1), a1, vC1);
            PG8_WAIT_V(8); PG8_WAIT_L(0); PG8_BAR; PG8_MMA(0, 0, At, B0); PG8_MMA(0, 1, At, B1); PG8_BAR; PG8_SCHED;
            PG8_LDA(At, 0, 1); PG8_STAGE(PG8_SB(0, 0), b2, voffB); PG8_STAGE(PG8_SB(0, 1), b2 + hstepB, voffB); PG8_STAGE(PG8_SA(0, 0), a2, v20);
            PG8_WAIT_V(8); PG8_WAIT_L(0); PG8_BAR; PG8_MMA(1, 0, At, B0); PG8_MMA(1, 1, At, B1); PG8_BAR; PG8_SCHED;
            PG8_LDB(B0, 1, 0); PG8_LDB(B1, 1, 1); PG8_SCHED; PG8_LDA(At, 1, 0); PG8_STAGE(PG8_SA(0, 1), a2, v21);
            PG8_WAIT_V(8); PG8_WAIT_L(0); PG8_BAR; PG8_MMA(0, 0, At, B0); PG8_MMA(0, 1, At, B1); PG8_BAR; PG8_SCHED;
            PG8_LDA(At, 1, 1); PG8_STAGE(PG8_SB(1, 0), b3, voffB); PG8_STAGE(PG8_SB(1, 1), b3 + hstepB, voffB); PG8_STAGE(PG8_SA(1, 0), a3, v20);
            PG8_WAIT_V(8); PG8_WAIT_L(0); PG8_BAR; PG8_MMA(1, 0, At, B0); PG8_MMA(1, 1, At, B1); PG8_BAR; PG8_SCHED;
        }
        if (wr == 0) PG8_BAR;
        if constexpr (FP8) asm volatile("s_nop 15\n\ts_nop 15" ::: "memory");
        E(acc, cur, wr, wc, fr, fq, (const LAS float*)(bring + (ui & 1) * 1024));
#ifdef EPI_TWICE
        asm volatile("" ::: "memory"); E(acc, cur, wr, wc, fr, fq, (const LAS float*)(bring + (ui & 1) * 1024));
#endif
        if (!has_next) break;
#pragma unroll
        for (int a = 0; a < 2; ++a)
#pragma unroll
            for (int b = 0; b < 2; ++b)
#pragma unroll
                for (int m = 0; m < 4; ++m)
#pragma unroll
                    for (int n = 0; n < 2; ++n) acc[a][b][m][n] = (f32x4){0.f, 0.f, 0.f, 0.f};
        cur = nxt; cB = nB; vC0[0] = vN0[0]; vC0[1] = vN0[1]; vC1[0] = vN1[0]; vC1[1] = vN1[1]; ++ui;
        if (wr == 1) PG8_BAR;
    }
    PG8_WAIT_V(0);
    PG8_BAR;
#undef PG8_SA
#undef PG8_SB
#undef PG8_STAGE
#undef PG8_LDA
#undef PG8_LDB
#undef PG8_MMA
#undef PG8_LO
#undef PG8_HI
#undef PG8_WAIT_V
#undef PG8_WAIT_L
#undef PG8_BAR
#undef PG8_SCHED
}

struct PlainSched {
    int nM, nN, nwg, G, c; unsigned lda2; const char* Bt; size_t tstepB;
    DI void init(int M, int N, int K, int lda, const void* Bt_, int G_, int c_, int eb = 2) { nM = M / BM; nN = N / BM; nwg = nM * nN; G = G_; c = c_; lda2 = (unsigned)(lda * eb); Bt = (const char*)Bt_; tstepB = (size_t)BM * K * eb; }
    DI bool next(int i, Unit& u) const {
        const long L = (long)i * G + c; if (L >= nwg) return false;
        int wgid = (int)L; { const int q = nwg / NXCD, r = nwg % NXCD, xcd = wgid % NXCD, off = wgid / NXCD; wgid = (xcd < r ? xcd * (q + 1) : r * (q + 1) + (xcd - r) * q) + off; }
        const int nig = WGM * nN, gid = wgid / nig, fm = gid * WGM, gsz = (nM - fm) < WGM ? (nM - fm) : WGM;
        u.pm = fm + ((wgid % nig) % gsz); u.pn = (wgid % nig) / gsz; u.e = 0; u.slot = i; u.Bp = Bt + (size_t)u.pn * tstepB; return true;
    }
    DI void arows(const Unit& u, const int (&R)[2], const int (&C)[2], unsigned (&v0)[2], unsigned (&v1)[2]) const {
#pragma unroll
        for (int i = 0; i < 2; ++i) { v0[i] = (unsigned)(u.pm * BM + R[i]) * lda2 + (unsigned)C[i] * 2u; v1[i] = (unsigned)(u.pm * BM + HALF + R[i]) * lda2 + (unsigned)C[i] * 2u; }
    }
};
struct MoeSched {
    int to_lane;
    int total, G, c, ntshift; bool gather;
    const LAS unsigned* tab;
    const char* W; size_t wexp, wpn; unsigned rowb;
    DI bool next(int i, Unit& u) const {
        const int per = G >> 3, x = c / per, j = c - x * per, ntile = total >> ntshift, tpx = (ntile + 7) >> 3, tpr = per >> ntshift;
        const int loc = i * tpr + (j >> ntshift), mtg = x * tpx + loc, pn = j & ((1 << ntshift) - 1);
        if (loc >= tpx || mtg >= ntile) return false;
        const int e = __builtin_popcountll(__ballot(to_lane <= mtg));
        u.pm = mtg; u.pn = pn; u.e = e; u.slot = i; u.Bp = W + (size_t)e * wexp + (size_t)pn * wpn; return true;
    }
    DI void arows(const Unit& u, const int (&R)[2], const int (&C)[2], unsigned (&v0)[2], unsigned (&v1)[2]) const {
        if (gather) {
#pragma unroll
            for (int i = 0; i < 2; ++i) { v0[i] = tab[u.slot * 256 + R[i]] + (unsigned)C[i] * 2u; v1[i] = tab[u.slot * 256 + HALF + R[i]] + (unsigned)C[i] * 2u; }
        } else {
#pragma unroll
            for (int i = 0; i < 2; ++i) { v0[i] = (unsigned)(u.pm * BM + R[i]) * rowb + (unsigned)C[i] * 2u; v1[i] = (unsigned)(u.pm * BM + HALF + R[i]) * rowb + (unsigned)C[i] * 2u; }
        }
    }
};

struct EpiProj {
    static constexpr bool PERM = true, HAS_BIAS = false; bf16_t* O; int ldc; float ascale;
    DI void operator()(const f32x4 (&acc)[2][2][4][2], const Unit& u, int wr, int wc, int fr, int fq, const LAS float*) const {
        const int row0 = u.pm * BM + wr * 64 + fr, col0 = u.pn * BM + wc * 32 + 8 * fq;
#pragma unroll
        for (int ai = 0; ai < 2; ++ai)
#pragma unroll
            for (int m = 0; m < 4; ++m) { bf16_t* rowp = O + (size_t)(row0 + ai * HALF + m * 16) * ldc + col0;
#pragma unroll
                for (int bj = 0; bj < 2; ++bj) { const f32x4 v0 = acc[ai][bj][m][0] * ascale, v1 = acc[ai][bj][m][1] * ascale;
                    u32x4 w; w.x = pk_bf16(v0[0], v0[1]); w.y = pk_bf16(v0[2], v0[3]); w.z = pk_bf16(v1[0], v1[1]); w.w = pk_bf16(v1[2], v1[3]);
                    *(u32x4*)(rowp + bj * HALF) = w; } }
    }
};
struct EpiRes {
    static constexpr bool PERM = false, HAS_BIAS = false; const float* res; const bf16_t* resb; bf16_t* out; float ascale;
    DI void operator()(const f32x4 (&acc)[2][2][4][2], const Unit& u, int wr, int wc, int fr, int fq, const LAS float*) const {
        const int row0 = u.pm * BM + wr * 64 + fr, col0 = u.pn * BM + wc * 32 + 4 * fq;
#pragma unroll
        for (int ai = 0; ai < 2; ++ai)
#pragma unroll
            for (int m = 0; m < 4; ++m) { const size_t off = (size_t)(row0 + ai * HALF + m * 16) * D + col0;
#pragma unroll
                for (int bj = 0; bj < 2; ++bj)
#pragma unroll
                    for (int n = 0; n < 2; ++n) { f32x4 r;
                        if (resb) { const u32x2 rb = *(const u32x2*)(resb + off + bj * HALF + n * 16); r = (f32x4){bflo(rb.x), bfhi(rb.x), bflo(rb.y), bfhi(rb.y)}; }
                        else r = *(const f32x4*)(res + off + bj * HALF + n * 16);
                        const f32x4 o = acc[ai][bj][m][n] * ascale + r * ALPHA; u32x2 w; w.x = pk_bf16(o[0], o[1]); w.y = pk_bf16(o[2], o[3]);
                        *(u32x2*)(out + off + bj * HALF + n * 16) = w; } }
    }
};
struct EpiSwiglu {
    static constexpr bool PERM = true, HAS_BIAS = true; unsigned char* O; const float* bgu; float ascale;
    DI const float* bias_src(const Unit& u, int lane) const { return bgu + (size_t)u.e * 2048 + u.pn * HALF + (lane >> 5) * 1024 + 4 * (lane & 31); }
    DI void operator()(const f32x4 (&acc)[2][2][4][2], const Unit& u, int wr, int wc, int fr, int fq, const LAS float* bias) const {
        const int row0 = u.pm * BM + wr * 64 + fr, col0 = u.pn * HALF + wc * 32 + 8 * fq;
        f32x4 bgv[2], buv[2];
#pragma unroll
        for (int n = 0; n < 2; ++n) { bgv[n] = *(const LAS f32x4*)(bias + wc * 32 + 8 * fq + 4 * n); buv[n] = *(const LAS f32x4*)(bias + 128 + wc * 32 + 8 * fq + 4 * n); }
#pragma unroll
        for (int ai = 0; ai < 2; ++ai)
#pragma unroll
            for (int m = 0; m < 4; ++m) { float o[8];
#pragma unroll
                for (int n = 0; n < 2; ++n)
#pragma unroll
                    for (int jj = 0; jj < 2; ++jj) {
                        const f32x2 ag = {acc[ai][0][m][n][2 * jj], acc[ai][0][m][n][2 * jj + 1]}, au = {acc[ai][1][m][n][2 * jj], acc[ai][1][m][n][2 * jj + 1]};
                        const f32x2 bg2 = {bgv[n][2 * jj], bgv[n][2 * jj + 1]}, bu2 = {buv[n][2 * jj], buv[n][2 * jj + 1]};
                        f32x2 g = ag * ascale + bg2, up = au * ascale + bu2;
                        g = __builtin_elementwise_min(g, (f32x2){7.0f, 7.0f});
                        up = __builtin_elementwise_min(__builtin_elementwise_max(up, (f32x2){-7.0f, -7.0f}), (f32x2){7.0f, 7.0f});
                        const f32x2 ex = g * (-1.702f * LOG2E);
                        f32x2 e2; e2.x = fexp2(ex.x); e2.y = fexp2(ex.y);
                        const f32x2 den = e2 + 1.0f;
                        f32x2 sg; sg.x = frcp(den.x); sg.y = frcp(den.y);
                        const f32x2 r = (g * sg) * (up + 1.0f);
                        o[4 * n + 2 * jj] = r.x; o[4 * n + 2 * jj + 1] = r.y; }
                if (!MOE_FP8) { u32x4 w; w.x = pk_bf16(o[0], o[1]); w.y = pk_bf16(o[2], o[3]); w.z = pk_bf16(o[4], o[5]); w.w = pk_bf16(o[6], o[7]);
                    *(u32x4*)(O + ((size_t)(row0 + ai * HALF + m * 16) * DFF + col0) * 2) = w; }
                else { u32x2 w;
                    int p = __builtin_amdgcn_cvt_pk_fp8_f32(o[0] * ASCALE, o[1] * ASCALE, 0, false); p = __builtin_amdgcn_cvt_pk_fp8_f32(o[2] * ASCALE, o[3] * ASCALE, p, true); w.x = (unsigned)p;
                    p = __builtin_amdgcn_cvt_pk_fp8_f32(o[4] * ASCALE, o[5] * ASCALE, 0, false); p = __builtin_amdgcn_cvt_pk_fp8_f32(o[6] * ASCALE, o[7] * ASCALE, p, true); w.y = (unsigned)p;
                    *(u32x2*)(O + (size_t)(row0 + ai * HALF + m * 16) * DFF + col0) = w; } }
    }
};
struct EpiDown {
    static constexpr bool PERM = true, HAS_BIAS = true; unsigned char* O; const float* bd; float ascale;
    DI const float* bias_src(const Unit& u, int lane) const { return bd + (size_t)u.e * 1024 + u.pn * BM + 4 * lane; }
    DI void operator()(const f32x4 (&acc)[2][2][4][2], const Unit& u, int wr, int wc, int fr, int fq, const LAS float* bias) const {
        const int row0 = u.pm * BM + wr * 64 + fr, col0 = u.pn * BM + wc * 32 + 8 * fq;
        f32x4 bv[2][2];
#pragma unroll
        for (int bj = 0; bj < 2; ++bj)
#pragma unroll
            for (int n = 0; n < 2; ++n) bv[bj][n] = *(const LAS f32x4*)(bias + bj * HALF + wc * 32 + 8 * fq + 4 * n) * YSCALE;
        const float as = ascale * YSCALE;
#pragma unroll
        for (int ai = 0; ai < 2; ++ai)
#pragma unroll
            for (int m = 0; m < 4; ++m) { unsigned char* rowp = O + (size_t)(row0 + ai * HALF + m * 16) * D + col0;
#pragma unroll
                for (int bj = 0; bj < 2; ++bj) { const f32x4 v0 = acc[ai][bj][m][0] * as + bv[bj][0], v1 = acc[ai][bj][m][1] * as + bv[bj][1];
                    u32x2 w; w.x = pk_fp8x4(v0[0], v0[1], v0[2], v0[3]); w.y = pk_fp8x4(v1[0], v1[1], v1[2], v1[3]);
                    *(u32x2*)(rowp + bj * HALF) = w; } }
    }
};
}

struct Frame {
    LAS unsigned char* lds;
    gu32* ctl;
    int tid, lane, wave, vcu, G;
    unsigned char* ws;
    const float* in[22];
    float* out;
};
#define WSP(T_, off) ((T_*)(F.ws + (off)))

DI void p0_transpose_item(const float* W, int K, int N, int Nvalid, bf16_t* WT, LAS float* scr, int item, int lane) {
    const int nblk = N / 32, kb = item / nblk, nb = item % nblk, k0 = 64 * kb, n0 = 32 * nb;
    const int n = n0 + (lane & 31); const bool ok = n < Nvalid;
#pragma unroll 8
    for (int i = 0; i < 32; ++i) { const int kk = 2 * i + (lane >> 5); scr[kk * 33 + (lane & 31)] = ok ? W[(size_t)(k0 + kk) * Nvalid + n] : 0.f; }
    LDS_WAIT(); asm volatile("" ::: "memory");
    const int c = lane & 7;
#pragma unroll
    for (int j = 0; j < 4; ++j) { const int nn = (lane >> 3) + 8 * j; const LAS float* s = scr + (8 * c) * 33 + nn;
        u32x4 o; o.x = pk_bf16(s[0 * 33], s[1 * 33]); o.y = pk_bf16(s[2 * 33], s[3 * 33]); o.z = pk_bf16(s[4 * 33], s[5 * 33]); o.w = pk_bf16(s[6 * 33], s[7 * 33]);
        *(GAS u32x4*)(WT + (size_t)(n0 + nn) * K + k0 + 8 * c) = o; }
    LDS_WAIT(); asm volatile("" ::: "memory");
}
struct P0Desc { const float* W; unsigned char* WT; int N, Nvalid, sub, fp8; float scale; };
DI void p0_load(const P0Desc& d, f32x4 (&v)[16], int lane) {
    const int nblk = d.N / 64, kb = d.sub / nblk, nb = d.sub % nblk, k0 = 64 * kb, n0 = 64 * nb;
    const int nn = n0 + 4 * (lane & 15); const bool ok = nn < d.Nvalid;
#pragma unroll
    for (int i = 0; i < 16; ++i) { const int kk = 4 * i + (lane >> 4); v[i] = ok ? __builtin_nontemporal_load((const f32x4*)(d.W + (size_t)(k0 + kk) * d.Nvalid + nn)) : (f32x4){0.f, 0.f, 0.f, 0.f}; }
}
DI void p0_finish(const P0Desc& d, const f32x4 (&v)[16], LAS float* scr, int lane) {
    constexpr int K = 1024;
    const int nblk = d.N / 64, kb = d.sub / nblk, nb = d.sub % nblk, k0 = 64 * kb, n0 = 64 * nb;
#pragma unroll
    for (int i = 0; i < 16; ++i) { const int kk = 4 * i + (lane >> 4); LAS float* p = scr + kk * 65 + 4 * (lane & 15); p[0] = v[i][0]; p[1] = v[i][1]; p[2] = v[i][2]; p[3] = v[i][3]; }
    LDS_WAIT(); asm volatile("" ::: "memory");
    if (!d.fp8) {
        const int c = lane & 7;
#pragma unroll
        for (int j = 0; j < 8; ++j) { const int n = (lane >> 3) + 8 * j; const LAS float* sp = scr + (8 * c) * 65 + n;
            u32x4 o; o.x = pk_bf16(sp[0], sp[65]); o.y = pk_bf16(sp[2 * 65], sp[3 * 65]); o.z = pk_bf16(sp[4 * 65], sp[5 * 65]); o.w = pk_bf16(sp[6 * 65], sp[7 * 65]);
            *(GAS u32x4*)(d.WT + ((size_t)(n0 + n) * K + k0 + 8 * c) * 2) = o; }
    } else {
        const int c = lane & 3; const float ws = d.scale;
#pragma unroll
        for (int j = 0; j < 4; ++j) { const int n = (lane >> 2) + 16 * j; const LAS float* sp = scr + (16 * c) * 65 + n;
            u32x4 o;
#pragma unroll
            for (int q = 0; q < 4; ++q) { int p = __builtin_amdgcn_cvt_pk_fp8_f32(sp[(4 * q) * 65] * ws, sp[(4 * q + 1) * 65] * ws, 0, false);
                p = __builtin_amdgcn_cvt_pk_fp8_f32(sp[(4 * q + 2) * 65] * ws, sp[(4 * q + 3) * 65] * ws, p, true); o[q] = (unsigned)p; }
            *(GAS u32x4*)(d.WT + (size_t)(n0 + n) * K + k0 + 16 * c) = o; }
    }
    LDS_WAIT(); asm volatile("" ::: "memory");
}
DI void p0_prologue(Frame& F) {
    LAS float* scr = (LAS float*)(F.lds + F.wave * 16896);
    const int gw = F.vcu * NWAVES + F.wave, NGW = F.G * NWAVES;
    constexpr int I_GU = 16 * 32, I_DN = 16 * 16, I_EVIN = 16 * 48, I_EVOUT = 16 * 16, I_ODIN = 16 * 44;
    constexpr int N_GU = 64 * I_GU, N_DN = 64 * I_DN;
    constexpr int NITEMS = N_GU + N_DN + I_EVIN + I_EVOUT + I_ODIN;
    auto desc = [&](int it) -> P0Desc { P0Desc d; int r = it;
        if (r < N_GU) { const int mtx = r / I_GU; d.W = F.in[16] + (size_t)mtx * 1024 * 2048; d.WT = WSP(unsigned char, WS_WGU) + (size_t)mtx * 2048 * 1024 * MOE_EB; d.N = 2048; d.Nvalid = 2048; d.sub = r % I_GU; d.fp8 = MOE_FP8; d.scale = WSCALE; return d; } r -= N_GU;
        if (r < N_DN) { const int mtx = r / I_DN; d.W = F.in[18] + (size_t)mtx * 1024 * 1024; d.WT = WSP(unsigned char, WS_WD) + (size_t)mtx * 1024 * 1024 * MOE_EB; d.N = 1024; d.Nvalid = 1024; d.sub = r % I_DN; d.fp8 = MOE_FP8; d.scale = WSCALE; return d; } r -= N_DN;
        if (r < I_EVIN) { d.W = F.in[1]; d.WT = WSP(unsigned char, WS_WEVIN); d.N = EV_COLS; d.Nvalid = EV_COLS; d.sub = r; d.fp8 = IN_FP8; d.scale = WSCALE; return d; } r -= I_EVIN;
        if (r < I_EVOUT) { d.W = F.in[2]; d.WT = WSP(unsigned char, WS_WEVOUT); d.N = 1024; d.Nvalid = 1024; d.sub = r; d.fp8 = PLAIN_FP8; d.scale = WSCALE; return d; } r -= I_EVOUT;
        d.W = F.in[8]; d.WT = WSP(unsigned char, WS_WODIN); d.N = OD_COLS_P; d.Nvalid = OD_COLS; d.sub = r; d.fp8 = IN1_FP8; d.scale = WSCALE; return d; };
    {
        int it = gw; P0Desc d0, d1; f32x4 v0[16], v1[16];
        if (it < NITEMS) { d0 = desc(it); p0_load(d0, v0, F.lane); }
        while (it < NITEMS) {
            const int itn = it + NGW; const bool more = itn < NITEMS;
            if (more) { d1 = desc(itn); p0_load(d1, v1, F.lane); }
            p0_finish(d0, v0, scr, F.lane);
            if (more) { d0 = d1;
#pragma unroll
                for (int i = 0; i < 16; ++i) v0[i] = v1[i]; }
            it = itn;
        }
    }
    for (int it = gw; it < 32; it += NGW) { const int l = it >> 4; p0_transpose_item(F.in[14] + (size_t)l * 1024 * 32, 1024, 32, 32, WSP(bf16_t, WS_WR) + (size_t)l * 32 * 1024, scr, it & 15, F.lane); }
    {
        const float* wuv = F.in[10]; const float* wout = F.in[11]; bf16_t* wc = WSP(bf16_t, WS_WCOMB); unsigned char* wc8 = WSP(unsigned char, WS_WCOMB);
        for (int it = gw; it < 16 * 512; it += NGW) {
            const int nb = it & 15, kq = __builtin_amdgcn_readfirstlane(it >> 4), k0 = 4 * kq, h = k0 >> 7, n = 64 * nb + F.lane;
            const float* b = wout + (size_t)(h * 64) * 1024 + n; const float* a = wuv + (size_t)k0 * 64;
            float sv[4] = {0.f, 0.f, 0.f, 0.f};
#pragma unroll 32
            for (int d = 0; d < 64; ++d) { const float bv = b[(size_t)d * 1024];
#pragma unroll
                for (int q = 0; q < 4; ++q) sv[q] += a[q * 64 + d] * bv; }
            if (PLAIN_FP8) *(unsigned*)(wc8 + (size_t)n * 2048 + k0) = pk_fp8x4(sv[0] * WCSCALE, sv[1] * WCSCALE, sv[2] * WCSCALE, sv[3] * WCSCALE);
            else { u32x2 w2; w2.x = pk_bf16(sv[0], sv[1]); w2.y = pk_bf16(sv[2], sv[3]); *(u32x2*)(wc + (size_t)n * 2048 + k0) = w2; }
        }
    }
    {
        const float* x = F.in[0]; bf16_t* xb = WSP(bf16_t, WS_XB); unsigned char* x8 = WSP(unsigned char, WS_X8);
        const size_t gt = (size_t)F.vcu * NTHR + F.tid, NGT = (size_t)F.G * NTHR;
        for (size_t o = gt; o < (size_t)T * D / 8; o += 4 * NGT) {
            f32x4 a[4], b[4];
#pragma unroll
            for (int u = 0; u < 4; ++u) { const size_t oo = o + u * NGT; if (oo < (size_t)T * D / 8) { a[u] = __builtin_nontemporal_load((const f32x4*)(x + oo * 8)); b[u] = __builtin_nontemporal_load((const f32x4*)(x + oo * 8 + 4)); } }
#pragma unroll
            for (int u = 0; u < 4; ++u) { const size_t oo = o + u * NGT; if (oo >= (size_t)T * D / 8) break;
                if (IN_FP8) { u32x2 w; w.x = pk_fp8x4(a[u][0] * XSCALE, a[u][1] * XSCALE, a[u][2] * XSCALE, a[u][3] * XSCALE); w.y = pk_fp8x4(b[u][0] * XSCALE, b[u][1] * XSCALE, b[u][2] * XSCALE, b[u][3] * XSCALE); *(u32x2*)(x8 + oo * 8) = w; }
                else { u32x4 w; w.x = pk_bf16(a[u][0], a[u][1]); w.y = pk_bf16(a[u][2], a[u][3]); w.z = pk_bf16(b[u][0], b[u][1]); w.w = pk_bf16(b[u][2], b[u][3]); *(u32x4*)(xb + oo * 8) = w; } }
        }
    }
}

namespace att0 {
constexpr int KP = 144, VP_SB = 144, VP_DF = 288;
constexpr int BUF = 64 * KP + 64 * VP_DF;
constexpr int PITCH = EV_COLS;
DI int crow(int i, int hh) { return (i & 3) + 8 * (i >> 2) + 4 * hh; }
DI bf16x8 pack8(const f32x16& p, int s) {
    u32x4 w; w.x = pk_bf16(p[8 * s], p[8 * s + 1]); w.y = pk_bf16(p[8 * s + 2], p[8 * s + 3]); w.z = pk_bf16(p[8 * s + 4], p[8 * s + 5]); w.w = pk_bf16(p[8 * s + 6], p[8 * s + 7]);
    return __builtin_bit_cast(bf16x8, w);
}
DI s16x4 trrd(const LAS unsigned char* p) { typedef short v4i16_t __attribute__((ext_vector_type(4))); return __builtin_bit_cast(s16x4, __builtin_amdgcn_ds_read_tr16_b64_v4i16((LAS v4i16_t*)p)); }
DI f32x16 qk32(const LAS unsigned char* kb, const bf16x8 (&qf)[4], int lane, f32x16 p = f32x16{}) {
    const LAS unsigned char* kp = kb + (lane & 31) * KP + (lane >> 5) * 16;
#pragma unroll
    for (int s = 0; s < 4; ++s) { const bf16x8 a = *(const LAS bf16x8*)(kp + s * 32); p = __builtin_amdgcn_mfma_f32_32x32x16_bf16(a, qf[s], p, 0, 0, 0); }
    return p;
}
DI const LAS unsigned char* vtlane(const LAS unsigned char* vb, int pitch, int lane) {
    const int hh = lane >> 5, blk = (lane >> 4) & 1, q = (lane & 15) >> 2, p = lane & 3;
    return vb + (4 * hh + q) * pitch + (16 * blk + 4 * p) * 2;
}
DI bf16x8 vtfrag(const LAS unsigned char* vl, int pitch, int c, int rbase) {
    const s16x4 lo = trrd(vl + rbase * pitch + 64 * c), hi = trrd(vl + (rbase + 8) * pitch + 64 * c);
    return __builtin_shufflevector(lo, hi, 0, 1, 2, 3, 4, 5, 6, 7);
}
template <int VD> struct StageRegs { u32x4 k; u32x4 v[VD / 64]; };
template <int VD> DI void stage_load(StageRegs<VD>& r, const bf16_t* proj, int b, int kt, int colK, int colV, int tid) {
    const size_t rowb = (size_t)(b * SEQ + kt * 64);
    r.k = *(const u32x4*)(proj + (rowb + (tid >> 3)) * PITCH + colK + (tid & 7) * 8);
    if (VD == 64) r.v[0] = *(const u32x4*)(proj + (rowb + (tid >> 3)) * PITCH + colV + (tid & 7) * 8);
    else {
#pragma unroll
        for (int j = 0; j < VD / 64; ++j) { const int idx = tid + 512 * j; r.v[j] = *(const u32x4*)(proj + (rowb + (idx >> 4)) * PITCH + colV + (idx & 15) * 8); }
    }
}
template <int VD> DI void stage_write(const StageRegs<VD>& r, LAS unsigned char* buf, int tid) {
    constexpr int VP = VD == 64 ? VP_SB : VP_DF;
    *(LAS u32x4*)(buf + (tid >> 3) * KP + (tid & 7) * 16) = r.k;
    if (VD == 64) *(LAS u32x4*)(buf + 64 * KP + (tid >> 3) * VP + (tid & 7) * 16) = r.v[0];
    else {
#pragma unroll
        for (int j = 0; j < VD / 64; ++j) { const int idx = tid + 512 * j; *(LAS u32x4*)(buf + 64 * KP + (idx >> 4) * VP + (idx & 15) * 16) = r.v[j]; }
    }
}

DI void sb_unit(Frame& F, int b, int h, int qt, const bf16_t* proj, bf16_t* mix) {
    const int tid = F.tid, lane = F.lane, w = F.wave, hh = lane >> 5;
    LAS unsigned char* lds = F.lds;
    volatile LAS int* votes = (volatile LAS int*)(F.lds + LDS_INTS) + 160;
    const int q0 = qt * 256, tw = q0 + 32 * w, t = tw + (lane & 31);
    const int colQ = h * 64, colK = 512 + h * 64, colV = 1024 + h * 64;
    bf16x8 qf[4];
    { const bf16_t* qp = proj + (size_t)(b * SEQ + t) * PITCH + colQ + hh * 8;
#pragma unroll
      for (int s = 0; s < 4; ++s) qf[s] = *(const bf16x8*)(qp + 16 * s); }
    f32x16 O[2]; O[0] = f32x16{}; O[1] = f32x16{};
    float carry = 1.0f;
    int kt = qt * 4 + 3, it = 0;
    StageRegs<64> sr, sn;
    stage_load<64>(sr, proj, b, kt, colK, colV, tid);
    stage_write<64>(sr, lds, tid);
    if (kt > 0) stage_load<64>(sr, proj, b, kt - 1, colK, colV, tid);
    __syncthreads();
    for (;;) {
        const bool more = kt > 0;
        if (kt > 1) stage_load<64>(sn, proj, b, kt - 2, colK, colV, tid);
        const LAS unsigned char* kb = lds + (it & 1) * BUF; const LAS unsigned char* vb = vtlane(kb + 64 * KP, VP_SB, lane);
#pragma unroll
        for (int kbi = 1; kbi >= 0; --kbi) {
            const int key0 = kt * 64 + kbi * 32;
            if (key0 < tw + 31 && __ballot(carry > 0.0f) != 0ull) {
                f32x16 S = qk32(kb + kbi * 32 * KP, qf, lane);
                f32x16 beta, kp;
#pragma unroll
                for (int i = 0; i < 16; ++i) {
                    const int key = key0 + crow(i, hh);
                    float z = fmaxf(S[i] * 0.125f, -30.0f);
                    const float e = fexp2(-z * LOG2E), r = frcp(1.0f + e);
                    const bool valid = key < t;
                    beta[i] = valid ? r : 0.0f; kp[i] = valid ? e * r : 1.0f;
                }
                float a[4], bb[4], wgt[16];
#pragma unroll
                for (int m = 0; m < 4; ++m) { const float k0 = kp[4 * m], k1 = kp[4 * m + 1], k2 = kp[4 * m + 2], k3 = kp[4 * m + 3];
                    wgt[4 * m + 3] = 1.0f; wgt[4 * m + 2] = k3; wgt[4 * m + 1] = k3 * k2; wgt[4 * m] = wgt[4 * m + 1] * k1; a[m] = wgt[4 * m] * k0; }
#pragma unroll
                for (int m = 0; m < 4; ++m) bb[m] = __shfl_xor(a[m], 32);
                float run = carry; f32x16 P;
#pragma unroll
                for (int m = 3; m >= 0; --m) { const float SG = hh ? run : run * bb[m];
#pragma unroll
                    for (int j = 0; j < 4; ++j) P[4 * m + j] = beta[4 * m + j] * (SG * wgt[4 * m + j]);
                    run = run * (a[m] * bb[m]); }
                carry = run;
                const bf16x8 p0 = pack8(P, 0), p1 = pack8(P, 1);
                { const bf16x8 v00 = vtfrag(vb, VP_SB, 0, kbi * 32), v10 = vtfrag(vb, VP_SB, 1, kbi * 32), v01 = vtfrag(vb, VP_SB, 0, kbi * 32 + 16), v11 = vtfrag(vb, VP_SB, 1, kbi * 32 + 16);
                  O[0] = __builtin_amdgcn_mfma_f32_32x32x16_bf16(v00, p0, O[0], 0, 0, 0); O[1] = __builtin_amdgcn_mfma_f32_32x32x16_bf16(v10, p0, O[1], 0, 0, 0);
                  O[0] = __builtin_amdgcn_mfma_f32_32x32x16_bf16(v01, p1, O[0], 0, 0, 0); O[1] = __builtin_amdgcn_mfma_f32_32x32x16_bf16(v11, p1, O[1], 0, 0, 0); }
            }
        }
        if (more) stage_write<64>(sr, lds + ((it + 1) & 1) * BUF, tid);
        const bool act = __ballot(carry > 0.0f) != 0ull;
        if (lane == 0) votes[(it & 1) * 8 + w] = act ? 1 : 0;
        __syncthreads();
        if (!more) break;
        int any = 0;
#pragma unroll
        for (int j = 0; j < 8; ++j) any |= votes[(it & 1) * 8 + j];
        if (!any) break;
        --kt; ++it; sr = sn;
    }
    if (PLAIN_FP8) { unsigned char* op = (unsigned char*)mix + (size_t)(b * SEQ + t) * D + h * 64;
#pragma unroll
        for (int c = 0; c < 2; ++c)
#pragma unroll
            for (int m = 0; m < 4; ++m) *(unsigned*)(op + 32 * c + 8 * m + 4 * hh) = pk_fp8x4(O[c][4 * m] * MSCALE, O[c][4 * m + 1] * MSCALE, O[c][4 * m + 2] * MSCALE, O[c][4 * m + 3] * MSCALE);
    } else { bf16_t* op = mix + (size_t)(b * SEQ + t) * D + h * 64;
#pragma unroll
        for (int c = 0; c < 2; ++c)
#pragma unroll
            for (int m = 0; m < 4; ++m) { u32x2 wv; wv.x = pk_bf16(O[c][4 * m], O[c][4 * m + 1]); wv.y = pk_bf16(O[c][4 * m + 2], O[c][4 * m + 3]);
                *(u32x2*)(op + 32 * c + 8 * m + 4 * hh) = wv; } }
}

DI void diff_unit(Frame& F, int b, int hb, int qt, const bf16_t* proj, bf16_t* mix, float lam, const float* subln) {
    const int tid = F.tid, lane = F.lane, w = F.wave, hh = lane >> 5;
    LAS unsigned char* lds = F.lds;
    const int q0 = qt * 256, tw = q0 + 32 * w, t = tw + (lane & 31);
    const int colV = 2560 + hb * 128;
    const float slope2 = fexp2(-2.0f * (float)(hb + 1)) * LOG2E, sc2 = 0.125f * LOG2E;
    const int ntiles = qt * 4 + 4;
#pragma unroll 1
    for (int cm = 0; cm < 2; ++cm) {
        const int colQ = 1536 + hb * 128 + cm * 64, colK = 2048 + hb * 128 + cm * 64;
        bf16x8 qf[4];
        { const bf16_t* qp = proj + (size_t)(b * SEQ + t) * PITCH + colQ + hh * 8;
#pragma unroll
          for (int s = 0; s < 4; ++s) { const u32x4 raw = *(const u32x4*)(qp + 16 * s); u32x4 sc;
#pragma unroll
              for (int e = 0; e < 4; ++e) sc[e] = pk_bf16(bflo(raw[e]) * sc2, bfhi(raw[e]) * sc2);
              qf[s] = __builtin_bit_cast(bf16x8, sc); } }
        f32x16 O[4];
#pragma unroll
        for (int c = 0; c < 4; ++c) O[c] = f32x16{};
        float mref = 0.0f, lrun = 0.0f;
        StageRegs<128> sr;
        __syncthreads();
        stage_load<128>(sr, proj, b, ntiles - 1, colK, colV, tid);
        stage_write<128>(sr, lds, tid);
        __syncthreads();
        const int kd = tw >> 6;
#pragma unroll 1
        for (int it = 0; it < ntiles; ++it) {
            const int kt = ntiles - 1 - it;
            const bool more = kt > 0;
            if (more) stage_load<128>(sr, proj, b, kt - 1, colK, colV, tid);
            const LAS unsigned char* kb = lds + (it & 1) * BUF; const LAS unsigned char* vb = vtlane(kb + 64 * KP, VP_DF, lane);
            if (kt <= kd) {
                const float cl = slope2 * (float)(64 * kt + 4 * hh - t);
                f32x16 C0, C1;
#pragma unroll
                for (int i = 0; i < 16; ++i) { const float bi = slope2 * (float)((i & 3) + 8 * (i >> 2)); C0[i] = cl + bi; C1[i] = cl + (bi + 32.0f * slope2); }
                f32x16 S0 = C0, S1 = C1;
                { const LAS unsigned char* kp = kb + (lane & 31) * KP + (lane >> 5) * 16;
#pragma unroll
                  for (int s4 = 0; s4 < 4; ++s4) { const bf16x8 a0 = *(const LAS bf16x8*)(kp + s4 * 32), a1 = *(const LAS bf16x8*)(kp + 32 * KP + s4 * 32);
                      S0 = __builtin_amdgcn_mfma_f32_32x32x16_bf16(a0, qf[s4], S0, 0, 0, 0); S1 = __builtin_amdgcn_mfma_f32_32x32x16_bf16(a1, qf[s4], S1, 0, 0, 0); } }
                float mx;
                if (kt == kd) {
#pragma unroll
                    for (int i = 0; i < 16; ++i) { const int k0 = kt * 64 + crow(i, hh);
                        S0[i] = (k0 <= t) ? S0[i] : -INFINITY; S1[i] = (k0 + 32 <= t) ? S1[i] : -INFINITY; }
                }
                mx = fmaxf(S0[0], S1[0]);
#pragma unroll
                for (int i = 1; i < 16; ++i) mx = fmaxf(mx, fmaxf(S0[i], S1[i]));
                mx = fmaxf(mx, __shfl_xor(mx, 32));
                if (kt == kd) mref = mx;
                else if (__ballot(mx > mref + 8.0f) != 0ull) {
                    const float mnew = fmaxf(mref, mx), al = fexp2(mref - mnew); mref = mnew; lrun *= al;
#pragma unroll
                    for (int c = 0; c < 4; ++c)
#pragma unroll
                        for (int i = 0; i < 16; ++i) O[c][i] *= al;
                }
                if (__ballot(mx > mref - 150.0f) != 0ull) {
                float ls = 0.f;
#pragma unroll
                for (int i = 0; i < 16; ++i) { S0[i] = fexp2(S0[i] - mref); S1[i] = fexp2(S1[i] - mref); ls += S0[i] + S1[i]; }
                lrun += ls;
                const bf16x8 p0 = pack8(S0, 0), p1 = pack8(S0, 1), p2 = pack8(S1, 0), p3 = pack8(S1, 1);
#define DF_PVSTEP(row_, p_) do { const bf16x8 f0_ = vtfrag(vb, VP_DF, 0, (row_)), f1_ = vtfrag(vb, VP_DF, 1, (row_)), f2_ = vtfrag(vb, VP_DF, 2, (row_)), f3_ = vtfrag(vb, VP_DF, 3, (row_)); \
                    O[0] = __builtin_amdgcn_mfma_f32_32x32x16_bf16(f0_, (p_), O[0], 0, 0, 0); O[1] = __builtin_amdgcn_mfma_f32_32x32x16_bf16(f1_, (p_), O[1], 0, 0, 0); \
                    O[2] = __builtin_amdgcn_mfma_f32_32x32x16_bf16(f2_, (p_), O[2], 0, 0, 0); O[3] = __builtin_amdgcn_mfma_f32_32x32x16_bf16(f3_, (p_), O[3], 0, 0, 0); __builtin_amdgcn_sched_barrier(0); } while (0)
                DF_PVSTEP(0, p0); DF_PVSTEP(16, p1); DF_PVSTEP(32, p2); DF_PVSTEP(48, p3);
#undef DF_PVSTEP
                }
            }
            if (more) stage_write<128>(sr, lds + ((it + 1) & 1) * BUF, tid);
            __syncthreads();
        }
        const float ltot = lrun + __shfl_xor(lrun, 32);
        const float inv = 1.0f / ltot;
        LAS unsigned char* stash = lds + 2 * BUF + w * 8192 + lane * 16;
        if (cm == 0) {
#pragma unroll
            for (int c = 0; c < 4; ++c)
#pragma unroll
                for (int hf = 0; hf < 2; ++hf) { u32x4 pw;
                    pw.x = pk_bf16(O[c][8 * hf] * inv, O[c][8 * hf + 1] * inv); pw.y = pk_bf16(O[c][8 * hf + 2] * inv, O[c][8 * hf + 3] * inv);
                    pw.z = pk_bf16(O[c][8 * hf + 4] * inv, O[c][8 * hf + 5] * inv); pw.w = pk_bf16(O[c][8 * hf + 6] * inv, O[c][8 * hf + 7] * inv);
                    *(LAS u32x4*)(stash + (2 * c + hf) * 1024) = pw; }
        } else {
            const float li = lam * inv; float ss = 0.f;
#pragma unroll
            for (int c = 0; c < 4; ++c)
#pragma unroll
                for (int hf = 0; hf < 2; ++hf) { const u32x4 pw = *(const LAS u32x4*)(stash + (2 * c + hf) * 1024);
#pragma unroll
                    for (int q = 0; q < 4; ++q) { const float r0 = bflo(pw[q]) - li * O[c][8 * hf + 2 * q], r1 = bfhi(pw[q]) - li * O[c][8 * hf + 2 * q + 1]; ss += r0 * r0 + r1 * r1; } }
            ss += __shfl_xor(ss, 32);
            const float rs = 0.8f / sqrtf(ss * (1.0f / 128.0f) + RMS_EPS);
            bf16_t* op = mix + (size_t)(b * SEQ + t) * D + 512 + hb * 128;
#pragma unroll
            for (int c = 0; c < 4; ++c)
#pragma unroll
                for (int hf = 0; hf < 2; ++hf) { const u32x4 pw = *(const LAS u32x4*)(stash + (2 * c + hf) * 1024);
#pragma unroll
                    for (int mm = 0; mm < 2; ++mm) { const int m = 2 * hf + mm, d0 = 32 * c + 8 * m + 4 * hh; const f32x4 g = *(const f32x4*)(subln + d0);
                        const float r0 = bflo(pw[2 * mm]) - li * O[c][4 * m], r1 = bfhi(pw[2 * mm]) - li * O[c][4 * m + 1], r2 = bflo(pw[2 * mm + 1]) - li * O[c][4 * m + 2], r3 = bfhi(pw[2 * mm + 1]) - li * O[c][4 * m + 3];
                        if (PLAIN_FP8) *(unsigned*)((unsigned char*)mix + (size_t)(b * SEQ + t) * D + 512 + hb * 128 + d0) = pk_fp8x4(r0 * rs * g[0] * MSCALE, r1 * rs * g[1] * MSCALE, r2 * rs * g[2] * MSCALE, r3 * rs * g[3] * MSCALE);
                        else { u32x2 wv; wv.x = pk_bf16(r0 * rs * g[0], r1 * rs * g[1]); wv.y = pk_bf16(r2 * rs * g[2], r3 * rs * g[3]); *(u32x2*)(op + d0) = wv; } } }
        }
    }
}

DI void phase(Frame& F) {
    const bf16_t* proj = WSP(bf16_t, WS_R1); bf16_t* mix = WSP(bf16_t, WS_R2);
    float lam;
    { const float a = F.in[3][F.lane] * F.in[4][F.lane], c = F.in[5][F.lane] * F.in[6][F.lane];
      lam = expf(wave_sum(a)) - expf(wave_sum(c)) + 0.2f; }
    const float* subln = F.in[7];
    const int j = F.vcu;
#ifndef NO_DIFF
    for (int L = j; L < 256; L += F.G) {
#pragma unroll 1
        for (int rep = 0; rep < 2; ++rep) { const int L2 = rep ? 511 - L : L, qt = 7 - (L2 >> 6), bh = L2 & 63; diff_unit(F, bh >> 2, bh & 3, qt, proj, mix, lam, subln); }
    }
#endif
#ifndef NO_SB
    for (int L = j; L < 1024; L += F.G) {
        const int qt = 7 - (L >> 7), bh = L & 127;
        __syncthreads();
        sb_unit(F, bh >> 3, bh & 7, qt, proj, mix);
    }
#endif
    __syncthreads();
}
}

namespace lnr {
constexpr int WP = 2064;
DI void phase(Frame& F, int layer) {
    const int lane = F.lane, w = F.wave, tid = F.tid;
    const bf16_t* pre = WSP(bf16_t, WS_PRE); bf16_t* h1 = WSP(bf16_t, WS_H1); bf16_t* hb = WSP(bf16_t, WS_HB);
    const float* g = F.in[12] + layer * D; const float* bta = F.in[13] + layer * D; const float* rb = F.in[15] + layer * NEXP;
    const bf16_t* wr = WSP(bf16_t, WS_WR) + (size_t)layer * NEXP * D;
    unsigned* cnt = (unsigned*)(F.ctl + (layer ? CW_CNT1 : CW_CNT0));
    int* perm = WSP(int, WS_PERM); int* toker = WSP(int, WS_TOKER); float* tokg = WSP(float, WS_TOKG);
    LAS unsigned char* wl = F.lds;
    LAS float* gl = (LAS float*)(F.lds + 32 * WP);
    LAS int* ints = (LAS int*)(F.lds + LDS_INTS);
    LAS int* hist = ints + 96; LAS int* base = ints + 128;
    for (int i = tid; i < 32 * 128; i += NTHR) { const int r = i >> 7, c = i & 127; *(LAS u32x4*)(wl + r * WP + c * 16) = *(const u32x4*)(wr + (size_t)r * D + c * 8); }
    for (int i = tid; i < D; i += NTHR) { gl[i] = g[i]; gl[D + i] = bta[i]; }
    for (int ub = F.vcu; ub < T / 128; ub += F.G) {
        if (tid < 32) hist[tid] = 0;
        __syncthreads();
        const int r0 = ub * 128 + w * 16;
        float mean_l, rstd_l;
        { const bf16_t* rp = pre + (size_t)(r0 + (lane & 15)) * D + 8 * (lane >> 4);
          float s1 = 0.f, s2 = 0.f;
#pragma unroll 8
          for (int s = 0; s < 32; ++s) { const u32x4 xx = *(const u32x4*)(rp + 32 * s);
#pragma unroll
              for (int e = 0; e < 4; ++e) { const float a = bflo(xx[e]), c = bfhi(xx[e]); s1 += a + c; s2 += a * a + c * c; } }
          s1 += __shfl_xor(s1, 16); s2 += __shfl_xor(s2, 16); s1 += __shfl_xor(s1, 32); s2 += __shfl_xor(s2, 32);
          mean_l = s1 * (1.0f / D);
          const float var = fmaxf(s2 * (1.0f / D) - mean_l * mean_l, 0.0f);
          rstd_l = 1.0f / sqrtf(var + LN_EPS); }
        const int tok = lane & 15, q = lane >> 4; const size_t row = (size_t)(r0 + tok);
        f32x4 acc0 = {0.f, 0.f, 0.f, 0.f}, acc1 = {0.f, 0.f, 0.f, 0.f};
#pragma unroll 2
        for (int s = 0; s < 32; ++s) {
            const int k0 = 32 * s + 8 * q;
            const u32x4 xx = *(const u32x4*)(pre + row * D + k0);
            const f32x4 xa = {bflo(xx.x), bfhi(xx.x), bflo(xx.y), bfhi(xx.y)}, xb = {bflo(xx.z), bfhi(xx.z), bflo(xx.w), bfhi(xx.w)};
            const f32x4 ga = *(const LAS f32x4*)(gl + k0), gb = *(const LAS f32x4*)(gl + k0 + 4), ba = *(const LAS f32x4*)(gl + D + k0), bb = *(const LAS f32x4*)(gl + D + k0 + 4);
            const f32x4 ya = (xa - mean_l) * rstd_l * ga + ba, yb = (xb - mean_l) * rstd_l * gb + bb;
            u32x4 pw; pw.x = pk_bf16(ya[0], ya[1]); pw.y = pk_bf16(ya[2], ya[3]); pw.z = pk_bf16(yb[0], yb[1]); pw.w = pk_bf16(yb[2], yb[3]);
            *(u32x4*)(h1 + row * D + k0) = pw;
            if (!MOE_FP8) *(u32x4*)(hb + row * D + k0) = pw;
            else { u32x2 w8; const f32x4 za = ya * XSCALE, zb = yb * XSCALE;
                int p = __builtin_amdgcn_cvt_pk_fp8_f32(fminf(fmaxf(za[0], -440.f), 440.f), fminf(fmaxf(za[1], -440.f), 440.f), 0, false); p = __builtin_amdgcn_cvt_pk_fp8_f32(fminf(fmaxf(za[2], -440.f), 440.f), fminf(fmaxf(za[3], -440.f), 440.f), p, true); w8.x = (unsigned)p;
                p = __builtin_amdgcn_cvt_pk_fp8_f32(fminf(fmaxf(zb[0], -440.f), 440.f), fminf(fmaxf(zb[1], -440.f), 440.f), 0, false); p = __builtin_amdgcn_cvt_pk_fp8_f32(fminf(fmaxf(zb[2], -440.f), 440.f), fminf(fmaxf(zb[3], -440.f), 440.f), p, true); w8.y = (unsigned)p;
                *(u32x2*)((unsigned char*)hb + row * D + k0) = w8; }
            const bf16x8 bfrag = __builtin_bit_cast(bf16x8, pw);
            const bf16x8 a0 = *(const LAS bf16x8*)(wl + tok * WP + k0 * 2), a1 = *(const LAS bf16x8*)(wl + (16 + tok) * WP + k0 * 2);
            acc0 = __builtin_amdgcn_mfma_f32_16x16x32_bf16(a0, bfrag, acc0, 0, 0, 0);
            acc1 = __builtin_amdgcn_mfma_f32_16x16x32_bf16(a1, bfrag, acc1, 0, 0, 0);
        }
        float v[8];
#pragma unroll
        for (int i = 0; i < 4; ++i) { v[i] = acc0[i] + rb[4 * q + i]; v[4 + i] = acc1[i] + rb[16 + 4 * q + i]; }
        float tv[4]; int te[4];
#pragma unroll
        for (int k = 0; k < 4; ++k) {
            float bv = v[0]; int be = 4 * q;
#pragma unroll
            for (int i = 1; i < 8; ++i) { const int ee = (i < 4) ? 4 * q + i : 16 + 4 * q + (i - 4); if (v[i] > bv) { bv = v[i]; be = ee; } }
#pragma unroll
            for (int o = 16; o <= 32; o <<= 1) { const float ov = __shfl_xor(bv, o); const int oe = __shfl_xor(be, o); if (ov > bv || (ov == bv && oe < be)) { bv = ov; be = oe; } }
            tv[k] = bv; te[k] = be;
#pragma unroll
            for (int i = 0; i < 8; ++i) { const int ee = (i < 4) ? 4 * q + i : 16 + 4 * q + (i - 4); if (ee == be) v[i] = -INFINITY; }
        }
        float ge[4], gs = 0.f;
#pragma unroll
        for (int k = 0; k < 4; ++k) { ge[k] = __expf(tv[k] - tv[0]); gs += ge[k]; }
        const float ginv = 1.0f / gs;
        const int my_e = q == 0 ? te[0] : q == 1 ? te[1] : q == 2 ? te[2] : te[3];
        const float my_g = (q == 0 ? ge[0] : q == 1 ? ge[1] : q == 2 ? ge[2] : ge[3]) * ginv;
        const int rloc = __hip_atomic_fetch_add(hist + my_e, 1, __ATOMIC_RELAXED, __HIP_MEMORY_SCOPE_WORKGROUP);
        __syncthreads();
        if (tid < 32) base[tid] = (int)__hip_atomic_fetch_add(cnt + tid, (unsigned)hist[tid], RLX_AGENT);
        __syncthreads();
        const int rank = base[my_e] + rloc;
        perm[(size_t)my_e * T + rank] = (int)row;
        toker[row * 4 + q] = (my_e << 16) | rank;
        tokg[row * 4 + q] = my_g;
        __syncthreads();
    }
}
}

DI int moe_tileoff(Frame& F, int layer) {
    LAS int* ints = (LAS int*)(F.lds + LDS_INTS);
    unsigned* cnt = (unsigned*)(F.ctl + (layer ? CW_CNT1 : CW_CNT0));
    __syncthreads();
    if (F.tid < 32) ints[F.tid] = (int)__hip_atomic_load(cnt + F.tid, RLX_AGENT);
    __syncthreads();
    if (F.tid < 64) {
        const int tl = (F.tid < 32) ? (ints[F.tid] + 255) >> 8 : 0; int inc = tl;
#pragma unroll
        for (int o = 1; o < 32; o <<= 1) { const int up = __shfl_up(inc, o); if ((F.tid & 63) >= o) inc += up; }
        if (F.tid < 32) ints[32 + F.tid] = inc - tl;
        if (F.tid == 31) ints[64] = inc;
    }
    __syncthreads();
    return ints[64];
}

DI void cmb_phase(Frame& F, int layer, float* outf, bf16_t* outb) {
    const int ntile = moe_tileoff(F, layer); (void)ntile;
    const LAS int* ints = (const LAS int*)(F.lds + LDS_INTS);
    const bf16_t* h1 = WSP(bf16_t, WS_H1); const unsigned char* y = WSP(unsigned char, WS_R1);
    const int* toker = WSP(int, WS_TOKER); const float* tokg = WSP(float, WS_TOKG);
    const float* g = F.in[20] + layer * D; const float* bta = F.in[21] + layer * D;
    const int gw = F.vcu * NWAVES + F.wave, NGW = F.G * NWAVES, lane = F.lane;
    struct RowLd { u32x2 h[4]; int yv[4][4]; f32x4 gg; };
    auto issue = [&](int row, const i32x4& er, const f32x4& gg, RowLd& L) {
        L.gg = gg;
#pragma unroll
        for (int k = 0; k < 4; ++k) { const int e = er[k] >> 16, rank = er[k] & 0xffff; const size_t pos = (size_t)ints[32 + e] * 256 + rank;
#pragma unroll
            for (int j = 0; j < 4; ++j) L.yv[k][j] = __builtin_nontemporal_load((const int*)(y + pos * D) + lane + 64 * j); }
#pragma unroll
        for (int j = 0; j < 4; ++j) L.h[j] = *((const u32x2*)(h1 + (size_t)row * D) + lane + 64 * j);
    };
    i32x4 er1 = {0, 0, 0, 0}; f32x4 gg1 = {0.f, 0.f, 0.f, 0.f}; RowLd L0, L1;
    if (gw < T) { const i32x4 er0 = *(const i32x4*)(toker + (size_t)gw * 4); const f32x4 gg0 = *(const f32x4*)(tokg + (size_t)gw * 4); issue(gw, er0, gg0, L0); }
    if (gw + NGW < T) { er1 = *(const i32x4*)(toker + (size_t)(gw + NGW) * 4); gg1 = *(const f32x4*)(tokg + (size_t)(gw + NGW) * 4); }
    for (int row = gw; row < T; row += NGW) {
        const int rown = row + NGW, rownn = row + 2 * NGW;
        i32x4 er2 = {0, 0, 0, 0}; f32x4 gg2 = {0.f, 0.f, 0.f, 0.f};
        if (rownn < T) { er2 = *(const i32x4*)(toker + (size_t)rownn * 4); gg2 = *(const f32x4*)(tokg + (size_t)rownn * 4); }
        if (rown < T) issue(rown, er1, gg1, L1);
        f32x4 v[4]; float s = 0.f;
#pragma unroll
        for (int j = 0; j < 4; ++j) {
            f32x4 a = (f32x4){bflo(L0.h[j].x), bfhi(L0.h[j].x), bflo(L0.h[j].y), bfhi(L0.h[j].y)} * ALPHA;
#pragma unroll
            for (int k = 0; k < 4; ++k) { const int yy = L0.yv[k][j]; const float gk = L0.gg[k] * (1.0f / YSCALE);
                const f32x2 ylo = __builtin_amdgcn_cvt_pk_f32_fp8(yy, false), yhi = __builtin_amdgcn_cvt_pk_f32_fp8(yy, true);
                a[0] += gk * ylo[0]; a[1] += gk * ylo[1]; a[2] += gk * yhi[0]; a[3] += gk * yhi[1]; }
            v[j] = a; s += (a[0] + a[1]) + (a[2] + a[3]);
        }
        const float mean = wave_sum(s) * (1.0f / D); float s2 = 0.f;
#pragma unroll
        for (int j = 0; j < 4; ++j) { v[j] = v[j] - mean; s2 += (v[j][0] * v[j][0] + v[j][1] * v[j][1]) + (v[j][2] * v[j][2] + v[j][3] * v[j][3]); }
        const float rstd = 1.0f / sqrtf(wave_sum(s2) * (1.0f / D) + LN_EPS);
#pragma unroll
        for (int j = 0; j < 4; ++j) { const f32x4 gv = *((const f32x4*)g + lane + 64 * j), bv = *((const f32x4*)bta + lane + 64 * j);
            const f32x4 o = v[j] * rstd * gv + bv;
            if (outf) __builtin_nontemporal_store(o, (f32x4*)(outf + (size_t)row * D) + lane + 64 * j);
            if (outb) { u32x2 wv; wv.x = pk_bf16(o[0], o[1]); wv.y = pk_bf16(o[2], o[3]); *((u32x2*)(outb + (size_t)row * D) + lane + 64 * j) = wv;
                if (IN1_FP8) *((unsigned*)(WSP(unsigned char, WS_X8) + (size_t)row * D) + lane + 64 * j) = pk_fp8x4(o[0] * XSCALE, o[1] * XSCALE, o[2] * XSCALE, o[3] * XSCALE); } }
        L0 = L1; er1 = er2; gg1 = gg2;
    }
}

DI void moe_up_phase(Frame& F, int layer) {
    const int ntile = moe_tileoff(F, layer);
    LAS int* ints = (LAS int*)(F.lds + LDS_INTS);
    LAS unsigned* tab = (LAS unsigned*)(F.lds + LDS_TAB);
    constexpr unsigned RB = 1024 * MOE_EB;
    pg8::MoeSched S; S.to_lane = (F.lane < 32) ? ints[33 + F.lane] : 0x7fffffff; S.total = ntile * 8; S.G = F.G; S.c = F.vcu; S.ntshift = 3; S.gather = true; S.tab = tab; S.rowb = RB;
    S.W = (const char*)(WSP(unsigned char, WS_WGU) + (size_t)layer * 32 * 2048 * RB); S.wexp = (size_t)2048 * RB; S.wpn = (size_t)128 * RB;
    const int* perm = WSP(int, WS_PERM);
    { int tk[18];
#pragma unroll
      for (int i = 0; i < 18; ++i) { pg8::Unit u; tk[i] = -1;
          if (S.next(i, u) && F.tid < 256) { const int mloc = u.pm - ints[32 + u.e], r = mloc * 256 + F.tid; tk[i] = (r < ints[u.e]) ? perm[(size_t)u.e * T + r] : 0; } }
#pragma unroll
      for (int i = 0; i < 18; ++i) if (tk[i] >= 0) tab[i * 256 + F.tid] = (unsigned)tk[i] * RB; }
    __syncthreads();
    pg8::EpiSwiglu E{WSP(unsigned char, WS_R2), F.in[17] + (size_t)layer * 32 * 2048, MOE_FP8 ? 1.0f / (XSCALE * WSCALE) : 1.0f};
    pg8::gemm_phase<pg8::EpiSwiglu, pg8::MoeSched, MOE_FP8>(F.lds + LDS_STAGE, (const char*)WSP(unsigned char, WS_HB), RB, (size_t)1024 * RB, S, E);
}
DI void moe_down_phase(Frame& F, int layer) {
    const int ntile = moe_tileoff(F, layer);
    LAS int* ints = (LAS int*)(F.lds + LDS_INTS);
    constexpr unsigned RB = 1024 * MOE_EB;
    pg8::MoeSched S; S.to_lane = (F.lane < 32) ? ints[33 + F.lane] : 0x7fffffff; S.total = ntile * 4; S.G = F.G; S.c = F.vcu; S.ntshift = 2; S.gather = false; S.tab = nullptr; S.rowb = RB;
    S.W = (const char*)(WSP(unsigned char, WS_WD) + (size_t)layer * 32 * 1024 * RB); S.wexp = (size_t)1024 * RB; S.wpn = (size_t)256 * RB;
    pg8::EpiDown E{WSP(unsigned char, WS_R1), F.in[19] + (size_t)layer * 32 * 1024, MOE_FP8 ? 1.0f / (ASCALE * WSCALE) : 1.0f};
    pg8::gemm_phase<pg8::EpiDown, pg8::MoeSched, MOE_FP8>(F.lds + LDS_STAGE, (const char*)WSP(unsigned char, WS_R2), RB, (size_t)128 * RB, S, E);
}

namespace idx1 {
constexpr int PITCH = OD_COLS_P;
DI unsigned f2key(float f) { const unsigned u = __float_as_uint(f + 0.0f); return u ^ ((u >> 31) ? 0xffffffffu : 0x80000000u); }
DI int mbcnt64(unsigned long long m) { return (int)__builtin_amdgcn_mbcnt_hi((unsigned)(m >> 32), __builtin_amdgcn_mbcnt_lo((unsigned)m, 0u)); }
DI int wsum6(int c) { int t = 0;
#pragma unroll
    for (int b = 0; b < 6; ++b) t += __builtin_popcountll(__ballot((c >> b) & 1)) << b;
    return t; }
template <int NJ> DI void select_finish(const unsigned (&key)[NJ], unsigned th, int* op, LAS unsigned* bnd, LAS int* list, int lane);
template <int NJ> DI void select256x2(const LAS float* rowA, const LAS float* rowB, int nA, int nB, int* opA, int* opB, LAS unsigned* bnd, LAS int* list, int lane) {
    unsigned keyA[NJ], keyB[NJ];
#pragma unroll
    for (int j = 0; j < NJ; ++j) { const int p = lane + 64 * j; keyA[j] = (p < nA) ? f2key(rowA[p]) : 0u; keyB[j] = (p < nB) ? f2key(rowB[p]) : 0u; }
    unsigned thA = 0u, thB = 0u;
#pragma unroll 1
    for (int bit = 15; bit >= 0; --bit) {
        const unsigned candA = (thA | (1u << bit)) << 16, candB = (thB | (1u << bit)) << 16; int cA = 0, cB = 0;
#pragma unroll
        for (int j = 0; j < NJ; ++j) { cA += (keyA[j] >= candA) ? 1 : 0; cB += (keyB[j] >= candB) ? 1 : 0; }
        int tA = 0, tB = 0;
#pragma unroll
        for (int b = 0; b < 6; ++b) { tA += __builtin_popcountll(__ballot((cA >> b) & 1)) << b; tB += __builtin_popcountll(__ballot((cB >> b) & 1)) << b; }
        if (tA >= 256) thA |= (1u << bit);
        if (tB >= 256) thB |= (1u << bit);
    }
    select_finish<NJ>(keyA, thA, opA, bnd, list, lane);
    select_finish<NJ>(keyB, thB, opB, bnd, list, lane);
}
template <int NJ> DI void select_finish(const unsigned (&key)[NJ], unsigned th, int* op, LAS unsigned* bnd, LAS int* list, int lane) {
    const unsigned lo32 = th << 16;
    int cg = 0, ce = 0;
#pragma unroll
    for (int j = 0; j < NJ; ++j) { const unsigned d = key[j] - lo32; cg += (key[j] >= lo32 && d > 0xffffu) ? 1 : 0; ce += (key[j] >= lo32 && d <= 0xffffu) ? 1 : 0; }
    int G = 0, pre = 0, B = 0, preE = 0;
#pragma unroll
    for (int b = 0; b < 6; ++b) { const unsigned long long m = __ballot((cg >> b) & 1); G += __builtin_popcountll(m) << b; pre += mbcnt64(m) << b;
        const unsigned long long me = __ballot((ce >> b) & 1); B += __builtin_popcountll(me) << b; preE += mbcnt64(me) << b; }
    const int dummy = 256 + lane;
    unsigned lo32b = lo32; asm volatile("" : "+s"(lo32b));
    {   int w = pre;
#pragma unroll
        for (int j = 0; j < NJ; ++j) { const unsigned d = key[j] - lo32b; const bool ab = key[j] >= lo32b && d > 0xffffu; list[ab ? w : dummy] = lane + 64 * j; w += ab ? 1 : 0; }
    }
    const int need = 256 - G;
    if (B <= 64) {
        unsigned lo32c = lo32; asm volatile("" : "+s"(lo32c));
        {   int w = preE;
#pragma unroll
            for (int j = 0; j < NJ; ++j) { const unsigned d = key[j] - lo32c; const bool eq = key[j] >= lo32c && d <= 0xffffu; bnd[eq ? w : 64 + lane] = (d << 11) | (unsigned)(2047 - (lane + 64 * j)); w += eq ? 1 : 0; }
        }
        LDS_WAIT(); asm volatile("" ::: "memory");
        const unsigned mine = (lane < B) ? bnd[lane] : 0u;
        int rank = 0;
#pragma unroll 1
        for (int i = 0; i < B; ++i) { const unsigned o = (unsigned)__builtin_amdgcn_readlane((int)mine, i); rank += (o > mine) ? 1 : 0; }
        list[(lane < B && rank < need) ? G + rank : dummy] = 2047 - (int)(mine & 2047u);
    } else {
        unsigned tl = 0u;
#pragma unroll 1
        for (int bit = 15; bit >= 0; --bit) {
            const unsigned cand = lo32 | tl | (1u << bit); int c = 0;
#pragma unroll
            for (int j = 0; j < NJ; ++j) c += (key[j] >= cand) ? 1 : 0;
            if (wsum6(c) >= 256) tl |= (1u << bit);
        }
        const unsigned tau = lo32 | tl; int base = G;
#pragma unroll
        for (int j = 0; j < NJ; ++j) { const bool sel = key[j] > tau && (key[j] - lo32) <= 0xffffu; const unsigned long long m = __ballot(sel);
            list[sel ? base + mbcnt64(m) : dummy] = lane + 64 * j; base += __builtin_popcountll(m); }
        const int need2 = 256 - base; int eb = 0;
#pragma unroll
        for (int j = 0; j < NJ; ++j) { const bool eq = key[j] == tau; const unsigned long long m = __ballot(eq); const int pos = eb + mbcnt64(m);
            list[(eq && pos < need2) ? base + pos : dummy] = lane + 64 * j; eb += __builtin_popcountll(m); }
    }
    LDS_WAIT(); asm volatile("" ::: "memory");
    *(i32x4*)(op + 4 * lane) = *(const LAS i32x4*)(list + 4 * lane);
    LDS_WAIT(); asm volatile("" ::: "memory");
}
DI void phase(Frame& F) {
    const int lane = F.lane, w = F.wave, tid = F.tid, hh = lane >> 5;
    const bf16_t* proj = WSP(bf16_t, WS_R1);
    { const float* kvw = F.in[9]; bf16_t* ckv = WSP(bf16_t, WS_CKV);
      const int gw = F.vcu * NWAVES + w, NGW = F.G * NWAVES;
      const float w0 = kvw[2 * lane], w1 = kvw[2 * lane + 1];
      for (int row = gw; row < T; row += 4 * NGW) {
          unsigned c[4];
#pragma unroll
          for (int u = 0; u < 4; ++u) c[u] = (row + u * NGW < T) ? *(const unsigned*)(proj + (size_t)(row + u * NGW) * PITCH + 2048 + 2 * lane) : 0u;
#pragma unroll
          for (int u = 0; u < 4; ++u) { if (row + u * NGW >= T) break;
              const float a = bflo(c[u]), b = bfhi(c[u]);
              const float ss = wave_sum(a * a + b * b);
              const float rs = 1.0f / sqrtf(ss * (1.0f / 128.0f) + RMS_EPS);
              *(unsigned*)(ckv + (size_t)(row + u * NGW) * 128 + 2 * lane) = pk_bf16(a * rs * w0, b * rs * w1); }
      } }
    LAS float* sc = (LAS float*)F.lds;
    LAS float* wq = (LAS float*)(F.lds + LDS_TAB);
    LAS unsigned* bnd = (LAS unsigned*)(F.lds + LDS_TAB + 1024) + w * 128;
    LAS int* list = (LAS int*)(F.lds + LDS_TAB + 8192) + w * 320;
    int* idxo = WSP(int, WS_IDX);
    for (int u = F.vcu; u < T / 16; u += F.G) {
        const int b = u >> 7, q0 = (((u & 127) + 16 * (b >> 1)) & 127) * 16;
        __syncthreads();
        if (tid < 128) wq[tid] = bf2f(proj[(size_t)(b * SEQ + q0 + (tid >> 3)) * PITCH + 2752 + (tid & 7)]);
        bf16x8 qf[4][4];
#pragma unroll
        for (int rg = 0; rg < 4; ++rg) { const bf16_t* qp = proj + (size_t)(b * SEQ + q0 + 4 * rg + ((lane & 31) >> 3)) * PITCH + 2176 + (lane & 7) * 64 + hh * 8;
#pragma unroll
            for (int s = 0; s < 4; ++s) qf[rg][s] = *(const bf16x8*)(qp + 16 * s); }
        const int nkb = (q0 + 15) / 32 + 1;
        const bf16_t* kbase = proj + (size_t)(b * SEQ + (lane & 31)) * PITCH + 2688 + hh * 8;
        bf16x8 kf[4], kn[4];
        if (w < nkb) {
#pragma unroll
            for (int s = 0; s < 4; ++s) kf[s] = *(const bf16x8*)(kbase + (size_t)(32 * w) * PITCH + 16 * s); }
        __syncthreads();
        for (int kb = w; kb < nkb; kb += NWAVES) {
            if (kb + NWAVES < nkb) {
#pragma unroll
                for (int s = 0; s < 4; ++s) kn[s] = *(const bf16x8*)(kbase + (size_t)(32 * (kb + NWAVES)) * PITCH + 16 * s); }
#pragma unroll
            for (int rg = 0; rg < 4; ++rg) {
                f32x16 dd = {};
#pragma unroll
                for (int s = 0; s < 4; ++s) dd = __builtin_amdgcn_mfma_f32_32x32x16_bf16(qf[rg][s], kf[s], dd, 0, 0, 0);
                float part[4];
#pragma unroll
                for (int q4 = 0; q4 < 4; ++q4) { const f32x4 wv = *(const LAS f32x4*)(wq + (4 * rg + q4) * 8 + 4 * hh);
                    part[q4] = wv[0] * fmaxf(dd[4 * q4], 0.f) + wv[1] * fmaxf(dd[4 * q4 + 1], 0.f) + wv[2] * fmaxf(dd[4 * q4 + 2], 0.f) + wv[3] * fmaxf(dd[4 * q4 + 3], 0.f); }
#pragma unroll
                for (int q4 = 0; q4 < 4; ++q4) part[q4] += __shfl_xor(part[q4], 32);
                const int key = 32 * kb + (lane & 31);
                if (hh == 0) { sc[(4 * rg + 0) * 2048 + key] = part[0]; sc[(4 * rg + 1) * 2048 + key] = part[1]; }
                else         { sc[(4 * rg + 2) * 2048 + key] = part[2]; sc[(4 * rg + 3) * 2048 + key] = part[3]; }
            }
#pragma unroll
            for (int s = 0; s < 4; ++s) kf[s] = kn[s];
        }
        __syncthreads();
        {
            const int qi = 2 * w, t = q0 + qi, n = t + 1;
            int* opA = idxo + (size_t)(b * SEQ + t) * 256; int* opB = opA + 256;
            if (n + 1 <= 256) {
#pragma unroll
                for (int j = 0; j < 4; ++j) { const int p = lane + 64 * j; opA[p] = (p < n) ? p : -1; opB[p] = (p < n + 1) ? p : -1; }
            } else {
                const LAS float* rowA = sc + qi * 2048; const LAS float* rowB = rowA + 2048;
                if (n + 1 <= 512) select256x2<8>(rowA, rowB, n, n + 1, opA, opB, bnd, list, lane);
                else if (n + 1 <= 1024) select256x2<16>(rowA, rowB, n, n + 1, opA, opB, bnd, list, lane);
                else if (n + 1 <= 1536) select256x2<24>(rowA, rowB, n, n + 1, opA, opB, bnd, list, lane);
                else select256x2<32>(rowA, rowB, n, n + 1, opA, opB, bnd, list, lane);
            }
        }
    }
    __syncthreads();
}
}

namespace spa1 {
constexpr int RP = 272;
constexpr int PITCH = OD_COLS_P;
DI s16x4 trrd(const LAS unsigned char* p) { typedef short v4i16_t __attribute__((ext_vector_type(4))); return __builtin_bit_cast(s16x4, __builtin_amdgcn_ds_read_tr16_b64_v4i16((LAS v4i16_t*)p)); }
DI void phase(Frame& F) {
    const int lane = F.lane, w = F.wave, hd = lane & 15, g = lane >> 4;
    const bf16_t* proj = WSP(bf16_t, WS_R1); const bf16_t* ckv = WSP(bf16_t, WS_CKV); const int* idx = WSP(int, WS_IDX); bf16_t* of = WSP(bf16_t, WS_R2);
    LAS unsigned char* buf = F.lds + w * (32 * RP + 2048);
    LAS float* dl = (LAS float*)(buf + 32 * RP);
    LAS unsigned* ofl = (LAS unsigned*)(buf + 32 * RP + 1024);
    const float slope2 = fexp2(-0.5f * (float)(hd + 1)) * LOG2E, sc2 = 0.08838834764831845f * LOG2E;
    const int gw = F.vcu * NWAVES + w, NGW = F.G * NWAVES;
#define SPA_Q(jj, b_, t_, row_) const int lin_##jj = gw + (jj) * NGW, b_ = lin_##jj / SEQ, t_ = (lin_##jj + 131 * b_) % SEQ; const size_t row_ = (size_t)(b_ * SEQ + t_)
    i32x4 idr; bf16x8 qn[4];
    if (gw < T) { SPA_Q(0, b0_, t0_, row0_); (void)t0_; idr = *(const i32x4*)(idx + row0_ * 256 + 4 * lane);
        const bf16_t* qp = proj + row0_ * PITCH + hd * 128 + g * 8;
#pragma unroll
        for (int s = 0; s < 4; ++s) qn[s] = *(const bf16x8*)(qp + 32 * s); }
    for (int j = 0; gw + j * NGW < T; ++j) {
        const int lin = gw + j * NGW, b = lin / SEQ, t = (lin + 131 * b) % SEQ;
        const size_t row = (size_t)(b * SEQ + t);
        const int nsel = (t + 1 < 256) ? t + 1 : 256, nch = (nsel + 31) >> 5;
        { f32x4 d4;
#pragma unroll
          for (int e = 0; e < 4; ++e) d4[e] = idr[e] < 0 ? 1.0e30f : (float)(t - idr[e]);
          *(LAS f32x4*)(dl + 4 * lane) = d4; }
        { u32x4 o4;
#pragma unroll
          for (int e = 0; e < 4; ++e) o4[e] = (unsigned)(idr[e] < 0 ? 0 : idr[e]) * 256u;
          *(LAS u32x4*)(ofl + 4 * lane) = o4; }
        const char* ckvb = (const char*)(ckv + (size_t)b * SEQ * 128) + 16 * hd;
        bf16x8 qf[4];
#pragma unroll
        for (int s = 0; s < 4; ++s) qf[s] = qn[s];
        if (gw + (j + 1) * NGW < T) {
            const int lin2 = gw + (j + 1) * NGW, b2 = lin2 / SEQ, t2 = (lin2 + 131 * b2) % SEQ; const size_t row2 = (size_t)(b2 * SEQ + t2);
            idr = *(const i32x4*)(idx + row2 * 256 + 4 * lane);
            const bf16_t* qp = proj + row2 * PITCH + hd * 128 + g * 8;
#pragma unroll
            for (int s = 0; s < 4; ++s) qn[s] = *(const bf16x8*)(qp + 32 * s);
        }
        f32x4 O[8];
#pragma unroll
        for (int c = 0; c < 8; ++c) O[c] = (f32x4){0.f, 0.f, 0.f, 0.f};
        float mrun = -1.0e30f, lrun = 0.f;
#define SPA_CORE             const f32x4 kd0 = *(const LAS f32x4*)(dl + 32 * c + 4 * g) * slope2, kd1 = *(const LAS f32x4*)(dl + 32 * c + 16 + 4 * g) * slope2; \
            f32x4 s0 = {0.f, 0.f, 0.f, 0.f}, s1 = {0.f, 0.f, 0.f, 0.f}; \
_Pragma("unroll") \
            for (int s = 0; s < 4; ++s) { \
                const bf16x8 a0 = *(const LAS bf16x8*)(buf + hd * RP + (32 * s + 8 * g) * 2), a1 = *(const LAS bf16x8*)(buf + (16 + hd) * RP + (32 * s + 8 * g) * 2); \
                s0 = __builtin_amdgcn_mfma_f32_16x16x32_bf16(a0, qf[s], s0, 0, 0, 0); \
                s1 = __builtin_amdgcn_mfma_f32_16x16x32_bf16(a1, qf[s], s1, 0, 0, 0); \
            } \
            float mx = -INFINITY; \
_Pragma("unroll") \
            for (int i = 0; i < 4; ++i) { \
                s0[i] = s0[i] * sc2 - kd0[i]; \
                s1[i] = s1[i] * sc2 - kd1[i]; \
                mx = fmaxf(mx, fmaxf(s0[i], s1[i])); \
            } \
            mx = fmaxf(mx, __shfl_xor(mx, 16)); mx = fmaxf(mx, __shfl_xor(mx, 32)); \
            if (__ballot(mx > mrun + 8.0f) != 0ull) { const float mnew = fmaxf(mrun, mx), al = fexp2(mrun - mnew); mrun = mnew; lrun *= al; \
                _Pragma("unroll") for (int c8 = 0; c8 < 8; ++c8) O[c8] = O[c8] * al; } \
            float ls = 0.f; \
_Pragma("unroll") \
            for (int i = 0; i < 4; ++i) { s0[i] = fexp2(s0[i] - mrun); s1[i] = fexp2(s1[i] - mrun); ls += s0[i] + s1[i]; } \
            lrun += ls; \
            u32x4 pw; pw.x = pk_bf16(s0[0], s0[1]); pw.y = pk_bf16(s0[2], s0[3]); pw.z = pk_bf16(s1[0], s1[1]); pw.w = pk_bf16(s1[2], s1[3]); \
            const bf16x8 pf = __builtin_bit_cast(bf16x8, pw); \
            const int q = hd >> 2, p = hd & 3; \
_Pragma("unroll") \
            for (int c8 = 0; c8 < 8; ++c8) { \
                const LAS unsigned char* a = buf + (4 * g + q) * RP + (16 * c8 + 4 * p) * 2; \
                const s16x4 lo = trrd(a), hi = trrd(a + 16 * RP); \
                const bf16x8 vf = __builtin_shufflevector(lo, hi, 0, 1, 2, 3, 4, 5, 6, 7); \
                O[c8] = __builtin_amdgcn_mfma_f32_16x16x32_bf16(vf, pf, O[c8], 0, 0, 0); \
            }
        u32x4 grA[8], grB[8];
#define SPA_GLOAD(gr_, cc) do { _Pragma("unroll") for (int i_ = 0; i_ < 8; ++i_) gr_[i_] = *(const u32x4*)(ckvb + ofl[32 * (cc) + g + 4 * i_]); } while (0)
#define SPA_CHUNK(gr_, cnext_) do { \
            _Pragma("unroll") for (int i = 0; i < 8; ++i) *(LAS u32x4*)(buf + (g + 4 * i) * RP + 16 * hd) = gr_[i]; \
            if ((cnext_) < nch) SPA_GLOAD(gr_, (cnext_)); \
            SPA_CORE } while (0)
        SPA_GLOAD(grA, 0);
        if (nch > 1) SPA_GLOAD(grB, 1);
#pragma unroll 1
        for (int c2 = 0; c2 < nch; c2 += 2) {
            { const int c = c2; SPA_CHUNK(grA, c2 + 2); }
            if (c2 + 1 < nch) { const int c = c2 + 1; SPA_CHUNK(grB, c2 + 3); }
        }
#undef SPA_CHUNK
#undef SPA_GLOAD
        float lt = lrun + __shfl_xor(lrun, 16); lt += __shfl_xor(lt, 32);
        const float inv = 1.0f / lt;
        if (PLAIN_FP8) { unsigned char* op = (unsigned char*)of + row * 2048 + hd * 128 + 4 * g; const float iv = inv * MSCALE;
#pragma unroll
            for (int c8 = 0; c8 < 8; ++c8) *(unsigned*)(op + 16 * c8) = pk_fp8x4(O[c8][0] * iv, O[c8][1] * iv, O[c8][2] * iv, O[c8][3] * iv);
        } else { bf16_t* op = of + row * 2048 + hd * 128 + 4 * g;
#pragma unroll
            for (int c8 = 0; c8 < 8; ++c8) { u32x2 wv; wv.x = pk_bf16(O[c8][0] * inv, O[c8][1] * inv); wv.y = pk_bf16(O[c8][2] * inv, O[c8][3] * inv); *(u32x2*)(op + 16 * c8) = wv; } }
    }
}
}

constexpr int NPHASE = 16;
struct Args { const float* in[22]; float* out; unsigned char* ws; int ph_lo, ph_hi, bar_region, pad; };
__global__ void __launch_bounds__(NTHR, 2) fwd(Args args) {
    extern __shared__ __attribute__((aligned(16))) unsigned char lds_raw[];
    Frame F;
    F.lds = (LAS unsigned char*)lds_raw;
    F.tid = threadIdx.x; F.lane = F.tid & 63; F.wave = __builtin_amdgcn_readfirstlane(F.tid >> 6);
    F.G = gridDim.x; { const int bx = blockIdx.x; F.vcu = (F.G % 8 == 0) ? (bx % 8) * (F.G / 8) + bx / 8 : bx; }
    F.ws = args.ws; F.ctl = (gu32*)(args.ws + WS_CTL); F.out = args.out;
#pragma unroll
    for (int i = 0; i < 22; ++i) F.in[i] = args.in[i];
    volatile LAS unsigned* MISC = (volatile LAS unsigned*)(F.lds + LDS_MISC);
    if (F.tid < 64) MISC[F.tid] = 0u;
    __syncthreads();
    const int lo = args.ph_lo, hi = args.ph_hi;
    XcdBarrier bar; bar.bar = (unsigned*)(F.ctl + CW_BAR) + args.bar_region * XCD_BAR_WORDS; bar.x = 0; bar.st = nullptr;
    if (hi - lo > 1) bar = xcd_barrier_post((unsigned*)(F.ctl + CW_BAR) + args.bar_region * XCD_BAR_WORDS, MISC + 8);
#ifndef REPEAT_MASK
#define REPEAT_MASK 0
#endif
#ifndef PHASE_MASK
#define PHASE_MASK 0xFFFF
#endif
#define IN(k) (((PHASE_MASK >> (k)) & 1) && lo <= (k) && (k) < hi)
#define REPEAT_LOOP(k)
#define SEAM(k) do { if (IN(k) && IN((k) + 1)) xcd_barrier(bar); } while (0)

    if (IN(0)) { REPEAT_LOOP(0) { p0_prologue(F); } } SEAM(0);
    if (IN(1)) { REPEAT_LOOP(1) { pg8::PlainSched S; S.init(T, EV_COLS, D, D, WSP(unsigned char, WS_WEVIN), F.G, (int)blockIdx.x, IN_EB);
        pg8::EpiProj E{WSP(bf16_t, WS_R1), EV_COLS, IN_FP8 ? 1.0f / (XSCALE * WSCALE) : 1.0f};
        pg8::gemm_phase<pg8::EpiProj, pg8::PlainSched, IN_FP8>(F.lds + LDS_STAGE, (const char*)(IN_FP8 ? WSP(unsigned char, WS_X8) : WSP(unsigned char, WS_XB)), D * IN_EB, (size_t)128 * D * IN_EB, S, E); } } SEAM(1);
    if (IN(2)) { REPEAT_LOOP(2) { att0::phase(F); } } SEAM(2);
    if (IN(3)) { REPEAT_LOOP(3) { pg8::PlainSched S; S.init(T, D, D, D, WSP(unsigned char, WS_WEVOUT), F.G, (int)blockIdx.x, PL_EB);
        pg8::EpiRes E{nullptr, WSP(bf16_t, WS_XB), WSP(bf16_t, WS_PRE), PLAIN_FP8 ? 1.0f / (MSCALE * WSCALE) : 1.0f};
        pg8::gemm_phase<pg8::EpiRes, pg8::PlainSched, PLAIN_FP8>(F.lds + LDS_STAGE, (const char*)WSP(unsigned char, WS_R2), D * PL_EB, (size_t)128 * D * PL_EB, S, E); } } SEAM(3);
    if (IN(4)) { REPEAT_LOOP(4) { lnr::phase(F, 0); } } SEAM(4);
    if (IN(5)) { REPEAT_LOOP(5) { moe_up_phase(F, 0); } } SEAM(5);
    if (IN(6)) { REPEAT_LOOP(6) { moe_down_phase(F, 0); } } SEAM(6);
    if (IN(7)) { REPEAT_LOOP(7) { cmb_phase(F, 0, nullptr, WSP(bf16_t, WS_XB)); } } SEAM(7);
    if (IN(8)) { REPEAT_LOOP(8) { pg8::PlainSched S; S.init(T, OD_COLS_P, D, D, WSP(unsigned char, WS_WODIN), F.G, (int)blockIdx.x, IN1_EB);
        pg8::EpiProj E{WSP(bf16_t, WS_R1), OD_COLS_P, IN1_FP8 ? 1.0f / (XSCALE * WSCALE) : 1.0f};
        pg8::gemm_phase<pg8::EpiProj, pg8::PlainSched, IN1_FP8>(F.lds + LDS_STAGE, (const char*)(IN1_FP8 ? WSP(unsigned char, WS_X8) : WSP(unsigned char, WS_XB)), D * IN1_EB, (size_t)128 * D * IN1_EB, S, E); } } SEAM(8);
    if (IN(9)) { REPEAT_LOOP(9) { idx1::phase(F); } } SEAM(9);
    if (IN(10)) { REPEAT_LOOP(10) { spa1::phase(F); } } SEAM(10);
    if (IN(11)) { REPEAT_LOOP(11) { pg8::PlainSched S; S.init(T, D, 2048, 2048, WSP(unsigned char, WS_WCOMB), F.G, (int)blockIdx.x, PL_EB);
        pg8::EpiRes E{nullptr, WSP(bf16_t, WS_XB), WSP(bf16_t, WS_PRE), PLAIN_FP8 ? 1.0f / (MSCALE * WCSCALE) : 1.0f};
        pg8::gemm_phase<pg8::EpiRes, pg8::PlainSched, PLAIN_FP8>(F.lds + LDS_STAGE, (const char*)WSP(unsigned char, WS_R2), 2048 * PL_EB, (size_t)128 * 2048 * PL_EB, S, E); } } SEAM(11);
    if (IN(12)) { REPEAT_LOOP(12) { lnr::phase(F, 1); } } SEAM(12);
    if (IN(13)) { REPEAT_LOOP(13) { moe_up_phase(F, 1); } } SEAM(13);
    if (IN(14)) { REPEAT_LOOP(14) { moe_down_phase(F, 1); } } SEAM(14);
    if (IN(15)) { REPEAT_LOOP(15) { cmb_phase(F, 1, F.out, nullptr); } } SEAM(15);
#undef IN
#undef SEAM
}

extern "C" void kernel_launch(void* const* d_in, const int* in_sizes, int n_in, void* d_out, int out_size, void* d_ws, size_t ws_size, hipStream_t stream) {
    static int grid = 0;
    if (grid == 0) {
        if (n_in != 22 || out_size != T * D || ws_size < WS_END) { fprintf(stderr, "kernel_launch: unexpected shapes (n_in %d out %d ws %zu need %zu)\n", n_in, out_size, ws_size, (size_t)WS_END); grid = -1; return; }
        int dev = 0, cus = 0;
        if (hipGetDevice(&dev) != hipSuccess || hipDeviceGetAttribute(&cus, hipDeviceAttributeMultiprocessorCount, dev) != hipSuccess) { grid = -1; return; }
        if (hipFuncSetAttribute((const void*)fwd, hipFuncAttributeMaxDynamicSharedMemorySize, LDS_BYTES) != hipSuccess) { fprintf(stderr, "kernel_launch: hipFuncSetAttribute failed\n"); grid = -1; return; }
        int per_cu = 0;
        if (hipOccupancyMaxActiveBlocksPerMultiprocessor(&per_cu, (const void*)fwd, NTHR, LDS_BYTES) != hipSuccess || per_cu < 1) fprintf(stderr, "kernel_launch: occupancy query reports %d\n", per_cu);
        (void)hipGetLastError();
        grid = cus;
    }
    if (grid < 0) return;
    if (hipMemsetAsync((char*)d_ws + WS_CTL, 0, CTL_ZERO_BYTES, stream) != hipSuccess) return;
    Args a{};
    for (int i = 0; i < 22; ++i) a.in[i] = (const float*)d_in[i];
    a.out = (float*)d_out; a.ws = (unsigned char*)d_ws;
#if MK_PER_PHASE
    for (int p = 0; p < NPHASE; ++p) { a.ph_lo = p; a.ph_hi = p + 1; hipLaunchKernelGGL(fwd, dim3(grid), dim3(NTHR), LDS_BYTES, stream, a); }
#elif REPEAT_MASK
    { int lo = 0, reg = 0;
      for (int k = 0; k < NPHASE; ++k) if ((REPEAT_MASK >> k) & 1) {
          a.ph_lo = lo; a.ph_hi = k + 1; a.bar_region = reg++; hipLaunchKernelGGL(fwd, dim3(grid), dim3(NTHR), LDS_BYTES, stream, a);
          a.ph_lo = k; a.ph_hi = k + 1; a.bar_region = reg++; hipLaunchKernelGGL(fwd, dim3(grid), dim3(NTHR), LDS_BYTES, stream, a);
          lo = k + 1; }
      if (lo < NPHASE) { a.ph_lo = lo; a.ph_hi = NPHASE; a.bar_region = reg++; hipLaunchKernelGGL(fwd, dim3(grid), dim3(NTHR), LDS_BYTES, stream, a); } }
#else
    a.ph_lo = 0; a.ph_hi = NPHASE; hipLaunchKernelGGL(fwd, dim3(grid), dim3(NTHR), LDS_BYTES, stream, a);
#endif
}
```

```cpp
#include <hip/hip_runtime.h>
#include <cstdio>
#include <cstdint>

#ifndef MK_PER_PHASE
#define MK_PER_PHASE 0
#endif

#define GAS __attribute__((address_space(1)))
#define LAS __attribute__((address_space(3)))
typedef unsigned short bf16_t;
typedef short bf16x8 __attribute__((ext_vector_type(8)));
typedef short s16x4 __attribute__((ext_vector_type(4)));
typedef float f32x2 __attribute__((ext_vector_type(2)));
typedef float f32x4 __attribute__((ext_vector_type(4)));
typedef float f32x16 __attribute__((ext_vector_type(16)));
typedef unsigned u32x2 __attribute__((ext_vector_type(2)));
typedef unsigned u32x4 __attribute__((ext_vector_type(4)));
typedef int i32x4 __attribute__((ext_vector_type(4)));
typedef GAS unsigned gu32;
#define RLX_AGENT __ATOMIC_RELAXED, __HIP_MEMORY_SCOPE_AGENT
#define DI __device__ __forceinline__

constexpr int BATCH = 16, SEQ = 2048, T = BATCH * SEQ, D = 1024;
constexpr int NEXP = 32, DFF = 1024;
constexpr int EV_COLS = 3072, OD_COLS = 2760, OD_COLS_P = 2816;
constexpr float ALPHA = 1.41421356237309515f;
constexpr float LN_EPS = 1e-5f, RMS_EPS = 1e-5f;
constexpr float LOG2E = 1.4426950408889634f;
constexpr int MAXROWS = 131072 + 32 * 256;
constexpr int NWAVES = 8, NTHR = 512;
#ifndef MOE_FP8_ON
#define MOE_FP8_ON 1
#endif
constexpr bool MOE_FP8 = MOE_FP8_ON != 0;
constexpr int MOE_EB = MOE_FP8 ? 1 : 2;
#ifndef PLAIN_FP8_ON
#define PLAIN_FP8_ON 1
#endif
constexpr bool PLAIN_FP8 = PLAIN_FP8_ON != 0;
#ifndef IN_FP8_ON
#define IN_FP8_ON 0
#endif
constexpr bool IN_FP8 = IN_FP8_ON != 0;
#ifndef IN1_FP8_ON
#define IN1_FP8_ON 0
#endif
constexpr bool IN1_FP8 = IN1_FP8_ON != 0;
constexpr int PL_EB = PLAIN_FP8 ? 1 : 2, IN_EB = IN_FP8 ? 1 : 2, IN1_EB = IN1_FP8 ? 1 : 2;
constexpr float YSCALE = 64.0f;
constexpr float MSCALE = 32.0f, WCSCALE = 1024.0f;
constexpr float WSCALE = 256.0f, XSCALE = 16.0f, ASCALE = 4.0f;

constexpr size_t MiB = 1u << 20;
constexpr size_t WS_CTL = 0, CTL_ZERO_BYTES = 1 * MiB;
constexpr size_t WS_WEVIN = 1 * MiB;
constexpr size_t WS_WEVOUT = 7 * MiB;
constexpr size_t WS_WODIN = 9 * MiB;
constexpr size_t WS_WCOMB = 15 * MiB;
constexpr size_t WS_WR = 19 * MiB;
constexpr size_t WS_WGU = 20 * MiB;
constexpr size_t WS_WD = 276 * MiB;
constexpr size_t WS_XB = 404 * MiB;
constexpr size_t WS_HB = 468 * MiB;
constexpr size_t WS_R1 = 532 * MiB;
constexpr size_t WS_R2 = 804 * MiB;
constexpr size_t WS_PRE = 1076 * MiB;
constexpr size_t WS_H1 = 1204 * MiB;
constexpr size_t WS_X8 = 1332 * MiB;
constexpr size_t WS_PERM = 1460 * MiB;
constexpr size_t WS_TOKER = 1464 * MiB;
constexpr size_t WS_TOKG = 1465 * MiB;
constexpr size_t WS_CKV = 1466 * MiB;
constexpr size_t WS_IDX = 1474 * MiB;
constexpr size_t WS_END = 1506 * MiB;
constexpr int CW_CNT0 = 64, CW_CNT1 = 128;
constexpr int CW_BAR = 4096;

constexpr int LDS_STAGE = 0, LDS_TAB = 131072, LDS_BIAS = 131072 + 18 * 1024, LDS_INTS = 151552, LDS_MISC = 152576, LDS_BYTES = 153600;

DI unsigned pk_bf16(float lo, float hi) { typedef __bf16 b2 __attribute__((ext_vector_type(2))); f32x2 v = {lo, hi}; b2 b = __builtin_convertvector(v, b2); return __builtin_bit_cast(unsigned, b); }
DI unsigned pk_fp8x4(float a, float b, float c, float d) {
    a = fminf(fmaxf(a, -440.f), 440.f); b = fminf(fmaxf(b, -440.f), 440.f); c = fminf(fmaxf(c, -440.f), 440.f); d = fminf(fmaxf(d, -440.f), 440.f);
    int p = __builtin_amdgcn_cvt_pk_fp8_f32(a, b, 0, false); p = __builtin_amdgcn_cvt_pk_fp8_f32(c, d, p, true); return (unsigned)p; }
DI float bf2f(unsigned short b) { return __uint_as_float(((unsigned)b) << 16); }
DI float bflo(unsigned u) { return __uint_as_float(u << 16); }
DI float bfhi(unsigned u) { return __uint_as_float(u & 0xffff0000u); }
DI float wave_sum(float v) {
#pragma unroll
    for (int o = 1; o < 64; o <<= 1) v += __shfl_xor(v, o);
    return v;
}
DI float fexp2(float x) { return __builtin_amdgcn_exp2f(x); }
DI float frcp(float x) { return __builtin_amdgcn_rcpf(x); }
#define LDS_WAIT() asm volatile("s_waitcnt lgkmcnt(0)" ::: "memory")
#define VM_WAIT() asm volatile("s_waitcnt vmcnt(0)" ::: "memory")

#define XB_TMO      128
#define XB_XCNT(j)  (256  + 64 * (j))
#define XB_XSUB(j)  (1280 + 64 * (j))
#define XB_XGEN(j)  (2304 + 64 * (j))
#define XB_TOP      3328
#define XB_TOPGEN   3392
#define XCD_BAR_WORDS 3456
#define XB_SPIN_CAP (1u << 22)
DI unsigned xb_ld(unsigned* p)              { return __hip_atomic_load(p, __ATOMIC_RELAXED, __HIP_MEMORY_SCOPE_AGENT); }
DI unsigned xb_add(unsigned* p, unsigned v) { return __hip_atomic_fetch_add(p, v, __ATOMIC_RELAXED, __HIP_MEMORY_SCOPE_AGENT); }
DI unsigned xb_xcc_id() { return (unsigned)__builtin_amdgcn_s_getreg((3 << 11) | 20) & 0xFu; }
#define XB_SPIN(cond, bar) do { unsigned _sp = 0; while (cond) { __builtin_amdgcn_s_sleep(1); \
    if ((++_sp & 255u) == 0u) { if (xb_ld(&(bar)[XB_TMO])) break; if (_sp > XB_SPIN_CAP) { atomicAdd(&(bar)[XB_TMO], 1u); break; } } } } while (0)
struct XcdBarrier { unsigned* bar; unsigned x; volatile LAS unsigned* st; };
DI XcdBarrier xcd_barrier_post(unsigned* bar, volatile LAS unsigned* st) {
    XcdBarrier b; b.bar = bar; b.x = xb_xcc_id(); b.st = st;
    if (threadIdx.x == 0) (void)xb_add(&bar[XB_XCNT(b.x)], 1u);
    return b;
}
DI void xcd_barrier_complete(unsigned* bar, unsigned x, unsigned& nloc, unsigned& nx) {
    const unsigned G = gridDim.x * gridDim.y * gridDim.z;
    unsigned sum, cnt, mine, sp = 0u;
    for (;;) {
        sum = 0u; cnt = 0u; mine = 0u;
#pragma unroll
        for (unsigned j = 0; j < 16; ++j) { const unsigned c = xb_ld(&bar[XB_XCNT(j)]); sum += c; cnt += (c > 0u) ? 1u : 0u; mine = (j == x) ? c : mine; }
        if (sum == G) break;
        __builtin_amdgcn_s_sleep(1);
        if ((++sp & 255u) == 0u) { if (xb_ld(&bar[XB_TMO])) break; if (sp > XB_SPIN_CAP) { atomicAdd(&bar[XB_TMO], 1u); break; } }
    }
    nloc = mine > 0u ? mine : 1u; nx = cnt > 0u ? cnt : 1u;
}
DI void xcd_barrier(const XcdBarrier& b) {
    asm volatile("s_waitcnt vmcnt(0)" ::: "memory");
    __syncthreads();
    if (threadIdx.x == 0) {
        unsigned* bar = b.bar;
        __builtin_amdgcn_s_waitcnt(0);
        unsigned nloc = b.st[0], nx = b.st[1];
        if (nloc == 0u) { xcd_barrier_complete(bar, b.x, nloc, nx); b.st[0] = nloc; b.st[1] = nx; }
        const unsigned old = xb_add(&bar[XB_XSUB(b.x)], 1u);
        const unsigned gen = old / nloc;
        if (old + 1u == (gen + 1u) * nloc) {
            __builtin_amdgcn_fence(__ATOMIC_RELEASE, "agent");
            asm volatile("s_waitcnt vmcnt(0)" ::: "memory");
            const unsigned og = xb_add(&bar[XB_TOP], 1u);
            const unsigned tg = og / nx;
            if (og + 1u == (tg + 1u) * nx) xb_add(&bar[XB_TOPGEN], 1u);
            else XB_SPIN(xb_ld(&bar[XB_TOPGEN]) == tg, bar);
            __builtin_amdgcn_fence(__ATOMIC_ACQUIRE, "agent");
            xb_add(&bar[XB_XGEN(b.x)], 1u);
            asm volatile("s_waitcnt vmcnt(0)" ::: "memory");
        } else {
            XB_SPIN(xb_ld(&bar[XB_XGEN(b.x)]) == gen, bar);
            __builtin_amdgcn_fence(__ATOMIC_ACQUIRE, "agent");
            asm volatile("s_waitcnt vmcnt(0)" ::: "memory");
        }
    }
    __syncthreads();
}

namespace pg8 {
constexpr int BM = 256, BK = 64, HALF = 128, HTB = HALF * BK * 2, STAGE_BYTES = 8 * HTB, NXCD = 8, WGM = 8;
__host__ __device__ __forceinline__ int lds_byte(int r, int c) { const int st = (r >> 4) * 2 + (c >> 5), rr = r & 15, cc = c & 31, ob = rr * 64 + cc * 2; return st * 1024 + (ob ^ (((ob >> 9) & 1) << 5)); }
__host__ __device__ __forceinline__ void stage_rc(int b, int& R, int& C) { const int st = b / 1024, sb = b % 1024, swz = sb ^ (((sb >> 9) & 1) << 5); R = (st >> 1) * 16 + swz / 64; C = (st & 1) * 32 + (swz % 64) / 2; }
__host__ __device__ __forceinline__ int perm32(int rho) { const int n = rho >> 4, i = rho & 15; return 8 * (i >> 2) + 4 * n + (i & 3); }

struct Unit { int pm, pn, e, slot; const char* Bp; };

typedef int v4i_t __attribute__((ext_vector_type(4)));
typedef int v8i_t __attribute__((ext_vector_type(8)));
template <class Epi, class Sched, bool FP8 = false>
DI void gemm_phase(LAS unsigned char* lds, const char* Abase, const int RB, const size_t hstepB, const Sched& S, const Epi& E) {
    const int tid = threadIdx.x, wid = __builtin_amdgcn_readfirstlane(tid >> 6), lane = tid & 63, wr = wid >> 2, wc = wid & 3, fr = lane & 15, fq = lane >> 4;
    const int nt = RB / 128;
    int RA[2], CA[2]; unsigned voffB[2];
#pragma unroll
    for (int i = 0; i < 2; ++i) { int R, C; stage_rc(tid * 16 + i * 8192, R, C); const int Rb = Epi::PERM ? ((R & ~31) + perm32(R & 31)) : R;
        RA[i] = R; CA[i] = C; voffB[i] = (unsigned)(Rb * RB + C * 2); }
    const size_t kstep = (size_t)(BK * 2);
    const unsigned ldsw = (unsigned)wid * 1024u;
    const int aoff = lds_byte(wr * 64 + fr, fq * 8), boff = lds_byte(wc * 32 + fr, fq * 8);
#define PG8_SA(b, h) (((b) * 2 + (h)) * HTB)
#define PG8_SB(b, h) ((4 + (b) * 2 + (h)) * HTB)
#define PG8_STAGE(bufoff, gbase, voff) do { _Pragma("unroll") for (int _i = 0; _i < 2; ++_i) \
        __builtin_amdgcn_global_load_lds((const unsigned*)((const char*)(gbase) + (voff)[_i]), (LAS unsigned*)(lds + (bufoff) + ldsw + _i * 8192), 16, 0, 0); } while (0)
#define PG8_LDA(dst, b, h) do { _Pragma("unroll") for (int m = 0; m < 4; ++m) { const v4i_t lo_ = *(const LAS v4i_t*)(lds + PG8_SA(b, h) + aoff + m * 2048), hi_ = *(const LAS v4i_t*)(lds + PG8_SA(b, h) + aoff + m * 2048 + 1024); \
        dst[m] = __builtin_shufflevector(lo_, hi_, 0, 1, 2, 3, 4, 5, 6, 7); } } while (0)
#define PG8_LDB(dst, b, h) do { _Pragma("unroll") for (int n = 0; n < 2; ++n) { const v4i_t lo_ = *(const LAS v4i_t*)(lds + PG8_SB(b, h) + boff + n * 2048), hi_ = *(const LAS v4i_t*)(lds + PG8_SB(b, h) + boff + n * 2048 + 1024); \
        dst[n] = __builtin_shufflevector(lo_, hi_, 0, 1, 2, 3, 4, 5, 6, 7); } } while (0)
#define PG8_LO(x) __builtin_bit_cast(bf16x8, __builtin_shufflevector(x, x, 0, 1, 2, 3))
#define PG8_HI(x) __builtin_bit_cast(bf16x8, __builtin_shufflevector(x, x, 4, 5, 6, 7))
#define PG8_MMA(ai, bj, At, Bt) do { __builtin_amdgcn_s_setprio(1); if constexpr (FP8) asm volatile("s_nop 1"); _Pragma("unroll") for (int m = 0; m < 4; ++m) _Pragma("unroll") for (int n = 0; n < 2; ++n) { \
        if constexpr (!FP8) { acc[ai][bj][m][n] = __builtin_amdgcn_mfma_f32_16x16x32_bf16(PG8_LO(Bt[n]), PG8_LO(At[m]), acc[ai][bj][m][n], 0, 0, 0); \
                              acc[ai][bj][m][n] = __builtin_amdgcn_mfma_f32_16x16x32_bf16(PG8_HI(Bt[n]), PG8_HI(At[m]), acc[ai][bj][m][n], 0, 0, 0); } \
        else asm volatile("v_mfma_f32_16x16x128_f8f6f4 %0, %1, %2, %0" : "+v"(acc[ai][bj][m][n]) : "v"(Bt[n]), "v"(At[m])); } __builtin_amdgcn_s_setprio(0); } while (0)
#define PG8_WAIT_V(n) asm volatile("s_waitcnt vmcnt(" #n ")" ::: "memory")
#define PG8_WAIT_L(n) asm volatile("s_waitcnt lgkmcnt(" #n ")" ::: "memory")
#define PG8_BAR __builtin_amdgcn_s_barrier()
#define PG8_SCHED __builtin_amdgcn_sched_barrier(0)
    Unit cur, nxt; int ui = 0;
    if (!S.next(0, cur)) return;
    f32x4 acc[2][2][4][2];
#pragma unroll
    for (int a = 0; a < 2; ++a)
#pragma unroll
        for (int b = 0; b < 2; ++b)
#pragma unroll
            for (int m = 0; m < 4; ++m)
#pragma unroll
                for (int n = 0; n < 2; ++n) acc[a][b][m][n] = (f32x4){0.f, 0.f, 0.f, 0.f};
    v8i_t At[4], B0[2], B1[2];
    unsigned vC0[2], vC1[2], vN0[2], vN1[2];
    S.arows(cur, RA, CA, vC0, vC1);
    const char* cB = cur.Bp;
    LAS unsigned char* bring = lds + (LDS_BIAS - LDS_STAGE);
    if constexpr (Epi::HAS_BIAS) { if (wid == 0) __builtin_amdgcn_global_load_lds((const unsigned*)E.bias_src(cur, lane), (LAS unsigned*)bring, 16, 0, 0); }
    PG8_STAGE(PG8_SB(0, 0), cB, voffB); PG8_STAGE(PG8_SB(0, 1), cB + hstepB, voffB); PG8_STAGE(PG8_SA(0, 0), Abase, vC0); PG8_STAGE(PG8_SA(0, 1), Abase, vC1);
    if (wr == 1) PG8_BAR;
    PG8_WAIT_V(2); PG8_BAR;
    PG8_STAGE(PG8_SB(1, 0), cB + kstep, voffB); PG8_STAGE(PG8_SA(1, 0), Abase + kstep, vC0); PG8_STAGE(PG8_SB(1, 1), cB + hstepB + kstep, voffB);
    PG8_WAIT_V(6); PG8_BAR;
    for (;;) {
        const bool has_next = S.next(ui + 1, nxt);
        if (has_next) S.arows(nxt, RA, CA, vN0, vN1); else { vN0[0] = vC0[0]; vN0[1] = vC0[1]; vN1[0] = vC1[0]; vN1[1] = vC1[1]; }
        const char* nB = has_next ? nxt.Bp : cB;
#pragma unroll 1
        for (int t = 0; t < nt; t += 2) {
            const bool last = (t == nt - 2);
            if constexpr (Epi::HAS_BIAS) { if (last && has_next && wid == 0) __builtin_amdgcn_global_load_lds((const unsigned*)E.bias_src(nxt, lane), (LAS unsigned*)(bring + ((ui + 1) & 1) * 1024), 16, 0, 0); }
            const char* a1 = Abase + (size_t)(t + 1) * kstep;
            const char* a2 = last ? Abase : Abase + (size_t)(t + 2) * kstep; const char* b2 = last ? nB : cB + (size_t)(t + 2) * kstep;
            const char* a3 = a2 + kstep; const char* b3 = b2 + kstep;
            unsigned v20[2], v21[2];
            v20[0] = last ? vN0[0] : vC0[0]; v20[1] = last ? vN0[1] : vC0[1]; v21[0] = last ? vN1[0] : vC1[0]; v21[1] = last ? vN1[1] : vC1[1];
            PG8_LDB(B0, 0, 0); PG8_LDB(B1, 0, 1); PG8_SCHED; PG8_LDA(At, 0, 0); PG8_STAGE(PG8_SA(1, 1), a1, vC1);
            PG8_WAIT_V(8); PG8_WAIT_L(0); PG8_BAR; PG8_MMA(0, 0, At, B0); PG8_MMA(0, 1, At, B1); PG8_BAR; PG8_SCHED;
            PG8_LDA(At, 0, 1); PG8_STAGE(PG8_SB(0, 0), b2, voffB); PG8_STAGE(PG8_SB(0, 1), b2 + hstepB, voffB); PG8_STAGE(PG8_SA(0, 0), a2, v20);
            PG8_WAIT_V(8); PG8_WAIT_L(0); PG8_BAR; PG8_MMA(1, 0, At, B0); PG8_MMA(1, 1, At, B1); PG8_BAR; PG8_SCHED;
            PG8_LDB(B0, 1, 0); PG8_LDB(B1, 1, 1); PG8_SCHED; PG8_LDA(At, 1, 0); PG8_STAGE(PG8_SA(0, 1), a2, v21);
            PG8_WAIT_V(8); PG8_WAIT_L(0); PG8_BAR; PG8_MMA(0, 0, At, B0); PG8_MMA(0, 1, At, B1); PG8_BAR; PG8_SCHED;
            PG8_LDA(At, 1, 1); PG8_STAGE(PG8_SB(1, 0), b3, voffB); PG8_STAGE(PG8_SB(1, 1), b3 + hstepB, voffB); PG8_STAGE(PG8_SA(1, 0), a3, v20);
            PG8_WAIT_V(8); PG8_WAIT_L(0); PG8_BAR; PG8_MMA(1, 0, At, B0); PG8_MMA(1, 1, At, B1); PG8_BAR; PG8_SCHED;
        }
        if (wr == 0) PG8_BAR;
        if constexpr (FP8) asm volatile("s_nop 15\n\ts_nop 15" ::: "memory");
        E(acc, cur, wr, wc, fr, fq, (const LAS float*)(bring + (ui & 1) * 1024));
#ifdef EPI_TWICE
        asm volatile("" ::: "memory"); E(acc, cur, wr, wc, fr, fq, (const LAS float*)(bring + (ui & 1) * 1024));
#endif
        if (!has_next) break;
#pragma unroll
        for (int a = 0; a < 2; ++a)
#pragma unroll
            for (int b = 0; b < 2; ++b)
#pragma unroll
                for (int m = 0; m < 4; ++m)
#pragma unroll
                    for (int n = 0; n < 2; ++n) acc[a][b][m][n] = (f32x4){0.f, 0.f, 0.f, 0.f};
        cur = nxt; cB = nB; vC0[0] = vN0[0]; vC0[1] = vN0[1]; vC1[0] = vN1[0]; vC1[1] = vN1[1]; ++ui;
        if (wr == 1) PG8_BAR;
    }
    PG8_WAIT_V(0);
    PG8_BAR;
#undef PG8_SA
#undef PG8_SB
#undef PG8_STAGE
#undef PG8_LDA
#undef PG8_LDB
#undef PG8_MMA
#undef PG8_LO
#undef PG8_HI
#undef PG8_WAIT_V
#undef PG8_WAIT_L
#undef PG8_BAR
#undef PG8_SCHED
}

struct PlainSched {
    int nM, nN, nwg, G, c; unsigned lda2; const char* Bt; size_t tstepB;
    DI void init(int M, int N, int K, int lda, const void* Bt_, int G_, int c_, int eb = 2) { nM = M / BM; nN = N / BM; nwg = nM * nN; G = G_; c = c_; lda2 = (unsigned)(lda * eb); Bt = (const char*)Bt_; tstepB = (size_t)BM * K * eb; }
    DI bool next(int i, Unit& u) const {
        const long L = (long)i * G + c; if (L >= nwg) return false;
        int wgid = (int)L; { const int q = nwg / NXCD, r = nwg % NXCD, xcd = wgid % NXCD, off = wgid / NXCD; wgid = (xcd < r ? xcd * (q + 1) : r * (q + 1) + (xcd - r) * q) + off; }
        const int nig = WGM * nN, gid = wgid / nig, fm = gid * WGM, gsz = (nM - fm) < WGM ? (nM - fm) : WGM;
        u.pm = fm + ((wgid % nig) % gsz); u.pn = (wgid % nig) / gsz; u.e = 0; u.slot = i; u.Bp = Bt + (size_t)u.pn * tstepB; return true;
    }
    DI void arows(const Unit& u, const int (&R)[2], const int (&C)[2], unsigned (&v0)[2], unsigned (&v1)[2]) const {
#pragma unroll
        for (int i = 0; i < 2; ++i) { v0[i] = (unsigned)(u.pm * BM + R[i]) * lda2 + (unsigned)C[i] * 2u; v1[i] = (unsigned)(u.pm * BM + HALF + R[i]) * lda2 + (unsigned)C[i] * 2u; }
    }
};
struct MoeSched {
    int to_lane;
    int total, G, c, ntshift; bool gather;
    const LAS unsigned* tab;
    const char* W; size_t wexp, wpn; unsigned rowb;
    DI bool next(int i, Unit& u) const {
        const int per = G >> 3, x = c / per, j = c - x * per, ntile = total >> ntshift, tpx = (ntile + 7) >> 3, tpr = per >> ntshift;
        const int loc = i * tpr + (j >> ntshift), mtg = x * tpx + loc, pn = j & ((1 << ntshift) - 1);
        if (loc >= tpx || mtg >= ntile) return false;
        const int e = __builtin_popcountll(__ballot(to_lane <= mtg));
        u.pm = mtg; u.pn = pn; u.e = e; u.slot = i; u.Bp = W + (size_t)e * wexp + (size_t)pn * wpn; return true;
    }
    DI void arows(const Unit& u, const int (&R)[2], const int (&C)[2], unsigned (&v0)[2], unsigned (&v1)[2]) const {
        if (gather) {
#pragma unroll
            for (int i = 0; i < 2; ++i) { v0[i] = tab[u.slot * 256 + R[i]] + (unsigned)C[i] * 2u; v1[i] = tab[u.slot * 256 + HALF + R[i]] + (unsigned)C[i] * 2u; }
        } else {
#pragma unroll
            for (int i = 0; i < 2; ++i) { v0[i] = (unsigned)(u.pm * BM + R[i]) * rowb + (unsigned)C[i] * 2u; v1[i] = (unsigned)(u.pm * BM + HALF + R[i]) * rowb + (unsigned)C[i] * 2u; }
        }
    }
};

struct EpiProj {
    static constexpr bool PERM = true, HAS_BIAS = false; bf16_t* O; int ldc; float ascale;
    DI void operator()(const f32x4 (&acc)[2][2][4][2], const Unit& u, int wr, int wc, int fr, int fq, const LAS float*) const {
        const int row0 = u.pm * BM + wr * 64 + fr, col0 = u.pn * BM + wc * 32 + 8 * fq;
#pragma unroll
        for (int ai = 0; ai < 2; ++ai)
#pragma unroll
            for (int m = 0; m < 4; ++m) { bf16_t* rowp = O + (size_t)(row0 + ai * HALF + m * 16) * ldc + col0;
#pragma unroll
                for (int bj = 0; bj < 2; ++bj) { const f32x4 v0 = acc[ai][bj][m][0] * ascale, v1 = acc[ai][bj][m][1] * ascale;
                    u32x4 w; w.x = pk_bf16(v0[0], v0[1]); w.y = pk_bf16(v0[2], v0[3]); w.z = pk_bf16(v1[0], v1[1]); w.w = pk_bf16(v1[2], v1[3]);
                    *(u32x4*)(rowp + bj * HALF) = w; } }
    }
};
struct EpiRes {
    static constexpr bool PERM = false, HAS_BIAS = false; const float* res; const bf16_t* resb; bf16_t* out; float ascale;
    DI void operator()(const f32x4 (&acc)[2][2][4][2], const Unit& u, int wr, int wc, int fr, int fq, const LAS float*) const {
        const int row0 = u.pm * BM + wr * 64 + fr, col0 = u.pn * BM + wc * 32 + 4 * fq;
#pragma unroll
        for (int ai = 0; ai < 2; ++ai)
#pragma unroll
            for (int m = 0; m < 4; ++m) { const size_t off = (size_t)(row0 + ai * HALF + m * 16) * D + col0;
#pragma unroll
                for (int bj = 0; bj < 2; ++bj)
#pragma unroll
                    for (int n = 0; n < 2; ++n) { f32x4 r;
                        if (resb) { const u32x2 rb = *(const u32x2*)(resb + off + bj * HALF + n * 16); r = (f32x4){bflo(rb.x), bfhi(rb.x), bflo(rb.y), bfhi(rb.y)}; }
                        else r = *(const f32x4*)(res + off + bj * HALF + n * 16);
                        const f32x4 o = acc[ai][bj][m][n] * ascale + r * ALPHA; u32x2 w; w.x = pk_bf16(o[0], o[1]); w.y = pk_bf16(o[2], o[3]);
                        *(u32x2*)(out + off + bj * HALF + n * 16) = w; } }
    }
};
struct EpiSwiglu {
    static constexpr bool PERM = true, HAS_BIAS = true; unsigned char* O; const float* bgu; float ascale;
    DI const float* bias_src(const Unit& u, int lane) const { return bgu + (size_t)u.e * 2048 + u.pn * HALF + (lane >> 5) * 1024 + 4 * (lane & 31); }
    DI void operator()(const f32x4 (&acc)[2][2][4][2], const Unit& u, int wr, int wc, int fr, int fq, const LAS float* bias) const {
        const int row0 = u.pm * BM + wr * 64 + fr, col0 = u.pn * HALF + wc * 32 + 8 * fq;
        f32x4 bgv[2], buv[2];
#pragma unroll
        for (int n = 0; n < 2; ++n) { bgv[n] = *(const LAS f32x4*)(bias + wc * 32 + 8 * fq + 4 * n); buv[n] = *(const LAS f32x4*)(bias + 128 + wc * 32 + 8 * fq + 4 * n); }
#pragma unroll
        for (int ai = 0; ai < 2; ++ai)
#pragma unroll
            for (int m = 0; m < 4; ++m) { float o[8];
#pragma unroll
                for (int n = 0; n < 2; ++n)
#pragma unroll
                    for (int jj = 0; jj < 2; ++jj) {
                        const f32x2 ag = {acc[ai][0][m][n][2 * jj], acc[ai][0][m][n][2 * jj + 1]}, au = {acc[ai][1][m][n][2 * jj], acc[ai][1][m][n][2 * jj + 1]};
                        const f32x2 bg2 = {bgv[n][2 * jj], bgv[n][2 * jj + 1]}, bu2 = {buv[n][2 * jj], buv[n][2 * jj + 1]};
                        f32x2 g = ag * ascale + bg2, up = au * ascale + bu2;
                        g = __builtin_elementwise_min(g, (f32x2){7.0f, 7.0f});
                        up = __builtin_elementwise_min(__builtin_elementwise_max(up, (f32x2){-7.0f, -7.0f}), (f32x2){7.0f, 7.0f});
                        const f32x2 ex = g * (-1.702f * LOG2E);
                        f32x2 e2; e2.x = fexp2(ex.x); e2.y = fexp2(ex.y);
                        const f32x2 den = e2 + 1.0f;
                        f32x2 sg; sg.x = frcp(den.x); sg.y = frcp(den.y);
                        const f32x2 r = (g * sg) * (up + 1.0f);
                        o[4 * n + 2 * jj] = r.x; o[4 * n + 2 * jj + 1] = r.y; }
                if (!MOE_FP8) { u32x4 w; w.x = pk_bf16(o[0], o[1]); w.y = pk_bf16(o[2], o[3]); w.z = pk_bf16(o[4], o[5]); w.w = pk_bf16(o[6], o[7]);
                    *(u32x4*)(O + ((size_t)(row0 + ai * HALF + m * 16) * DFF + col0) * 2) = w; }
                else { u32x2 w;
                    int p = __builtin_amdgcn_cvt_pk_fp8_f32(o[0] * ASCALE, o[1] * ASCALE, 0, false); p = __builtin_amdgcn_cvt_pk_fp8_f32(o[2] * ASCALE, o[3] * ASCALE, p, true); w.x = (unsigned)p;
                    p = __builtin_amdgcn_cvt_pk_fp8_f32(o[4] * ASCALE, o[5] * ASCALE, 0, false); p = __builtin_amdgcn_cvt_pk_fp8_f32(o[6] * ASCALE, o[7] * ASCALE, p, true); w.y = (unsigned)p;
                    *(u32x2*)(O + (size_t)(row0 + ai * HALF + m * 16) * DFF + col0) = w; } }
    }
};
struct EpiDown {
    static constexpr bool PERM = true, HAS_BIAS = true; unsigned char* O; const float* bd; float ascale;
    DI const float* bias_src(const Unit& u, int lane) const { return bd + (size_t)u.e * 1024 + u.pn * BM + 4 * lane; }
    DI void operator()(const f32x4 (&acc)[2][2][4][2], const Unit& u, int wr, int wc, int fr, int fq, const LAS float* bias) const {
        const int row0 = u.pm * BM + wr * 64 + fr, col0 = u.pn * BM + wc * 32 + 8 * fq;
        f32x4 bv[2][2];
#pragma unroll
        for (int bj = 0; bj < 2; ++bj)
#pragma unroll
            for (int n = 0; n < 2; ++n) bv[bj][n] = *(const LAS f32x4*)(bias + bj * HALF + wc * 32 + 8 * fq + 4 * n) * YSCALE;
        const float as = ascale * YSCALE;
#pragma unroll
        for (int ai = 0; ai < 2; ++ai)
#pragma unroll
            for (int m = 0; m < 4; ++m) { unsigned char* rowp = O + (size_t)(row0 + ai * HALF + m * 16) * D + col0;
#pragma unroll
                for (int bj = 0; bj < 2; ++bj) { const f32x4 v0 = acc[ai][bj][m][0] * as + bv[bj][0], v1 = acc[ai][bj][m][1] * as + bv[bj][1];
                    u32x2 w; w.x = pk_fp8x4(v0[0], v0[1], v0[2], v0[3]); w.y = pk_fp8x4(v1[0], v1[1], v1[2], v1[3]);
                    *(u32x2*)(rowp + bj * HALF) = w; } }
    }
};
}

struct Frame {
    LAS unsigned char* lds;
    gu32* ctl;
    int tid, lane, wave, vcu, G;
    unsigned char* ws;
    const float* in[22];
    float* out;
};
#define WSP(T_, off) ((T_*)(F.ws + (off)))

DI void p0_transpose_item(const float* W, int K, int N, int Nvalid, bf16_t* WT, LAS float* scr, int item, int lane) {
    const int nblk = N / 32, kb = item / nblk, nb = item % nblk, k0 = 64 * kb, n0 = 32 * nb;
    const int n = n0 + (lane & 31); const bool ok = n < Nvalid;
#pragma unroll 8
    for (int i = 0; i < 32; ++i) { const int kk = 2 * i + (lane >> 5); scr[kk * 33 + (lane & 31)] = ok ? W[(size_t)(k0 + kk) * Nvalid + n] : 0.f; }
    LDS_WAIT(); asm volatile("" ::: "memory");
    const int c = lane & 7;
#pragma unroll
    for (int j = 0; j < 4; ++j) { const int nn = (lane >> 3) + 8 * j; const LAS float* s = scr + (8 * c) * 33 + nn;
        u32x4 o; o.x = pk_bf16(s[0 * 33], s[1 * 33]); o.y = pk_bf16(s[2 * 33], s[3 * 33]); o.z = pk_bf16(s[4 * 33], s[5 * 33]); o.w = pk_bf16(s[6 * 33], s[7 * 33]);
        *(GAS u32x4*)(WT + (size_t)(n0 + nn) * K + k0 + 8 * c) = o; }
    LDS_WAIT(); asm volatile("" ::: "memory");
}
struct P0Desc { const float* W; unsigned char* WT; int N, Nvalid, sub, fp8; float scale; };
template <bool CHECK = true> DI void p0_load(const P0Desc& d, f32x4 (&v)[16], int lane) {
    const int nblk = d.N / 64, kb = d.sub / nblk, nb = d.sub % nblk, k0 = 64 * kb, n0 = 64 * nb;
    const int nn = n0 + 4 * (lane & 15); const bool ok = !CHECK || nn < d.Nvalid;
#pragma unroll
    for (int i = 0; i < 16; ++i) { const int kk = 4 * i + (lane >> 4); v[i] = ok ? __builtin_nontemporal_load((const f32x4*)(d.W + (size_t)(k0 + kk) * d.Nvalid + nn)) : (f32x4){0.f, 0.f, 0.f, 0.f}; }
}
DI void p0_finish(const P0Desc& d, const f32x4 (&v)[16], LAS float* scr, int lane) {
    constexpr int K = 1024;
    const int nblk = d.N / 64, kb = d.sub / nblk, nb = d.sub % nblk, k0 = 64 * kb, n0 = 64 * nb;
#pragma unroll
    for (int i = 0; i < 16; ++i) { const int kk = 4 * i + (lane >> 4); LAS float* p = scr + kk * 65 + 4 * (lane & 15); p[0] = v[i][0]; p[1] = v[i][1]; p[2] = v[i][2]; p[3] = v[i][3]; }
    LDS_WAIT(); asm volatile("" ::: "memory");
    if (!d.fp8) {
        const int c = lane & 7;
#pragma unroll
        for (int j = 0; j < 8; ++j) { const int n = (lane >> 3) + 8 * j; const LAS float* sp = scr + (8 * c) * 65 + n;
            u32x4 o; o.x = pk_bf16(sp[0], sp[65]); o.y = pk_bf16(sp[2 * 65], sp[3 * 65]); o.z = pk_bf16(sp[4 * 65], sp[5 * 65]); o.w = pk_bf16(sp[6 * 65], sp[7 * 65]);
            *(GAS u32x4*)(d.WT + ((size_t)(n0 + n) * K + k0 + 8 * c) * 2) = o; }
    } else {
        const int c = lane & 3; const float ws = d.scale;
#pragma unroll
        for (int j = 0; j < 4; ++j) { const int n = (lane >> 2) + 16 * j; const LAS float* sp = scr + (16 * c) * 65 + n;
            u32x4 o;
#pragma unroll
            for (int q = 0; q < 4; ++q) { int p = __builtin_amdgcn_cvt_pk_fp8_f32(sp[(4 * q) * 65] * ws, sp[(4 * q + 1) * 65] * ws, 0, false);
                p = __builtin_amdgcn_cvt_pk_fp8_f32(sp[(4 * q + 2) * 65] * ws, sp[(4 * q + 3) * 65] * ws, p, true); o[q] = (unsigned)p; }
            *(GAS u32x4*)(d.WT + (size_t)(n0 + n) * K + k0 + 16 * c) = o; }
    }
    LDS_WAIT(); asm volatile("" ::: "memory");
}
constexpr int I_GU = 16 * 32, I_DN = 16 * 16, I_EVIN = 16 * 48, I_EVOUT = 16 * 16, I_ODIN = 16 * 44;
constexpr int N_GU1 = 32 * I_GU, N_DN1 = 32 * I_DN;
DI P0Desc p0_desc(const Frame& F, int it, int part) { P0Desc d; int r = it;
    if (r < N_GU1) { const int mtx = r / I_GU + 32 * part; d.W = F.in[16] + (size_t)mtx * 1024 * 2048; d.WT = WSP(unsigned char, WS_WGU) + (size_t)mtx * 2048 * 1024 * MOE_EB; d.N = 2048; d.Nvalid = 2048; d.sub = r % I_GU; d.fp8 = MOE_FP8; d.scale = WSCALE; return d; } r -= N_GU1;
    if (r < N_DN1) { const int mtx = r / I_DN + 32 * part; d.W = F.in[18] + (size_t)mtx * 1024 * 1024; d.WT = WSP(unsigned char, WS_WD) + (size_t)mtx * 1024 * 1024 * MOE_EB; d.N = 1024; d.Nvalid = 1024; d.sub = r % I_DN; d.fp8 = MOE_FP8; d.scale = WSCALE; return d; } r -= N_DN1;
    if (r < I_EVIN) { d.W = F.in[1]; d.WT = WSP(unsigned char, WS_WEVIN); d.N = EV_COLS; d.Nvalid = EV_COLS; d.sub = r; d.fp8 = IN_FP8; d.scale = WSCALE; return d; } r -= I_EVIN;
    if (r < I_EVOUT) { d.W = F.in[2]; d.WT = WSP(unsigned char, WS_WEVOUT); d.N = 1024; d.Nvalid = 1024; d.sub = r; d.fp8 = PLAIN_FP8; d.scale = WSCALE; return d; } r -= I_EVOUT;
    d.W = F.in[8]; d.WT = WSP(unsigned char, WS_WODIN); d.N = OD_COLS_P; d.Nvalid = OD_COLS; d.sub = r; d.fp8 = IN1_FP8; d.scale = WSCALE; return d; }
DI void p0_convert(const Frame& F, LAS float* scr, int first, int stride, int nitems, int part) {
    int it = first; P0Desc d0, d1; f32x4 v0[16], v1[16];
    if (it < nitems) { d0 = p0_desc(F, it, part); p0_load(d0, v0, F.lane); }
    while (it < nitems) {
        const int itn = it + stride; const bool more = itn < nitems;
        if (more) { d1 = p0_desc(F, itn, part); p0_load(d1, v1, F.lane); }
        p0_finish(d0, v0, scr, F.lane);
        if (more) { d0 = d1;
#pragma unroll
            for (int i = 0; i < 16; ++i) v0[i] = v1[i]; }
        it = itn;
    }
}
DI void p0_convert3(const Frame& F, LAS float* scr, int first, int stride, int nitems, int part) {
    if (first >= nitems) return;
    const int lastit = first + ((nitems - 1 - first) / stride) * stride;
    int it = first; P0Desc dA, dB, dC; f32x4 vA[16], vB[16], vC[16];
#define P0_CL(i_) ((i_) < lastit ? (i_) : lastit)
    dA = p0_desc(F, it, part); p0_load<false>(dA, vA, F.lane);
    dB = p0_desc(F, P0_CL(it + stride), part); p0_load<false>(dB, vB, F.lane);
    for (;;) {
        dC = p0_desc(F, P0_CL(it + 2 * stride), part); p0_load<false>(dC, vC, F.lane);
        p0_finish(dA, vA, scr, F.lane); it += stride; if (it >= nitems) break;
        dA = p0_desc(F, P0_CL(it + 2 * stride), part); p0_load<false>(dA, vA, F.lane);
        p0_finish(dB, vB, scr, F.lane); it += stride; if (it >= nitems) break;
        dB = p0_desc(F, P0_CL(it + 2 * stride), part); p0_load<false>(dB, vB, F.lane);
        p0_finish(dC, vC, scr, F.lane); it += stride; if (it >= nitems) break;
    }
#undef P0_CL
}
DI void p0_prologue(Frame& F) {
    LAS float* scr = (LAS float*)(F.lds + F.wave * 16896);
    const int gw = F.vcu * NWAVES + F.wave, NGW = F.G * NWAVES;
    p0_convert(F, scr, gw, NGW, N_GU1 + N_DN1 + I_EVIN + I_EVOUT + I_ODIN, 0);
    for (int it = gw; it < 32; it += NGW) { const int l = it >> 4; p0_transpose_item(F.in[14] + (size_t)l * 1024 * 32, 1024, 32, 32, WSP(bf16_t, WS_WR) + (size_t)l * 32 * 1024, scr, it & 15, F.lane); }
    {
        const float* wuv = F.in[10]; const float* wout = F.in[11]; bf16_t* wc = WSP(bf16_t, WS_WCOMB); unsigned char* wc8 = WSP(unsigned char, WS_WCOMB);
        for (int it = gw; it < 16 * 512; it += NGW) {
            const int nb = it & 15, kq = __builtin_amdgcn_readfirstlane(it >> 4), k0 = 4 * kq, h = k0 >> 7, n = 64 * nb + F.lane;
            const float* b = wout + (size_t)(h * 64) * 1024 + n; const float* a = wuv + (size_t)k0 * 64;
            float sv[4] = {0.f, 0.f, 0.f, 0.f};
#pragma unroll 32
            for (int d = 0; d < 64; ++d) { const float bv = b[(size_t)d * 1024];
#pragma unroll
                for (int q = 0; q < 4; ++q) sv[q] += a[q * 64 + d] * bv; }
            if (PLAIN_FP8) *(unsigned*)(wc8 + (size_t)n * 2048 + k0) = pk_fp8x4(sv[0] * WCSCALE, sv[1] * WCSCALE, sv[2] * WCSCALE, sv[3] * WCSCALE);
            else { u32x2 w2; w2.x = pk_bf16(sv[0], sv[1]); w2.y = pk_bf16(sv[2], sv[3]); *(u32x2*)(wc + (size_t)n * 2048 + k0) = w2; }
        }
    }
    {
        const float* x = F.in[0]; bf16_t* xb = WSP(bf16_t, WS_XB); unsigned char* x8 = WSP(unsigned char, WS_X8);
        const size_t gt = (size_t)F.vcu * NTHR + F.tid, NGT = (size_t)F.G * NTHR;
        for (size_t o = gt; o < (size_t)T * D / 8; o += 4 * NGT) {
            f32x4 a[4], b[4];
#pragma unroll
            for (int u = 0; u < 4; ++u) { const size_t oo = o + u * NGT; if (oo < (size_t)T * D / 8) { a[u] = __builtin_nontemporal_load((const f32x4*)(x + oo * 8)); b[u] = __builtin_nontemporal_load((const f32x4*)(x + oo * 8 + 4)); } }
#pragma unroll
            for (int u = 0; u < 4; ++u) { const size_t oo = o + u * NGT; if (oo >= (size_t)T * D / 8) break;
                if (IN_FP8) { u32x2 w; w.x = pk_fp8x4(a[u][0] * XSCALE, a[u][1] * XSCALE, a[u][2] * XSCALE, a[u][3] * XSCALE); w.y = pk_fp8x4(b[u][0] * XSCALE, b[u][1] * XSCALE, b[u][2] * XSCALE, b[u][3] * XSCALE); *(u32x2*)(x8 + oo * 8) = w; }
                else { u32x4 w; w.x = pk_bf16(a[u][0], a[u][1]); w.y = pk_bf16(a[u][2], a[u][3]); w.z = pk_bf16(b[u][0], b[u][1]); w.w = pk_bf16(b[u][2], b[u][3]); *(u32x4*)(xb + oo * 8) = w; } }
        }
    }
}

namespace att0 {
constexpr int KP = 144, VP_SB = 144, VP_DF = 288;
constexpr int BUF = 64 * KP + 64 * VP_DF;
constexpr int PITCH = EV_COLS;
DI int crow(int i, int hh) { return (i & 3) + 8 * (i >> 2) + 4 * hh; }
DI bf16x8 pack8(const f32x16& p, int s) {
    u32x4 w; w.x = pk_bf16(p[8 * s], p[8 * s + 1]); w.y = pk_bf16(p[8 * s + 2], p[8 * s + 3]); w.z = pk_bf16(p[8 * s + 4], p[8 * s + 5]); w.w = pk_bf16(p[8 * s + 6], p[8 * s + 7]);
    return __builtin_bit_cast(bf16x8, w);
}
DI s16x4 trrd(const LAS unsigned char* p) { typedef short v4i16_t __attribute__((ext_vector_type(4))); return __builtin_bit_cast(s16x4, __builtin_amdgcn_ds_read_tr16_b64_v4i16((LAS v4i16_t*)p)); }
DI f32x16 qk32(const LAS unsigned char* kb, const bf16x8 (&qf)[4], int lane, f32x16 p = f32x16{}) {
    const LAS unsigned char* kp = kb + (lane & 31) * KP + (lane >> 5) * 16;
#pragma unroll
    for (int s = 0; s < 4; ++s) { const bf16x8 a = *(const LAS bf16x8*)(kp + s * 32); p = __builtin_amdgcn_mfma_f32_32x32x16_bf16(a, qf[s], p, 0, 0, 0); }
    return p;
}
DI const LAS unsigned char* vtlane(const LAS unsigned char* vb, int pitch, int lane) {
    const int hh = lane >> 5, blk = (lane >> 4) & 1, q = (lane & 15) >> 2, p = lane & 3;
    return vb + (4 * hh + q) * pitch + (16 * blk + 4 * p) * 2;
}
DI bf16x8 vtfrag(const LAS unsigned char* vl, int pitch, int c, int rbase) {
    const s16x4 lo = trrd(vl + rbase * pitch + 64 * c), hi = trrd(vl + (rbase + 8) * pitch + 64 * c);
    return __builtin_shufflevector(lo, hi, 0, 1, 2, 3, 4, 5, 6, 7);
}
template <int VD> struct StageRegs { u32x4 k; u32x4 v[VD / 64]; };
template <int VD> DI void stage_load(StageRegs<VD>& r, const bf16_t* proj, int b, int kt, int colK, int colV, int tid) {
    const size_t rowb = (size_t)(b * SEQ + kt * 64);
    r.k = *(const u32x4*)(proj + (rowb + (tid >> 3)) * PITCH + colK + (tid & 7) * 8);
    if (VD == 64) r.v[0] = *(const u32x4*)(proj + (rowb + (tid >> 3)) * PITCH + colV + (tid & 7) * 8);
    else {
#pragma unroll
        for (int j = 0; j < VD / 64; ++j) { const int idx = tid + 512 * j; r.v[j] = *(const u32x4*)(proj + (rowb + (idx >> 4)) * PITCH + colV + (idx & 15) * 8); }
    }
}
template <int VD> DI void stage_write(const StageRegs<VD>& r, LAS unsigned char* buf, int tid) {
    constexpr int VP = VD == 64 ? VP_SB : VP_DF;
    *(LAS u32x4*)(buf + (tid >> 3) * KP + (tid & 7) * 16) = r.k;
    if (VD == 64) *(LAS u32x4*)(buf + 64 * KP + (tid >> 3) * VP + (tid & 7) * 16) = r.v[0];
    else {
#pragma unroll
        for (int j = 0; j < VD / 64; ++j) { const int idx = tid + 512 * j; *(LAS u32x4*)(buf + 64 * KP + (idx >> 4) * VP + (idx & 15) * 16) = r.v[j]; }
    }
}

DI void sb_unit(Frame& F, int b, int h, int qt, const bf16_t* proj, bf16_t* mix) {
    const int tid = F.tid, lane = F.lane, w = F.wave, hh = lane >> 5;
    LAS unsigned char* lds = F.lds;
    volatile LAS int* votes = (volatile LAS int*)(F.lds + LDS_INTS) + 160;
    const int q0 = qt * 256, tw = q0 + 32 * w, t = tw + (lane & 31);
    const int colQ = h * 64, colK = 512 + h * 64, colV = 1024 + h * 64;
    bf16x8 qf[4];
    { const bf16_t* qp = proj + (size_t)(b * SEQ + t) * PITCH + colQ + hh * 8;
#pragma unroll
      for (int s = 0; s < 4; ++s) qf[s] = *(const bf16x8*)(qp + 16 * s); }
    f32x16 O[2]; O[0] = f32x16{}; O[1] = f32x16{};
    float carry = 1.0f;
    int kt = qt * 4 + 3, it = 0;
    StageRegs<64> sr, sn;
    stage_load<64>(sr, proj, b, kt, colK, colV, tid);
    stage_write<64>(sr, lds, tid);
    if (kt > 0) stage_load<64>(sr, proj, b, kt - 1, colK, colV, tid);
    __syncthreads();
    for (;;) {
        const bool more = kt > 0;
        if (kt > 1) stage_load<64>(sn, proj, b, kt - 2, colK, colV, tid);
        const LAS unsigned char* kb = lds + (it & 1) * BUF; const LAS unsigned char* vb = vtlane(kb + 64 * KP, VP_SB, lane);
#pragma unroll
        for (int kbi = 1; kbi >= 0; --kbi) {
            const int key0 = kt * 64 + kbi * 32;
            if (key0 < tw + 31 && __ballot(carry > 0.0f) != 0ull) {
                f32x16 S = qk32(kb + kbi * 32 * KP, qf, lane);
                f32x16 beta, kp;
#pragma unroll
                for (int i = 0; i < 16; ++i) {
                    const int key = key0 + crow(i, hh);
                    float z = fmaxf(S[i] * 0.125f, -30.0f);
                    const float e = fexp2(-z * LOG2E), r = frcp(1.0f + e);
                    const bool valid = key < t;
                    beta[i] = valid ? r : 0.0f; kp[i] = valid ? e * r : 1.0f;
                }
                float a[4], bb[4], wgt[16];
#pragma unroll
                for (int m = 0; m < 4; ++m) { const float k0 = kp[4 * m], k1 = kp[4 * m + 1], k2 = kp[4 * m + 2], k3 = kp[4 * m + 3];
                    wgt[4 * m + 3] = 1.0f; wgt[4 * m + 2] = k3; wgt[4 * m + 1] = k3 * k2; wgt[4 * m] = wgt[4 * m + 1] * k1; a[m] = wgt[4 * m] * k0; }
#pragma unroll
                for (int m = 0; m < 4; ++m) bb[m] = __shfl_xor(a[m], 32);
                float run = carry; f32x16 P;
#pragma unroll
                for (int m = 3; m >= 0; --m) { const float SG = hh ? run : run * bb[m];
#pragma unroll
                    for (int j = 0; j < 4; ++j) P[4 * m + j] = beta[4 * m + j] * (SG * wgt[4 * m + j]);
                    run = run * (a[m] * bb[m]); }
                carry = run;
                const bf16x8 p0 = pack8(P, 0), p1 = pack8(P, 1);
                { const bf16x8 v00 = vtfrag(vb, VP_SB, 0, kbi * 32), v10 = vtfrag(vb, VP_SB, 1, kbi * 32), v01 = vtfrag(vb, VP_SB, 0, kbi * 32 + 16), v11 = vtfrag(vb, VP_SB, 1, kbi * 32 + 16);
                  O[0] = __builtin_amdgcn_mfma_f32_32x32x16_bf16(v00, p0, O[0], 0, 0, 0); O[1] = __builtin_amdgcn_mfma_f32_32x32x16_bf16(v10, p0, O[1], 0, 0, 0);
                  O[0] = __builtin_amdgcn_mfma_f32_32x32x16_bf16(v01, p1, O[0], 0, 0, 0); O[1] = __builtin_amdgcn_mfma_f32_32x32x16_bf16(v11, p1, O[1], 0, 0, 0); }
            }
        }
        if (more) stage_write<64>(sr, lds + ((it + 1) & 1) * BUF, tid);
        const bool act = __ballot(carry > 0.0f) != 0ull;
        if (lane == 0) votes[(it & 1) * 8 + w] = act ? 1 : 0;
        __syncthreads();
        if (!more) break;
        int any = 0;
#pragma unroll
        for (int j = 0; j < 8; ++j) any |= votes[(it & 1) * 8 + j];
        if (!any) break;
        --kt; ++it; sr = sn;
    }
    if (PLAIN_FP8) { unsigned char* op = (unsigned char*)mix + (size_t)(b * SEQ + t) * D + h * 64;
#pragma unroll
        for (int c = 0; c < 2; ++c)
#pragma unroll
            for (int m = 0; m < 4; ++m) *(unsigned*)(op + 32 * c + 8 * m + 4 * hh) = pk_fp8x4(O[c][4 * m] * MSCALE, O[c][4 * m + 1] * MSCALE, O[c][4 * m + 2] * MSCALE, O[c][4 * m + 3] * MSCALE);
    } else { bf16_t* op = mix + (size_t)(b * SEQ + t) * D + h * 64;
#pragma unroll
        for (int c = 0; c < 2; ++c)
#pragma unroll
            for (int m = 0; m < 4; ++m) { u32x2 wv; wv.x = pk_bf16(O[c][4 * m], O[c][4 * m + 1]); wv.y = pk_bf16(O[c][4 * m + 2], O[c][4 * m + 3]);
                *(u32x2*)(op + 32 * c + 8 * m + 4 * hh) = wv; } }
}

DI void diff_unit(Frame& F, int b, int hb, int qt, const bf16_t* proj, bf16_t* mix, float lam, const float* subln) {
    const int tid = F.tid, lane = F.lane, w = F.wave, hh = lane >> 5;
    LAS unsigned char* lds = F.lds;
    const int q0 = qt * 256, tw = q0 + 32 * w, t = tw + (lane & 31);
    const int colV = 2560 + hb * 128;
    const float slope2 = fexp2(-2.0f * (float)(hb + 1)) * LOG2E, sc2 = 0.125f * LOG2E;
    const int ntiles = qt * 4 + 4;
#pragma unroll 1
    for (int cm = 0; cm < 2; ++cm) {
        const int colQ = 1536 + hb * 128 + cm * 64, colK = 2048 + hb * 128 + cm * 64;
        bf16x8 qf[4];
        { const bf16_t* qp = proj + (size_t)(b * SEQ + t) * PITCH + colQ + hh * 8;
#pragma unroll
          for (int s = 0; s < 4; ++s) { const u32x4 raw = *(const u32x4*)(qp + 16 * s); u32x4 sc;
#pragma unroll
              for (int e = 0; e < 4; ++e) sc[e] = pk_bf16(bflo(raw[e]) * sc2, bfhi(raw[e]) * sc2);
              qf[s] = __builtin_bit_cast(bf16x8, sc); } }
        f32x16 O[4];
#pragma unroll
        for (int c = 0; c < 4; ++c) O[c] = f32x16{};
        float mref = 0.0f, lrun = 0.0f;
        StageRegs<128> sr;
        __syncthreads();
        stage_load<128>(sr, proj, b, ntiles - 1, colK, colV, tid);
        stage_write<128>(sr, lds, tid);
        __syncthreads();
        const int kd = tw >> 6;
#pragma unroll 1
        for (int it = 0; it < ntiles; ++it) {
            const int kt = ntiles - 1 - it;
            const bool more = kt > 0;
            if (more) stage_load<128>(sr, proj, b, kt - 1, colK, colV, tid);
            const LAS unsigned char* kb = lds + (it & 1) * BUF; const LAS unsigned char* vb = vtlane(kb + 64 * KP, VP_DF, lane);
            if (kt <= kd) {
                const float cl = slope2 * (float)(64 * kt + 4 * hh - t);
                f32x16 C0, C1;
#pragma unroll
                for (int i = 0; i < 16; ++i) { const float bi = slope2 * (float)((i & 3) + 8 * (i >> 2)); C0[i] = cl + bi; C1[i] = cl + (bi + 32.0f * slope2); }
                f32x16 S0 = C0, S1 = C1;
                { const LAS unsigned char* kp = kb + (lane & 31) * KP + (lane >> 5) * 16;
#pragma unroll
                  for (int s4 = 0; s4 < 4; ++s4) { const bf16x8 a0 = *(const LAS bf16x8*)(kp + s4 * 32), a1 = *(const LAS bf16x8*)(kp + 32 * KP + s4 * 32);
                      S0 = __builtin_amdgcn_mfma_f32_32x32x16_bf16(a0, qf[s4], S0, 0, 0, 0); S1 = __builtin_amdgcn_mfma_f32_32x32x16_bf16(a1, qf[s4], S1, 0, 0, 0); } }
                float mx;
                if (kt == kd) {
#pragma unroll
                    for (int i = 0; i < 16; ++i) { const int k0 = kt * 64 + crow(i, hh);
                        S0[i] = (k0 <= t) ? S0[i] : -INFINITY; S1[i] = (k0 + 32 <= t) ? S1[i] : -INFINITY; }
                }
                mx = fmaxf(S0[0], S1[0]);
#pragma unroll
                for (int i = 1; i < 16; ++i) mx = fmaxf(mx, fmaxf(S0[i], S1[i]));
                mx = fmaxf(mx, __shfl_xor(mx, 32));
                if (kt == kd) mref = mx;
                else if (__ballot(mx > mref + 8.0f) != 0ull) {
                    const float mnew = fmaxf(mref, mx), al = fexp2(mref - mnew); mref = mnew; lrun *= al;
#pragma unroll
                    for (int c = 0; c < 4; ++c)
#pragma unroll
                        for (int i = 0; i < 16; ++i) O[c][i] *= al;
                }
                if (__ballot(mx > mref - 150.0f) != 0ull) {
                float ls = 0.f;
#pragma unroll
                for (int i = 0; i < 16; ++i) { S0[i] = fexp2(S0[i] - mref); S1[i] = fexp2(S1[i] - mref); ls += S0[i] + S1[i]; }
                lrun += ls;
                const bf16x8 p0 = pack8(S0, 0), p1 = pack8(S0, 1), p2 = pack8(S1, 0), p3 = pack8(S1, 1);
#define DF_PVSTEP(row_, p_) do { const bf16x8 f0_ = vtfrag(vb, VP_DF, 0, (row_)), f1_ = vtfrag(vb, VP_DF, 1, (row_)), f2_ = vtfrag(vb, VP_DF, 2, (row_)), f3_ = vtfrag(vb, VP_DF, 3, (row_)); \
                    O[0] = __builtin_amdgcn_mfma_f32_32x32x16_bf16(f0_, (p_), O[0], 0, 0, 0); O[1] = __builtin_amdgcn_mfma_f32_32x32x16_bf16(f1_, (p_), O[1], 0, 0, 0); \
                    O[2] = __builtin_amdgcn_mfma_f32_32x32x16_bf16(f2_, (p_), O[2], 0, 0, 0); O[3] = __builtin_amdgcn_mfma_f32_32x32x16_bf16(f3_, (p_), O[3], 0, 0, 0); __builtin_amdgcn_sched_barrier(0); } while (0)
                DF_PVSTEP(0, p0); DF_PVSTEP(16, p1); DF_PVSTEP(32, p2); DF_PVSTEP(48, p3);
#undef DF_PVSTEP
                }
            }
            if (more) stage_write<128>(sr, lds + ((it + 1) & 1) * BUF, tid);
            __syncthreads();
        }
        const float ltot = lrun + __shfl_xor(lrun, 32);
        const float inv = 1.0f / ltot;
        LAS unsigned char* stash = lds + 2 * BUF + w * 8192 + lane * 16;
        if (cm == 0) {
#pragma unroll
            for (int c = 0; c < 4; ++c)
#pragma unroll
                for (int hf = 0; hf < 2; ++hf) { u32x4 pw;
                    pw.x = pk_bf16(O[c][8 * hf] * inv, O[c][8 * hf + 1] * inv); pw.y = pk_bf16(O[c][8 * hf + 2] * inv, O[c][8 * hf + 3] * inv);
                    pw.z = pk_bf16(O[c][8 * hf + 4] * inv, O[c][8 * hf + 5] * inv); pw.w = pk_bf16(O[c][8 * hf + 6] * inv, O[c][8 * hf + 7] * inv);
                    *(LAS u32x4*)(stash + (2 * c + hf) * 1024) = pw; }
        } else {
            const float li = lam * inv; float ss = 0.f;
#pragma unroll
            for (int c = 0; c < 4; ++c)
#pragma unroll
                for (int hf = 0; hf < 2; ++hf) { const u32x4 pw = *(const LAS u32x4*)(stash + (2 * c + hf) * 1024);
#pragma unroll
                    for (int q = 0; q < 4; ++q) { const float r0 = bflo(pw[q]) - li * O[c][8 * hf + 2 * q], r1 = bfhi(pw[q]) - li * O[c][8 * hf + 2 * q + 1]; ss += r0 * r0 + r1 * r1; } }
            ss += __shfl_xor(ss, 32);
            const float rs = 0.8f / sqrtf(ss * (1.0f / 128.0f) + RMS_EPS);
            bf16_t* op = mix + (size_t)(b * SEQ + t) * D + 512 + hb * 128;
#pragma unroll
            for (int c = 0; c < 4; ++c)
#pragma unroll
                for (int hf = 0; hf < 2; ++hf) { const u32x4 pw = *(const LAS u32x4*)(stash + (2 * c + hf) * 1024);
#pragma unroll
                    for (int mm = 0; mm < 2; ++mm) { const int m = 2 * hf + mm, d0 = 32 * c + 8 * m + 4 * hh; const f32x4 g = *(const f32x4*)(subln + d0);
                        const float r0 = bflo(pw[2 * mm]) - li * O[c][4 * m], r1 = bfhi(pw[2 * mm]) - li * O[c][4 * m + 1], r2 = bflo(pw[2 * mm + 1]) - li * O[c][4 * m + 2], r3 = bfhi(pw[2 * mm + 1]) - li * O[c][4 * m + 3];
                        if (PLAIN_FP8) *(unsigned*)((unsigned char*)mix + (size_t)(b * SEQ + t) * D + 512 + hb * 128 + d0) = pk_fp8x4(r0 * rs * g[0] * MSCALE, r1 * rs * g[1] * MSCALE, r2 * rs * g[2] * MSCALE, r3 * rs * g[3] * MSCALE);
                        else { u32x2 wv; wv.x = pk_bf16(r0 * rs * g[0], r1 * rs * g[1]); wv.y = pk_bf16(r2 * rs * g[2], r3 * rs * g[3]); *(u32x2*)(op + d0) = wv; } } }
        }
    }
}

DI void phase(Frame& F) {
    const bf16_t* proj = WSP(bf16_t, WS_R1); bf16_t* mix = WSP(bf16_t, WS_R2);
    float lam;
    { const float a = F.in[3][F.lane] * F.in[4][F.lane], c = F.in[5][F.lane] * F.in[6][F.lane];
      lam = expf(wave_sum(a)) - expf(wave_sum(c)) + 0.2f; }
    const float* subln = F.in[7];
    const int j = F.vcu;
#ifndef NO_DIFF
    for (int L = j; L < 256; L += F.G) {
#pragma unroll 1
        for (int rep = 0; rep < 2; ++rep) { const int L2 = rep ? 511 - L : L, qt = 7 - (L2 >> 6), bh = L2 & 63; diff_unit(F, bh >> 2, bh & 3, qt, proj, mix, lam, subln); }
    }
#endif
#ifndef NO_SB
    for (int L = j; L < 1024; L += F.G) {
        const int qt = 7 - (L >> 7), bh = L & 127;
        __syncthreads();
        sb_unit(F, bh >> 3, bh & 7, qt, proj, mix);
    }
#endif
    __syncthreads();
}
}

namespace lnr {
constexpr int WP = 2064;
DI void phase(Frame& F, int layer) {
    const int lane = F.lane, w = F.wave, tid = F.tid;
    const bf16_t* pre = WSP(bf16_t, WS_PRE); bf16_t* h1 = WSP(bf16_t, WS_H1); bf16_t* hb = WSP(bf16_t, WS_HB);
    const float* g = F.in[12] + layer * D; const float* bta = F.in[13] + layer * D; const float* rb = F.in[15] + layer * NEXP;
    const bf16_t* wr = WSP(bf16_t, WS_WR) + (size_t)layer * NEXP * D;
    unsigned* cnt = (unsigned*)(F.ctl + (layer ? CW_CNT1 : CW_CNT0));
    int* perm = WSP(int, WS_PERM); int* toker = WSP(int, WS_TOKER); float* tokg = WSP(float, WS_TOKG);
    LAS unsigned char* wl = F.lds;
    LAS float* gl = (LAS float*)(F.lds + 32 * WP);
    LAS int* ints = (LAS int*)(F.lds + LDS_INTS);
    LAS int* hist = ints + 96; LAS int* base = ints + 128;
    for (int i = tid; i < 32 * 128; i += NTHR) { const int r = i >> 7, c = i & 127; *(LAS u32x4*)(wl + r * WP + c * 16) = *(const u32x4*)(wr + (size_t)r * D + c * 8); }
    for (int i = tid; i < D; i += NTHR) { gl[i] = g[i]; gl[D + i] = bta[i]; }
    for (int ub = F.vcu; ub < T / 128; ub += F.G) {
        if (tid < 32) hist[tid] = 0;
        __syncthreads();
        const int r0 = ub * 128 + w * 16;
        float mean_l, rstd_l;
        { const bf16_t* rp = pre + (size_t)(r0 + (lane & 15)) * D + 8 * (lane >> 4);
          float s1 = 0.f, s2 = 0.f;
#pragma unroll 8
          for (int s = 0; s < 32; ++s) { const u32x4 xx = *(const u32x4*)(rp + 32 * s);
#pragma unroll
              for (int e = 0; e < 4; ++e) { const float a = bflo(xx[e]), c = bfhi(xx[e]); s1 += a + c; s2 += a * a + c * c; } }
          s1 += __shfl_xor(s1, 16); s2 += __shfl_xor(s2, 16); s1 += __shfl_xor(s1, 32); s2 += __shfl_xor(s2, 32);
          mean_l = s1 * (1.0f / D);
          const float var = fmaxf(s2 * (1.0f / D) - mean_l * mean_l, 0.0f);
          rstd_l = 1.0f / sqrtf(var + LN_EPS); }
        const int tok = lane & 15, q = lane >> 4; const size_t row = (size_t)(r0 + tok);
        f32x4 acc0 = {0.f, 0.f, 0.f, 0.f}, acc1 = {0.f, 0.f, 0.f, 0.f};
#pragma unroll 2
        for (int s = 0; s < 32; ++s) {
            const int k0 = 32 * s + 8 * q;
            const u32x4 xx = *(const u32x4*)(pre + row * D + k0);
            const f32x4 xa = {bflo(xx.x), bfhi(xx.x), bflo(xx.y), bfhi(xx.y)}, xb = {bflo(xx.z), bfhi(xx.z), bflo(xx.w), bfhi(xx.w)};
            const f32x4 ga = *(const LAS f32x4*)(gl + k0), gb = *(const LAS f32x4*)(gl + k0 + 4), ba = *(const LAS f32x4*)(gl + D + k0), bb = *(const LAS f32x4*)(gl + D + k0 + 4);
            const f32x4 ya = (xa - mean_l) * rstd_l * ga + ba, yb = (xb - mean_l) * rstd_l * gb + bb;
            u32x4 pw; pw.x = pk_bf16(ya[0], ya[1]); pw.y = pk_bf16(ya[2], ya[3]); pw.z = pk_bf16(yb[0], yb[1]); pw.w = pk_bf16(yb[2], yb[3]);
            *(u32x4*)(h1 + row * D + k0) = pw;
            if (!MOE_FP8) *(u32x4*)(hb + row * D + k0) = pw;
            else { u32x2 w8; const f32x4 za = ya * XSCALE, zb = yb * XSCALE;
                int p = __builtin_amdgcn_cvt_pk_fp8_f32(fminf(fmaxf(za[0], -440.f), 440.f), fminf(fmaxf(za[1], -440.f), 440.f), 0, false); p = __builtin_amdgcn_cvt_pk_fp8_f32(fminf(fmaxf(za[2], -440.f), 440.f), fminf(fmaxf(za[3], -440.f), 440.f), p, true); w8.x = (unsigned)p;
                p = __builtin_amdgcn_cvt_pk_fp8_f32(fminf(fmaxf(zb[0], -440.f), 440.f), fminf(fmaxf(zb[1], -440.f), 440.f), 0, false); p = __builtin_amdgcn_cvt_pk_fp8_f32(fminf(fmaxf(zb[2], -440.f), 440.f), fminf(fmaxf(zb[3], -440.f), 440.f), p, true); w8.y = (unsigned)p;
                *(u32x2*)((unsigned char*)hb + row * D + k0) = w8; }
            const bf16x8 bfrag = __builtin_bit_cast(bf16x8, pw);
            const bf16x8 a0 = *(const LAS bf16x8*)(wl + tok * WP + k0 * 2), a1 = *(const LAS bf16x8*)(wl + (16 + tok) * WP + k0 * 2);
            acc0 = __builtin_amdgcn_mfma_f32_16x16x32_bf16(a0, bfrag, acc0, 0, 0, 0);
            acc1 = __builtin_amdgcn_mfma_f32_16x16x32_bf16(a1, bfrag, acc1, 0, 0, 0);
        }
        float v[8];
#pragma unroll
        for (int i = 0; i < 4; ++i) { v[i] = acc0[i] + rb[4 * q + i]; v[4 + i] = acc1[i] + rb[16 + 4 * q + i]; }
        float tv[4]; int te[4];
#pragma unroll
        for (int k = 0; k < 4; ++k) {
            float bv = v[0]; int be = 4 * q;
#pragma unroll
            for (int i = 1; i < 8; ++i) { const int ee = (i < 4) ? 4 * q + i : 16 + 4 * q + (i - 4); if (v[i] > bv) { bv = v[i]; be = ee; } }
#pragma unroll
            for (int o = 16; o <= 32; o <<= 1) { const float ov = __shfl_xor(bv, o); const int oe = __shfl_xor(be, o); if (ov > bv || (ov == bv && oe < be)) { bv = ov; be = oe; } }
            tv[k] = bv; te[k] = be;
#pragma unroll
            for (int i = 0; i < 8; ++i) { const int ee = (i < 4) ? 4 * q + i : 16 + 4 * q + (i - 4); if (ee == be) v[i] = -INFINITY; }
        }
        float ge[4], gs = 0.f;
#pragma unroll
        for (int k = 0; k < 4; ++k) { ge[k] = __expf(tv[k] - tv[0]); gs += ge[k]; }
        const float ginv = 1.0f / gs;
        const int my_e = q == 0 ? te[0] : q == 1 ? te[1] : q == 2 ? te[2] : te[3];
        const float my_g = (q == 0 ? ge[0] : q == 1 ? ge[1] : q == 2 ? ge[2] : ge[3]) * ginv;
        const int rloc = __hip_atomic_fetch_add(hist + my_e, 1, __ATOMIC_RELAXED, __HIP_MEMORY_SCOPE_WORKGROUP);
        __syncthreads();
        if (tid < 32) base[tid] = (int)__hip_atomic_fetch_add(cnt + tid, (unsigned)hist[tid], RLX_AGENT);
        __syncthreads();
        const int rank = base[my_e] + rloc;
        perm[(size_t)my_e * T + rank] = (int)row;
        toker[row * 4 + q] = (my_e << 16) | rank;
        tokg[row * 4 + q] = my_g;
        __syncthreads();
    }
}
}

DI int moe_tileoff(Frame& F, int layer) {
    LAS int* ints = (LAS int*)(F.lds + LDS_INTS);
    unsigned* cnt = (unsigned*)(F.ctl + (layer ? CW_CNT1 : CW_CNT0));
    __syncthreads();
    if (F.tid < 32) ints[F.tid] = (int)__hip_atomic_load(cnt + F.tid, RLX_AGENT);
    __syncthreads();
    if (F.tid < 64) {
        const int tl = (F.tid < 32) ? (ints[F.tid] + 255) >> 8 : 0; int inc = tl;
#pragma unroll
        for (int o = 1; o < 32; o <<= 1) { const int up = __shfl_up(inc, o); if ((F.tid & 63) >= o) inc += up; }
        if (F.tid < 32) ints[32 + F.tid] = inc - tl;
        if (F.tid == 31) ints[64] = inc;
    }
    __syncthreads();
    return ints[64];
}

DI void cmb_phase(Frame& F, int layer, float* outf, bf16_t* outb) {
    const int ntile = moe_tileoff(F, layer); (void)ntile;
    const LAS int* ints = (const LAS int*)(F.lds + LDS_INTS);
    const bf16_t* h1 = WSP(bf16_t, WS_H1); const unsigned char* y = WSP(unsigned char, WS_R1);
    const int* toker = WSP(int, WS_TOKER); const float* tokg = WSP(float, WS_TOKG);
    const float* g = F.in[20] + layer * D; const float* bta = F.in[21] + layer * D;
    const int gw = F.vcu * NWAVES + F.wave, NGW = F.G * NWAVES, lane = F.lane;
    struct RowLd { u32x2 h[4]; int yv[4][4]; f32x4 gg; };
    auto issue = [&](int row, const i32x4& er, const f32x4& gg, RowLd& L) {
        L.gg = gg;
#pragma unroll
        for (int k = 0; k < 4; ++k) { const int e = er[k] >> 16, rank = er[k] & 0xffff; const size_t pos = (size_t)ints[32 + e] * 256 + rank;
#pragma unroll
            for (int j = 0; j < 4; ++j) L.yv[k][j] = __builtin_nontemporal_load((const int*)(y + pos * D) + lane + 64 * j); }
#pragma unroll
        for (int j = 0; j < 4; ++j) L.h[j] = *((const u32x2*)(h1 + (size_t)row * D) + lane + 64 * j);
    };
    i32x4 er1 = {0, 0, 0, 0}; f32x4 gg1 = {0.f, 0.f, 0.f, 0.f}; RowLd L0, L1;
    if (gw < T) { const i32x4 er0 = *(const i32x4*)(toker + (size_t)gw * 4); const f32x4 gg0 = *(const f32x4*)(tokg + (size_t)gw * 4); issue(gw, er0, gg0, L0); }
    if (gw + NGW < T) { er1 = *(const i32x4*)(toker + (size_t)(gw + NGW) * 4); gg1 = *(const f32x4*)(tokg + (size_t)(gw + NGW) * 4); }
    for (int row = gw; row < T; row += NGW) {
        const int rown = row + NGW, rownn = row + 2 * NGW;
        i32x4 er2 = {0, 0, 0, 0}; f32x4 gg2 = {0.f, 0.f, 0.f, 0.f};
        if (rownn < T) { er2 = *(const i32x4*)(toker + (size_t)rownn * 4); gg2 = *(const f32x4*)(tokg + (size_t)rownn * 4); }
        if (rown < T) issue(rown, er1, gg1, L1);
        f32x4 v[4]; float s = 0.f;
#pragma unroll
        for (int j = 0; j < 4; ++j) {
            f32x4 a = (f32x4){bflo(L0.h[j].x), bfhi(L0.h[j].x), bflo(L0.h[j].y), bfhi(L0.h[j].y)} * ALPHA;
#pragma unroll
            for (int k = 0; k < 4; ++k) { const int yy = L0.yv[k][j]; const float gk = L0.gg[k] * (1.0f / YSCALE);
                const f32x2 ylo = __builtin_amdgcn_cvt_pk_f32_fp8(yy, false), yhi = __builtin_amdgcn_cvt_pk_f32_fp8(yy, true);
                a[0] += gk * ylo[0]; a[1] += gk * ylo[1]; a[2] += gk * yhi[0]; a[3] += gk * yhi[1]; }
            v[j] = a; s += (a[0] + a[1]) + (a[2] + a[3]);
        }
        const float mean = wave_sum(s) * (1.0f / D); float s2 = 0.f;
#pragma unroll
        for (int j = 0; j < 4; ++j) { v[j] = v[j] - mean; s2 += (v[j][0] * v[j][0] + v[j][1] * v[j][1]) + (v[j][2] * v[j][2] + v[j][3] * v[j][3]); }
        const float rstd = 1.0f / sqrtf(wave_sum(s2) * (1.0f / D) + LN_EPS);
#pragma unroll
        for (int j = 0; j < 4; ++j) { const f32x4 gv = *((const f32x4*)g + lane + 64 * j), bv = *((const f32x4*)bta + lane + 64 * j);
            const f32x4 o = v[j] * rstd * gv + bv;
            if (outf) __builtin_nontemporal_store(o, (f32x4*)(outf + (size_t)row * D) + lane + 64 * j);
            if (outb) { u32x2 wv; wv.x = pk_bf16(o[0], o[1]); wv.y = pk_bf16(o[2], o[3]); *((u32x2*)(outb + (size_t)row * D) + lane + 64 * j) = wv;
                if (IN1_FP8) *((unsigned*)(WSP(unsigned char, WS_X8) + (size_t)row * D) + lane + 64 * j) = pk_fp8x4(o[0] * XSCALE, o[1] * XSCALE, o[2] * XSCALE, o[3] * XSCALE); } }
        L0 = L1; er1 = er2; gg1 = gg2;
    }
}

DI void moe_up_phase(Frame& F, int layer) {
    const int ntile = moe_tileoff(F, layer);
    LAS int* ints = (LAS int*)(F.lds + LDS_INTS);
    LAS unsigned* tab = (LAS unsigned*)(F.lds + LDS_TAB);
    constexpr unsigned RB = 1024 * MOE_EB;
    pg8::MoeSched S; S.to_lane = (F.lane < 32) ? ints[33 + F.lane] : 0x7fffffff; S.total = ntile * 8; S.G = F.G; S.c = F.vcu; S.ntshift = 3; S.gather = true; S.tab = tab; S.rowb = RB;
    S.W = (const char*)(WSP(unsigned char, WS_WGU) + (size_t)layer * 32 * 2048 * RB); S.wexp = (size_t)2048 * RB; S.wpn = (size_t)128 * RB;
    const int* perm = WSP(int, WS_PERM);
    { int tk[18];
#pragma unroll
      for (int i = 0; i < 18; ++i) { pg8::Unit u; tk[i] = -1;
          if (S.next(i, u) && F.tid < 256) { const int mloc = u.pm - ints[32 + u.e], r = mloc * 256 + F.tid; tk[i] = (r < ints[u.e]) ? perm[(size_t)u.e * T + r] : 0; } }
#pragma unroll
      for (int i = 0; i < 18; ++i) if (tk[i] >= 0) tab[i * 256 + F.tid] = (unsigned)tk[i] * RB; }
    __syncthreads();
    pg8::EpiSwiglu E{WSP(unsigned char, WS_R2), F.in[17] + (size_t)layer * 32 * 2048, MOE_FP8 ? 1.0f / (XSCALE * WSCALE) : 1.0f};
    pg8::gemm_phase<pg8::EpiSwiglu, pg8::MoeSched, MOE_FP8>(F.lds + LDS_STAGE, (const char*)WSP(unsigned char, WS_HB), RB, (size_t)1024 * RB, S, E);
}
DI void moe_down_phase(Frame& F, int layer) {
    const int ntile = moe_tileoff(F, layer);
    LAS int* ints = (LAS int*)(F.lds + LDS_INTS);
    constexpr unsigned RB = 1024 * MOE_EB;
    pg8::MoeSched S; S.to_lane = (F.lane < 32) ? ints[33 + F.lane] : 0x7fffffff; S.total = ntile * 4; S.G = F.G; S.c = F.vcu; S.ntshift = 2; S.gather = false; S.tab = nullptr; S.rowb = RB;
    S.W = (const char*)(WSP(unsigned char, WS_WD) + (size_t)layer * 32 * 1024 * RB); S.wexp = (size_t)1024 * RB; S.wpn = (size_t)256 * RB;
    pg8::EpiDown E{WSP(unsigned char, WS_R1), F.in[19] + (size_t)layer * 32 * 1024, MOE_FP8 ? 1.0f / (ASCALE * WSCALE) : 1.0f};
    pg8::gemm_phase<pg8::EpiDown, pg8::MoeSched, MOE_FP8>(F.lds + LDS_STAGE, (const char*)WSP(unsigned char, WS_R2), RB, (size_t)128 * RB, S, E);
}

namespace idx1 {
constexpr int PITCH = OD_COLS_P;
DI unsigned f2key(float f) { const unsigned u = __float_as_uint(f + 0.0f); return u ^ ((u >> 31) ? 0xffffffffu : 0x80000000u); }
DI int mbcnt64(unsigned long long m) { return (int)__builtin_amdgcn_mbcnt_hi((unsigned)(m >> 32), __builtin_amdgcn_mbcnt_lo((unsigned)m, 0u)); }
DI int wsum6(int c) { int t = 0;
#pragma unroll
    for (int b = 0; b < 6; ++b) t += __builtin_popcountll(__ballot((c >> b) & 1)) << b;
    return t; }
template <int NJ> DI void select_finish(const unsigned (&key)[NJ], unsigned th, int* op, LAS unsigned* bnd, LAS int* list, int lane);
template <int NJ> DI void select256x2(const LAS float* rowA, const LAS float* rowB, int nA, int nB, int* opA, int* opB, LAS unsigned* bnd, LAS int* list, int lane) {
    unsigned keyA[NJ], keyB[NJ];
#pragma unroll
    for (int j = 0; j < NJ; ++j) { const int p = lane + 64 * j; keyA[j] = (p < nA) ? f2key(rowA[p]) : 0u; keyB[j] = (p < nB) ? f2key(rowB[p]) : 0u; }
    unsigned thA = 0u, thB = 0u;
#pragma unroll 1
    for (int bit = 15; bit >= 0; --bit) {
        const unsigned candA = (thA | (1u << bit)) << 16, candB = (thB | (1u << bit)) << 16; int cA = 0, cB = 0;
#pragma unroll
        for (int j = 0; j < NJ; ++j) { cA += (keyA[j] >= candA) ? 1 : 0; cB += (keyB[j] >= candB) ? 1 : 0; }
        int tA = 0, tB = 0;
#pragma unroll
        for (int b = 0; b < 6; ++b) { tA += __builtin_popcountll(__ballot((cA >> b) & 1)) << b; tB += __builtin_popcountll(__ballot((cB >> b) & 1)) << b; }
        if (tA >= 256) thA |= (1u << bit);
        if (tB >= 256) thB |= (1u << bit);
    }
    select_finish<NJ>(keyA, thA, opA, bnd, list, lane);
    select_finish<NJ>(keyB, thB, opB, bnd, list, lane);
}
template <int NJ> DI void select_finish(const unsigned (&key)[NJ], unsigned th, int* op, LAS unsigned* bnd, LAS int* list, int lane) {
    const unsigned lo32 = th << 16;
    int cg = 0, ce = 0;
#pragma unroll
    for (int j = 0; j < NJ; ++j) { const unsigned d = key[j] - lo32; cg += (key[j] >= lo32 && d > 0xffffu) ? 1 : 0; ce += (key[j] >= lo32 && d <= 0xffffu) ? 1 : 0; }
    int G = 0, pre = 0, B = 0, preE = 0;
#pragma unroll
    for (int b = 0; b < 6; ++b) { const unsigned long long m = __ballot((cg >> b) & 1); G += __builtin_popcountll(m) << b; pre += mbcnt64(m) << b;
        const unsigned long long me = __ballot((ce >> b) & 1); B += __builtin_popcountll(me) << b; preE += mbcnt64(me) << b; }
    const int dummy = 256 + lane;
    unsigned lo32b = lo32; asm volatile("" : "+s"(lo32b));
    {   int w = pre;
#pragma unroll
        for (int j = 0; j < NJ; ++j) { const unsigned d = key[j] - lo32b; const bool ab = key[j] >= lo32b && d > 0xffffu; list[ab ? w : dummy] = lane + 64 * j; w += ab ? 1 : 0; }
    }
    const int need = 256 - G;
    if (B <= 64) {
        unsigned lo32c = lo32; asm volatile("" : "+s"(lo32c));
        {   int w = preE;
#pragma unroll
            for (int j = 0; j < NJ; ++j) { const unsigned d = key[j] - lo32c; const bool eq = key[j] >= lo32c && d <= 0xffffu; bnd[eq ? w : 64 + lane] = (d << 11) | (unsigned)(2047 - (lane + 64 * j)); w += eq ? 1 : 0; }
        }
        LDS_WAIT(); asm volatile("" ::: "memory");
        const unsigned mine = (lane < B) ? bnd[lane] : 0u;
        int rank = 0;
#pragma unroll 1
        for (int i = 0; i < B; ++i) { const unsigned o = (unsigned)__builtin_amdgcn_readlane((int)mine, i); rank += (o > mine) ? 1 : 0; }
        list[(lane < B && rank < need) ? G + rank : dummy] = 2047 - (int)(mine & 2047u);
    } else {
        unsigned tl = 0u;
#pragma unroll 1
        for (int bit = 15; bit >= 0; --bit) {
            const unsigned cand = lo32 | tl | (1u << bit); int c = 0;
#pragma unroll
            for (int j = 0; j < NJ; ++j) c += (key[j] >= cand) ? 1 : 0;
            if (wsum6(c) >= 256) tl |= (1u << bit);
        }
        const unsigned tau = lo32 | tl; int base = G;
#pragma unroll
        for (int j = 0; j < NJ; ++j) { const bool sel = key[j] > tau && (key[j] - lo32) <= 0xffffu; const unsigned long long m = __ballot(sel);
            list[sel ? base + mbcnt64(m) : dummy] = lane + 64 * j; base += __builtin_popcountll(m); }
        const int need2 = 256 - base; int eb = 0;
#pragma unroll
        for (int j = 0; j < NJ; ++j) { const bool eq = key[j] == tau; const unsigned long long m = __ballot(eq); const int pos = eb + mbcnt64(m);
            list[(eq && pos < need2) ? base + pos : dummy] = lane + 64 * j; eb += __builtin_popcountll(m); }
    }
    LDS_WAIT(); asm volatile("" ::: "memory");
    *(i32x4*)(op + 4 * lane) = *(const LAS i32x4*)(list + 4 * lane);
    LDS_WAIT(); asm volatile("" ::: "memory");
}
DI void phase(Frame& F) {
    const int lane = F.lane, w = F.wave, tid = F.tid, hh = lane >> 5;
    const bf16_t* proj = WSP(bf16_t, WS_R1);
    { const float* kvw = F.in[9]; bf16_t* ckv = WSP(bf16_t, WS_CKV);
      const int gw = F.vcu * NWAVES + w, NGW = F.G * NWAVES;
      const float w0 = kvw[2 * lane], w1 = kvw[2 * lane + 1];
      for (int row = gw; row < T; row += 4 * NGW) {
          unsigned c[4];
#pragma unroll
          for (int u = 0; u < 4; ++u) c[u] = (row + u * NGW < T) ? *(const unsigned*)(proj + (size_t)(row + u * NGW) * PITCH + 2048 + 2 * lane) : 0u;
#pragma unroll
          for (int u = 0; u < 4; ++u) { if (row + u * NGW >= T) break;
              const float a = bflo(c[u]), b = bfhi(c[u]);
              const float ss = wave_sum(a * a + b * b);
              const float rs = 1.0f / sqrtf(ss * (1.0f / 128.0f) + RMS_EPS);
              *(unsigned*)(ckv + (size_t)(row + u * NGW) * 128 + 2 * lane) = pk_bf16(a * rs * w0, b * rs * w1); }
      } }
    LAS float* sc = (LAS float*)F.lds;
    LAS float* wq = (LAS float*)(F.lds + LDS_TAB);
    LAS unsigned* bnd = (LAS unsigned*)(F.lds + LDS_TAB + 1024) + w * 128;
    LAS int* list = (LAS int*)(F.lds + LDS_TAB + 8192) + w * 320;
    int* idxo = WSP(int, WS_IDX);
    for (int u = F.vcu; u < T / 16; u += F.G) {
        const int b = u >> 7, q0 = (((u & 127) + 16 * (b >> 1)) & 127) * 16;
        __syncthreads();
        if (tid < 128) wq[tid] = bf2f(proj[(size_t)(b * SEQ + q0 + (tid >> 3)) * PITCH + 2752 + (tid & 7)]);
        bf16x8 qf[4][4];
#pragma unroll
        for (int rg = 0; rg < 4; ++rg) { const bf16_t* qp = proj + (size_t)(b * SEQ + q0 + 4 * rg + ((lane & 31) >> 3)) * PITCH + 2176 + (lane & 7) * 64 + hh * 8;
#pragma unroll
            for (int s = 0; s < 4; ++s) qf[rg][s] = *(const bf16x8*)(qp + 16 * s); }
        const int nkb = (q0 + 15) / 32 + 1;
        const bf16_t* kbase = proj + (size_t)(b * SEQ + (lane & 31)) * PITCH + 2688 + hh * 8;
        bf16x8 kf[4], kn[4];
        if (w < nkb) {
#pragma unroll
            for (int s = 0; s < 4; ++s) kf[s] = *(const bf16x8*)(kbase + (size_t)(32 * w) * PITCH + 16 * s); }
        __syncthreads();
        for (int kb = w; kb < nkb; kb += NWAVES) {
            if (kb + NWAVES < nkb) {
#pragma unroll
                for (int s = 0; s < 4; ++s) kn[s] = *(const bf16x8*)(kbase + (size_t)(32 * (kb + NWAVES)) * PITCH + 16 * s); }
#pragma unroll
            for (int rg = 0; rg < 4; ++rg) {
                f32x16 dd = {};
#pragma unroll
                for (int s = 0; s < 4; ++s) dd = __builtin_amdgcn_mfma_f32_32x32x16_bf16(qf[rg][s], kf[s], dd, 0, 0, 0);
                float part[4];
#pragma unroll
                for (int q4 = 0; q4 < 4; ++q4) { const f32x4 wv = *(const LAS f32x4*)(wq + (4 * rg + q4) * 8 + 4 * hh);
                    part[q4] = wv[0] * fmaxf(dd[4 * q4], 0.f) + wv[1] * fmaxf(dd[4 * q4 + 1], 0.f) + wv[2] * fmaxf(dd[4 * q4 + 2], 0.f) + wv[3] * fmaxf(dd[4 * q4 + 3], 0.f); }
#pragma unroll
                for (int q4 = 0; q4 < 4; ++q4) part[q4] += __shfl_xor(part[q4], 32);
                const int key = 32 * kb + (lane & 31);
                if (hh == 0) { sc[(4 * rg + 0) * 2048 + key] = part[0]; sc[(4 * rg + 1) * 2048 + key] = part[1]; }
                else         { sc[(4 * rg + 2) * 2048 + key] = part[2]; sc[(4 * rg + 3) * 2048 + key] = part[3]; }
            }
#pragma unroll
            for (int s = 0; s < 4; ++s) kf[s] = kn[s];
        }
        __syncthreads();
        {
            const int qi = 2 * w, t = q0 + qi, n = t + 1;
            int* opA = idxo + (size_t)(b * SEQ + t) * 256; int* opB = opA + 256;
            if (n + 1 <= 256) {
#pragma unroll
                for (int j = 0; j < 4; ++j) { const int p = lane + 64 * j; opA[p] = (p < n) ? p : -1; opB[p] = (p < n + 1) ? p : -1; }
            } else {
                const LAS float* rowA = sc + qi * 2048; const LAS float* rowB = rowA + 2048;
                if (n + 1 <= 512) select256x2<8>(rowA, rowB, n, n + 1, opA, opB, bnd, list, lane);
                else if (n + 1 <= 1024) select256x2<16>(rowA, rowB, n, n + 1, opA, opB, bnd, list, lane);
                else if (n + 1 <= 1536) select256x2<24>(rowA, rowB, n, n + 1, opA, opB, bnd, list, lane);
                else select256x2<32>(rowA, rowB, n, n + 1, opA, opB, bnd, list, lane);
            }
        }
    }
    __syncthreads();
}
}

namespace spa1 {
constexpr int RP = 272;
constexpr int SPA_WAVES = 7;
constexpr int PITCH = OD_COLS_P;
DI s16x4 trrd(const LAS unsigned char* p) { typedef short v4i16_t __attribute__((ext_vector_type(4))); return __builtin_bit_cast(s16x4, __builtin_amdgcn_ds_read_tr16_b64_v4i16((LAS v4i16_t*)p)); }
DI void phase(Frame& F) {
    const int lane = F.lane, w = F.wave, hd = lane & 15, g = lane >> 4;
    const bf16_t* proj = WSP(bf16_t, WS_R1); const bf16_t* ckv = WSP(bf16_t, WS_CKV); const int* idx = WSP(int, WS_IDX); bf16_t* of = WSP(bf16_t, WS_R2);
    LAS unsigned char* buf = F.lds + w * (32 * RP + 2048);
    LAS float* dl = (LAS float*)(buf + 32 * RP);
    LAS unsigned* ofl = (LAS unsigned*)(buf + 32 * RP + 1024);
    const float slope2 = fexp2(-0.5f * (float)(hd + 1)) * LOG2E, sc2 = 0.08838834764831845f * LOG2E;
    if (w == SPA_WAVES) { p0_convert3(F, (LAS float*)(F.lds + NWAVES * (32 * RP + 2048)), F.vcu, F.G, N_GU1 + N_DN1, 1); return; }
    const int gw = F.vcu * SPA_WAVES + w, NGW = F.G * SPA_WAVES;
#define SPA_Q(jj, b_, t_, row_) const int lin_##jj = gw + (jj) * NGW, b_ = lin_##jj / SEQ, t_ = (lin_##jj + 131 * b_) % SEQ; const size_t row_ = (size_t)(b_ * SEQ + t_)
    i32x4 idr; bf16x8 qn[4];
    if (gw < T) { SPA_Q(0, b0_, t0_, row0_); (void)t0_; idr = *(const i32x4*)(idx + row0_ * 256 + 4 * lane);
        const bf16_t* qp = proj + row0_ * PITCH + hd * 128 + g * 8;
#pragma unroll
        for (int s = 0; s < 4; ++s) qn[s] = *(const bf16x8*)(qp + 32 * s); }
    for (int j = 0; gw + j * NGW < T; ++j) {
        const int lin = gw + j * NGW, b = lin / SEQ, t = (lin + 131 * b) % SEQ;
        const size_t row = (size_t)(b * SEQ + t);
        const int nsel = (t + 1 < 256) ? t + 1 : 256, nch = (nsel + 31) >> 5;
        { f32x4 d4;
#pragma unroll
          for (int e = 0; e < 4; ++e) d4[e] = idr[e] < 0 ? 1.0e30f : (float)(t - idr[e]);
          *(LAS f32x4*)(dl + 4 * lane) = d4; }
        { u32x4 o4;
#pragma unroll
          for (int e = 0; e < 4; ++e) o4[e] = (unsigned)(idr[e] < 0 ? 0 : idr[e]) * 256u;
          *(LAS u32x4*)(ofl + 4 * lane) = o4; }
        const char* ckvb = (const char*)(ckv + (size_t)b * SEQ * 128) + 16 * hd;
        bf16x8 qf[4];
#pragma unroll
        for (int s = 0; s < 4; ++s) qf[s] = qn[s];
        if (gw + (j + 1) * NGW < T) {
            const int lin2 = gw + (j + 1) * NGW, b2 = lin2 / SEQ, t2 = (lin2 + 131 * b2) % SEQ; const size_t row2 = (size_t)(b2 * SEQ + t2);
            idr = *(const i32x4*)(idx + row2 * 256 + 4 * lane);
            const bf16_t* qp = proj + row2 * PITCH + hd * 128 + g * 8;
#pragma unroll
            for (int s = 0; s < 4; ++s) qn[s] = *(const bf16x8*)(qp + 32 * s);
        }
        f32x4 O[8];
#pragma unroll
        for (int c = 0; c < 8; ++c) O[c] = (f32x4){0.f, 0.f, 0.f, 0.f};
        float mrun = -1.0e30f, lrun = 0.f;
#define SPA_CORE             const f32x4 kd0 = *(const LAS f32x4*)(dl + 32 * c + 4 * g) * slope2, kd1 = *(const LAS f32x4*)(dl + 32 * c + 16 + 4 * g) * slope2; \
            f32x4 s0 = {0.f, 0.f, 0.f, 0.f}, s1 = {0.f, 0.f, 0.f, 0.f}; \
_Pragma("unroll") \
            for (int s = 0; s < 4; ++s) { \
                const bf16x8 a0 = *(const LAS bf16x8*)(buf + hd * RP + (32 * s + 8 * g) * 2), a1 = *(const LAS bf16x8*)(buf + (16 + hd) * RP + (32 * s + 8 * g) * 2); \
                s0 = __builtin_amdgcn_mfma_f32_16x16x32_bf16(a0, qf[s], s0, 0, 0, 0); \
                s1 = __builtin_amdgcn_mfma_f32_16x16x32_bf16(a1, qf[s], s1, 0, 0, 0); \
            } \
            float mx = -INFINITY; \
_Pragma("unroll") \
            for (int i = 0; i < 4; ++i) { \
                s0[i] = s0[i] * sc2 - kd0[i]; \
                s1[i] = s1[i] * sc2 - kd1[i]; \
                mx = fmaxf(mx, fmaxf(s0[i], s1[i])); \
            } \
            mx = fmaxf(mx, __shfl_xor(mx, 16)); mx = fmaxf(mx, __shfl_xor(mx, 32)); \
            if (__ballot(mx > mrun + 8.0f) != 0ull) { const float mnew = fmaxf(mrun, mx), al = fexp2(mrun - mnew); mrun = mnew; lrun *= al; \
                _Pragma("unroll") for (int c8 = 0; c8 < 8; ++c8) O[c8] = O[c8] * al; } \
            float ls = 0.f; \
_Pragma("unroll") \
            for (int i = 0; i < 4; ++i) { s0[i] = fexp2(s0[i] - mrun); s1[i] = fexp2(s1[i] - mrun); ls += s0[i] + s1[i]; } \
            lrun += ls; \
            u32x4 pw; pw.x = pk_bf16(s0[0], s0[1]); pw.y = pk_bf16(s0[2], s0[3]); pw.z = pk_bf16(s1[0], s1[1]); pw.w = pk_bf16(s1[2], s1[3]); \
            const bf16x8 pf = __builtin_bit_cast(bf16x8, pw); \
            const int q = hd >> 2, p = hd & 3; \
_Pragma("unroll") \
            for (int c8 = 0; c8 < 8; ++c8) { \
                const LAS unsigned char* a = buf + (4 * g + q) * RP + (16 * c8 + 4 * p) * 2; \
                const s16x4 lo = trrd(a), hi = trrd(a + 16 * RP); \
                const bf16x8 vf = __builtin_shufflevector(lo, hi, 0, 1, 2, 3, 4, 5, 6, 7); \
                O[c8] = __builtin_amdgcn_mfma_f32_16x16x32_bf16(vf, pf, O[c8], 0, 0, 0); \
            }
        u32x4 grA[8], grB[8];
#define SPA_GLOAD(gr_, cc) do { _Pragma("unroll") for (int i_ = 0; i_ < 8; ++i_) gr_[i_] = *(const u32x4*)(ckvb + ofl[32 * (cc) + g + 4 * i_]); } while (0)
#define SPA_CHUNK(gr_, cnext_) do { \
            _Pragma("unroll") for (int i = 0; i < 8; ++i) *(LAS u32x4*)(buf + (g + 4 * i) * RP + 16 * hd) = gr_[i]; \
            if ((cnext_) < nch) SPA_GLOAD(gr_, (cnext_)); \
            SPA_CORE } while (0)
        SPA_GLOAD(grA, 0);
        if (nch > 1) SPA_GLOAD(grB, 1);
#pragma unroll 1
        for (int c2 = 0; c2 < nch; c2 += 2) {
            { const int c = c2; SPA_CHUNK(grA, c2 + 2); }
            if (c2 + 1 < nch) { const int c = c2 + 1; SPA_CHUNK(grB, c2 + 3); }
        }
#undef SPA_CHUNK
#undef SPA_GLOAD
        float lt = lrun + __shfl_xor(lrun, 16); lt += __shfl_xor(lt, 32);
        const float inv = 1.0f / lt;
        if (PLAIN_FP8) { unsigned char* op = (unsigned char*)of + row * 2048 + hd * 128 + 4 * g; const float iv = inv * MSCALE;
#pragma unroll
            for (int c8 = 0; c8 < 8; ++c8) *(unsigned*)(op + 16 * c8) = pk_fp8x4(O[c8][0] * iv, O[c8][1] * iv, O[c8][2] * iv, O[c8][3] * iv);
        } else { bf16_t* op = of + row * 2048 + hd * 128 + 4 * g;
#pragma unroll
            for (int c8 = 0; c8 < 8; ++c8) { u32x2 wv; wv.x = pk_bf16(O[c8][0] * inv, O[c8][1] * inv); wv.y = pk_bf16(O[c8][2] * inv, O[c8][3] * inv); *(u32x2*)(op + 16 * c8) = wv; } }
    }
}
}

constexpr int NPHASE = 16;
struct Args { const float* in[22]; float* out; unsigned char* ws; int ph_lo, ph_hi, bar_region, pad; };
__global__ void __launch_bounds__(NTHR, 2) fwd(Args args) {
    extern __shared__ __attribute__((aligned(16))) unsigned char lds_raw[];
    Frame F;
    F.lds = (LAS unsigned char*)lds_raw;
    F.tid = threadIdx.x; F.lane = F.tid & 63; F.wave = __builtin_amdgcn_readfirstlane(F.tid >> 6);
    F.G = gridDim.x; { const int bx = blockIdx.x; F.vcu = (F.G % 8 == 0) ? (bx % 8) * (F.G / 8) + bx / 8 : bx; }
    F.ws = args.ws; F.ctl = (gu32*)(args.ws + WS_CTL); F.out = args.out;
#pragma unroll
    for (int i = 0; i < 22; ++i) F.in[i] = args.in[i];
    volatile LAS unsigned* MISC = (volatile LAS unsigned*)(F.lds + LDS_MISC);
    if (F.tid < 64) MISC[F.tid] = 0u;
    __syncthreads();
    const int lo = args.ph_lo, hi = args.ph_hi;
    XcdBarrier bar; bar.bar = (unsigned*)(F.ctl + CW_BAR) + args.bar_region * XCD_BAR_WORDS; bar.x = 0; bar.st = nullptr;
    if (hi - lo > 1) bar = xcd_barrier_post((unsigned*)(F.ctl + CW_BAR) + args.bar_region * XCD_BAR_WORDS, MISC + 8);
#ifndef REPEAT_MASK
#define REPEAT_MASK 0
#endif
#ifndef PHASE_MASK
#define PHASE_MASK 0xFFFF
#endif
#define IN(k) (((PHASE_MASK >> (k)) & 1) && lo <= (k) && (k) < hi)
#define REPEAT_LOOP(k)
#define SEAM(k) do { if (IN(k) && IN((k) + 1)) xcd_barrier(bar); } while (0)

    if (IN(0)) { REPEAT_LOOP(0) { p0_prologue(F); } } SEAM(0);
    if (IN(1)) { REPEAT_LOOP(1) { pg8::PlainSched S; S.init(T, EV_COLS, D, D, WSP(unsigned char, WS_WEVIN), F.G, (int)blockIdx.x, IN_EB);
        pg8::EpiProj E{WSP(bf16_t, WS_R1), EV_COLS, IN_FP8 ? 1.0f / (XSCALE * WSCALE) : 1.0f};
        pg8::gemm_phase<pg8::EpiProj, pg8::PlainSched, IN_FP8>(F.lds + LDS_STAGE, (const char*)(IN_FP8 ? WSP(unsigned char, WS_X8) : WSP(unsigned char, WS_XB)), D * IN_EB, (size_t)128 * D * IN_EB, S, E); } } SEAM(1);
    if (IN(2)) { REPEAT_LOOP(2) { att0::phase(F); } } SEAM(2);
    if (IN(3)) { REPEAT_LOOP(3) { pg8::PlainSched S; S.init(T, D, D, D, WSP(unsigned char, WS_WEVOUT), F.G, (int)blockIdx.x, PL_EB);
        pg8::EpiRes E{nullptr, WSP(bf16_t, WS_XB), WSP(bf16_t, WS_PRE), PLAIN_FP8 ? 1.0f / (MSCALE * WSCALE) : 1.0f};
        pg8::gemm_phase<pg8::EpiRes, pg8::PlainSched, PLAIN_FP8>(F.lds + LDS_STAGE, (const char*)WSP(unsigned char, WS_R2), D * PL_EB, (size_t)128 * D * PL_EB, S, E); } } SEAM(3);
    if (IN(4)) { REPEAT_LOOP(4) { lnr::phase(F, 0); } } SEAM(4);
    if (IN(5)) { REPEAT_LOOP(5) { moe_up_phase(F, 0); } } SEAM(5);
    if (IN(6)) { REPEAT_LOOP(6) { moe_down_phase(F, 0); } } SEAM(6);
    if (IN(7)) { REPEAT_LOOP(7) { cmb_phase(F, 0, nullptr, WSP(bf16_t, WS_XB)); } } SEAM(7);
    if (IN(8)) { REPEAT_LOOP(8) { pg8::PlainSched S; S.init(T, OD_COLS_P, D, D, WSP(unsigned char, WS_WODIN), F.G, (int)blockIdx.x, IN1_EB);
        pg8::EpiProj E{WSP(bf16_t, WS_R1), OD_COLS_P, IN1_FP8 ? 1.0f / (XSCALE * WSCALE) : 1.0f};
        pg8::gemm_phase<pg8::EpiProj, pg8::PlainSched, IN1_FP8>(F.lds + LDS_STAGE, (const char*)(IN1_FP8 ? WSP(unsigned char, WS_X8) : WSP(unsigned char, WS_XB)), D * IN1_EB, (size_t)128 * D * IN1_EB, S, E); } } SEAM(8);
    if (IN(9)) { REPEAT_LOOP(9) { idx1::phase(F); } } SEAM(9);
    if (IN(10)) { REPEAT_LOOP(10) { spa1::phase(F); } } SEAM(10);
    if (IN(11)) { REPEAT_LOOP(11) { pg8::PlainSched S; S.init(T, D, 2048, 2048, WSP(unsigned char, WS_WCOMB), F.G, (int)blockIdx.x, PL_EB);
        pg8::EpiRes E{nullptr, WSP(bf16_t, WS_XB), WSP(bf16_t, WS_PRE), PLAIN_FP8 ? 1.0f / (MSCALE * WCSCALE) : 1.0f};
        pg8::gemm_phase<pg8::EpiRes, pg8::PlainSched, PLAIN_FP8>(F.lds + LDS_STAGE, (const char*)WSP(unsigned char, WS_R2), 2048 * PL_EB, (size_t)128 * 2048 * PL_EB, S, E); } } SEAM(11);
    if (IN(12)) { REPEAT_LOOP(12) { lnr::phase(F, 1); } } SEAM(12);
    if (IN(13)) { REPEAT_LOOP(13) { moe_up_phase(F, 1); } } SEAM(13);
    if (IN(14)) { REPEAT_LOOP(14) { moe_down_phase(F, 1); } } SEAM(14);
    if (IN(15)) { REPEAT_LOOP(15) { cmb_phase(F, 1, F.out, nullptr); } } SEAM(15);
#undef IN
#undef SEAM
}

extern "C" void kernel_launch(void* const* d_in, const int* in_sizes, int n_in, void* d_out, int out_size, void* d_ws, size_t ws_size, hipStream_t stream) {
    static int grid = 0;
    if (grid == 0) {
        if (n_in != 22 || out_size != T * D || ws_size < WS_END) { fprintf(stderr, "kernel_launch: unexpected shapes (n_in %d out %d ws %zu need %zu)\n", n_in, out_size, ws_size, (size_t)WS_END); grid = -1; return; }
        int dev = 0, cus = 0;
        if (hipGetDevice(&dev) != hipSuccess || hipDeviceGetAttribute(&cus, hipDeviceAttributeMultiprocessorCount, dev) != hipSuccess) { grid = -1; return; }
        if (hipFuncSetAttribute((const void*)fwd, hipFuncAttributeMaxDynamicSharedMemorySize, LDS_BYTES) != hipSuccess) { fprintf(stderr, "kernel_launch: hipFuncSetAttribute failed\n"); grid = -1; return; }
        int per_cu = 0;
        if (hipOccupancyMaxActiveBlocksPerMultiprocessor(&per_cu, (const void*)fwd, NTHR, LDS_BYTES) != hipSuccess || per_cu < 1) fprintf(stderr, "kernel_launch: occupancy query reports %d\n", per_cu);
        (void)hipGetLastError();
        grid = cus;
    }
    if (grid < 0) return;
    if (hipMemsetAsync((char*)d_ws + WS_CTL, 0, CTL_ZERO_BYTES, stream) != hipSuccess) return;
    Args a{};
    for (int i = 0; i < 22; ++i) a.in[i] = (const float*)d_in[i];
    a.out = (float*)d_out; a.ws = (unsigned char*)d_ws;
#if MK_PER_PHASE
    for (int p = 0; p < NPHASE; ++p) { a.ph_lo = p; a.ph_hi = p + 1; hipLaunchKernelGGL(fwd, dim3(grid), dim3(NTHR), LDS_BYTES, stream, a); }
#elif REPEAT_MASK
    { int lo = 0, reg = 0;
      for (int k = 0; k < NPHASE; ++k) if ((REPEAT_MASK >> k) & 1) {
          a.ph_lo = lo; a.ph_hi = k + 1; a.bar_region = reg++; hipLaunchKernelGGL(fwd, dim3(grid), dim3(NTHR), LDS_BYTES, stream, a);
          a.ph_lo = k; a.ph_hi = k + 1; a.bar_region = reg++; hipLaunchKernelGGL(fwd, dim3(grid), dim3(NTHR), LDS_BYTES, stream, a);
          lo = k + 1; }
      if (lo < NPHASE) { a.ph_lo = lo; a.ph_hi = NPHASE; a.bar_region = reg++; hipLaunchKernelGGL(fwd, dim3(grid), dim3(NTHR), LDS_BYTES, stream, a); } }
#else
    a.ph_lo = 0; a.ph_hi = NPHASE; hipLaunchKernelGGL(fwd, dim3(grid), dim3(NTHR), LDS_BYTES, stream, a);
#endif
}
```

```cpp
#include <hip/hip_runtime.h>
#include <cstdio>
#include <cstdint>

#ifndef MK_PER_PHASE
#define MK_PER_PHASE 0
#endif

#define GAS __attribute__((address_space(1)))
#define LAS __attribute__((address_space(3)))
typedef unsigned short bf16_t;
typedef short bf16x8 __attribute__((ext_vector_type(8)));
typedef short s16x4 __attribute__((ext_vector_type(4)));
typedef float f32x2 __attribute__((ext_vector_type(2)));
typedef float f32x4 __attribute__((ext_vector_type(4)));
typedef float f32x16 __attribute__((ext_vector_type(16)));
typedef unsigned u32x2 __attribute__((ext_vector_type(2)));
typedef unsigned u32x4 __attribute__((ext_vector_type(4)));
typedef int i32x4 __attribute__((ext_vector_type(4)));
typedef GAS unsigned gu32;
#define RLX_AGENT __ATOMIC_RELAXED, __HIP_MEMORY_SCOPE_AGENT
#define DI __device__ __forceinline__

constexpr int BATCH = 16, SEQ = 2048, T = BATCH * SEQ, D = 1024;
constexpr int NEXP = 32, DFF = 1024;
constexpr int EV_COLS = 3072, OD_COLS = 2760, OD_COLS_P = 2816;
constexpr float ALPHA = 1.41421356237309515f;
constexpr float LN_EPS = 1e-5f, RMS_EPS = 1e-5f;
constexpr float LOG2E = 1.4426950408889634f;
constexpr int MAXROWS = 131072 + 32 * 256;
constexpr int NWAVES = 8, NTHR = 512;
#ifndef MOE_FP8_ON
#define MOE_FP8_ON 1
#endif
constexpr bool MOE_FP8 = MOE_FP8_ON != 0;
constexpr int MOE_EB = MOE_FP8 ? 1 : 2;
#ifndef PLAIN_FP8_ON
#define PLAIN_FP8_ON 1
#endif
constexpr bool PLAIN_FP8 = PLAIN_FP8_ON != 0;
#ifndef IN_FP8_ON
#define IN_FP8_ON 0
#endif
constexpr bool IN_FP8 = IN_FP8_ON != 0;
#ifndef IN1_FP8_ON
#define IN1_FP8_ON 0
#endif
constexpr bool IN1_FP8 = IN1_FP8_ON != 0;
constexpr int PL_EB = PLAIN_FP8 ? 1 : 2, IN_EB = IN_FP8 ? 1 : 2, IN1_EB = IN1_FP8 ? 1 : 2;
constexpr float YSCALE = 64.0f;
constexpr float MSCALE = 32.0f, WCSCALE = 1024.0f;
constexpr float WSCALE = 256.0f, XSCALE = 16.0f, ASCALE = 4.0f;

constexpr size_t MiB = 1u << 20;
constexpr size_t WS_CTL = 0, CTL_ZERO_BYTES = 1 * MiB;
constexpr size_t WS_WEVIN = 1 * MiB;
constexpr size_t WS_WEVOUT = 7 * MiB;
constexpr size_t WS_WODIN = 9 * MiB;
constexpr size_t WS_WCOMB = 15 * MiB;
constexpr size_t WS_WR = 19 * MiB;
constexpr size_t WS_WGU = 20 * MiB;
constexpr size_t WS_WD = 276 * MiB;
constexpr size_t WS_XB = 404 * MiB;
constexpr size_t WS_HB = 468 * MiB;
constexpr size_t WS_R1 = 532 * MiB;
constexpr size_t WS_R2 = 804 * MiB;
constexpr size_t WS_PRE = 1076 * MiB;
constexpr size_t WS_H1 = 1204 * MiB;
constexpr size_t WS_X8 = 1332 * MiB;
constexpr size_t WS_PERM = 1460 * MiB;
constexpr size_t WS_TOKER = 1464 * MiB;
constexpr size_t WS_TOKG = 1465 * MiB;
constexpr size_t WS_CKV = 1466 * MiB;
constexpr size_t WS_IDX = 1474 * MiB;
constexpr size_t WS_END = 1506 * MiB;
constexpr int CW_CNT0 = 64, CW_CNT1 = 128;
constexpr int CW_BAR = 4096;

constexpr int LDS_STAGE = 0, LDS_TAB = 131072, LDS_BIAS = 131072 + 18 * 1024, LDS_INTS = 151552, LDS_MISC = 152576, LDS_BYTES = 153600;

DI unsigned pk_bf16(float lo, float hi) { typedef __bf16 b2 __attribute__((ext_vector_type(2))); f32x2 v = {lo, hi}; b2 b = __builtin_convertvector(v, b2); return __builtin_bit_cast(unsigned, b); }
DI unsigned pk_fp8x4(float a, float b, float c, float d) {
    a = fminf(fmaxf(a, -440.f), 440.f); b = fminf(fmaxf(b, -440.f), 440.f); c = fminf(fmaxf(c, -440.f), 440.f); d = fminf(fmaxf(d, -440.f), 440.f);
    int p = __builtin_amdgcn_cvt_pk_fp8_f32(a, b, 0, false); p = __builtin_amdgcn_cvt_pk_fp8_f32(c, d, p, true); return (unsigned)p; }
DI float bf2f(unsigned short b) { return __uint_as_float(((unsigned)b) << 16); }
DI float bflo(unsigned u) { return __uint_as_float(u << 16); }
DI float bfhi(unsigned u) { return __uint_as_float(u & 0xffff0000u); }
DI float wave_sum(float v) {
#pragma unroll
    for (int o = 1; o < 64; o <<= 1) v += __shfl_xor(v, o);
    return v;
}
DI float fexp2(float x) { return __builtin_amdgcn_exp2f(x); }
DI float frcp(float x) { return __builtin_amdgcn_rcpf(x); }
#define LDS_WAIT() asm volatile("s_waitcnt lgkmcnt(0)" ::: "memory")
#define VM_WAIT() asm volatile("s_waitcnt vmcnt(0)" ::: "memory")

#define XB_TMO      128
#define XB_XCNT(j)  (256  + 64 * (j))
#define XB_XSUB(j)  (1280 + 64 * (j))
#define XB_XGEN(j)  (2304 + 64 * (j))
#define XB_TOP      3328
#define XB_TOPGEN   3392
#define XCD_BAR_WORDS 3456
#define XB_SPIN_CAP (1u << 22)
DI unsigned xb_ld(unsigned* p)              { return __hip_atomic_load(p, __ATOMIC_RELAXED, __HIP_MEMORY_SCOPE_AGENT); }
DI unsigned xb_add(unsigned* p, unsigned v) { return __hip_atomic_fetch_add(p, v, __ATOMIC_RELAXED, __HIP_MEMORY_SCOPE_AGENT); }
DI unsigned xb_xcc_id() { return (unsigned)__builtin_amdgcn_s_getreg((3 << 11) | 20) & 0xFu; }
#define XB_SPIN(cond, bar) do { unsigned _sp = 0; while (cond) { __builtin_amdgcn_s_sleep(1); \
    if ((++_sp & 255u) == 0u) { if (xb_ld(&(bar)[XB_TMO])) break; if (_sp > XB_SPIN_CAP) { atomicAdd(&(bar)[XB_TMO], 1u); break; } } } } while (0)
struct XcdBarrier { unsigned* bar; unsigned x; volatile LAS unsigned* st; };
DI XcdBarrier xcd_barrier_post(unsigned* bar, volatile LAS unsigned* st) {
    XcdBarrier b; b.bar = bar; b.x = xb_xcc_id(); b.st = st;
    if (threadIdx.x == 0) (void)xb_add(&bar[XB_XCNT(b.x)], 1u);
    return b;
}
DI void xcd_barrier_complete(unsigned* bar, unsigned x, unsigned& nloc, unsigned& nx) {
    const unsigned G = gridDim.x * gridDim.y * gridDim.z;
    unsigned sum, cnt, mine, sp = 0u;
    for (;;) {
        sum = 0u; cnt = 0u; mine = 0u;
#pragma unroll
        for (unsigned j = 0; j < 16; ++j) { const unsigned c = xb_ld(&bar[XB_XCNT(j)]); sum += c; cnt += (c > 0u) ? 1u : 0u; mine = (j == x) ? c : mine; }
        if (sum == G) break;
        __builtin_amdgcn_s_sleep(1);
        if ((++sp & 255u) == 0u) { if (xb_ld(&bar[XB_TMO])) break; if (sp > XB_SPIN_CAP) { atomicAdd(&bar[XB_TMO], 1u); break; } }
    }
    nloc = mine > 0u ? mine : 1u; nx = cnt > 0u ? cnt : 1u;
}
DI void xcd_barrier(const XcdBarrier& b) {
    asm volatile("s_waitcnt vmcnt(0)" ::: "memory");
    __syncthreads();
    if (threadIdx.x == 0) {
        unsigned* bar = b.bar;
        __builtin_amdgcn_s_waitcnt(0);
        unsigned nloc = b.st[0], nx = b.st[1];
        if (nloc == 0u) { xcd_barrier_complete(bar, b.x, nloc, nx); b.st[0] = nloc; b.st[1] = nx; }
        const unsigned old = xb_add(&bar[XB_XSUB(b.x)], 1u);
        const unsigned gen = old / nloc;
        if (old + 1u == (gen + 1u) * nloc) {
            __builtin_amdgcn_fence(__ATOMIC_RELEASE, "agent");
            asm volatile("s_waitcnt vmcnt(0)" ::: "memory");
            const unsigned og = xb_add(&bar[XB_TOP], 1u);
            const unsigned tg = og / nx;
            if (og + 1u == (tg + 1u) * nx) xb_add(&bar[XB_TOPGEN], 1u);
            else XB_SPIN(xb_ld(&bar[XB_TOPGEN]) == tg, bar);
            __builtin_amdgcn_fence(__ATOMIC_ACQUIRE, "agent");
            xb_add(&bar[XB_XGEN(b.x)], 1u);
            asm volatile("s_waitcnt vmcnt(0)" ::: "memory");
        } else {
            XB_SPIN(xb_ld(&bar[XB_XGEN(b.x)]) == gen, bar);
            __builtin_amdgcn_fence(__ATOMIC_ACQUIRE, "agent");
            asm volatile("s_waitcnt vmcnt(0)" ::: "memory");
        }
    }
    __syncthreads();
}

namespace pg8 {
constexpr int BM = 256, BK = 64, HALF = 128, HTB = HALF * BK * 2, STAGE_BYTES = 8 * HTB, NXCD = 8, WGM = 8;
__host__ __device__ __forceinline__ int lds_byte(int r, int c) { const int st = (r >> 4) * 2 + (c >> 5), rr = r & 15, cc = c & 31, ob = rr * 64 + cc * 2; return st * 1024 + (ob ^ (((ob >> 9) & 1) << 5)); }
__host__ __device__ __forceinline__ void stage_rc(int b, int& R, int& C) { const int st = b / 1024, sb = b % 1024, swz = sb ^ (((sb >> 9) & 1) << 5); R = (st >> 1) * 16 + swz / 64; C = (st & 1) * 32 + (swz % 64) / 2; }
__host__ __device__ __forceinline__ int perm32(int rho) { const int n = rho >> 4, i = rho & 15; return 8 * (i >> 2) + 4 * n + (i & 3); }

struct Unit { int pm, pn, e, slot; const char* Bp; };

typedef int v4i_t __attribute__((ext_vector_type(4)));
typedef int v8i_t __attribute__((ext_vector_type(8)));
template <class Epi, class Sched, bool FP8 = false>
DI void gemm_phase(LAS unsigned char* lds, const char* Abase, const int RB, const size_t hstepB, const Sched& S, const Epi& E) {
    const int tid = threadIdx.x, wid = __builtin_amdgcn_readfirstlane(tid >> 6), lane = tid & 63, wr = wid >> 2, wc = wid & 3, fr = lane & 15, fq = lane >> 4;
    const int nt = RB / 128;
    int RA[2], CA[2]; unsigned voffB[2];
#pragma unroll
    for (int i = 0; i < 2; ++i) { int R, C; stage_rc(tid * 16 + i * 8192, R, C); const int Rb = Epi::PERM ? ((R & ~31) + perm32(R & 31)) : R;
        RA[i] = R; CA[i] = C; voffB[i] = (unsigned)(Rb * RB + C * 2); }
    const size_t kstep = (size_t)(BK * 2);
    const unsigned ldsw = (unsigned)wid * 1024u;
    const int aoff = lds_byte(wr * 64 + fr, fq * 8), boff = lds_byte(wc * 32 + fr, fq * 8);
#define PG8_SA(b, h) (((b) * 2 + (h)) * HTB)
#define PG8_SB(b, h) ((4 + (b) * 2 + (h)) * HTB)
#define PG8_STAGE(bufoff, gbase, voff) do { _Pragma("unroll") for (int _i = 0; _i < 2; ++_i) \
        __builtin_amdgcn_global_load_lds((const unsigned*)((const char*)(gbase) + (voff)[_i]), (LAS unsigned*)(lds + (bufoff) + ldsw + _i * 8192), 16, 0, 0); } while (0)
#define PG8_LDA(dst, b, h) do { _Pragma("unroll") for (int m = 0; m < 4; ++m) { const v4i_t lo_ = *(const LAS v4i_t*)(lds + PG8_SA(b, h) + aoff + m * 2048), hi_ = *(const LAS v4i_t*)(lds + PG8_SA(b, h) + aoff + m * 2048 + 1024); \
        dst[m] = __builtin_shufflevector(lo_, hi_, 0, 1, 2, 3, 4, 5, 6, 7); } } while (0)
#define PG8_LDB(dst, b, h) do { _Pragma("unroll") for (int n = 0; n < 2; ++n) { const v4i_t lo_ = *(const LAS v4i_t*)(lds + PG8_SB(b, h) + boff + n * 2048), hi_ = *(const LAS v4i_t*)(lds + PG8_SB(b, h) + boff + n * 2048 + 1024); \
        dst[n] = __builtin_shufflevector(lo_, hi_, 0, 1, 2, 3, 4, 5, 6, 7); } } while (0)
#define PG8_LO(x) __builtin_bit_cast(bf16x8, __builtin_shufflevector(x, x, 0, 1, 2, 3))
#define PG8_HI(x) __builtin_bit_cast(bf16x8, __builtin_shufflevector(x, x, 4, 5, 6, 7))
#define PG8_MMA(ai, bj, At, Bt) do { __builtin_amdgcn_s_setprio(1); if constexpr (FP8) asm volatile("s_nop 1"); _Pragma("unroll") for (int m = 0; m < 4; ++m) _Pragma("unroll") for (int n = 0; n < 2; ++n) { \
        if constexpr (!FP8) { acc[ai][bj][m][n] = __builtin_amdgcn_mfma_f32_16x16x32_bf16(PG8_LO(Bt[n]), PG8_LO(At[m]), acc[ai][bj][m][n], 0, 0, 0); \
                              acc[ai][bj][m][n] = __builtin_amdgcn_mfma_f32_16x16x32_bf16(PG8_HI(Bt[n]), PG8_HI(At[m]), acc[ai][bj][m][n], 0, 0, 0); } \
        else asm volatile("v_mfma_f32_16x16x128_f8f6f4 %0, %1, %2, %0" : "+v"(acc[ai][bj][m][n]) : "v"(Bt[n]), "v"(At[m])); } __builtin_amdgcn_s_setprio(0); } while (0)
#define PG8_WAIT_V(n) asm volatile("s_waitcnt vmcnt(" #n ")" ::: "memory")
#define PG8_WAIT_L(n) asm volatile("s_waitcnt lgkmcnt(" #n ")" ::: "memory")
#define PG8_BAR __builtin_amdgcn_s_barrier()
#define PG8_SCHED __builtin_amdgcn_sched_barrier(0)
    Unit cur, nxt; int ui = 0;
    if (!S.next(0, cur)) return;
    f32x4 acc[2][2][4][2];
#pragma unroll
    for (int a = 0; a < 2; ++a)
#pragma unroll
        for (int b = 0; b < 2; ++b)
#pragma unroll
            for (int m = 0; m < 4; ++m)
#pragma unroll
                for (int n = 0; n < 2; ++n) acc[a][b][m][n] = (f32x4){0.f, 0.f, 0.f, 0.f};
    v8i_t At[4], B0[2], B1[2];
    unsigned vC0[2], vC1[2], vN0[2], vN1[2];
    S.arows(cur, RA, CA, vC0, vC1);
    const char* cB = cur.Bp;
    LAS unsigned char* bring = lds + (LDS_BIAS - LDS_STAGE);
    if constexpr (Epi::HAS_BIAS) { if (wid == 0) __builtin_amdgcn_global_load_lds((const unsigned*)E.bias_src(cur, lane), (LAS unsigned*)bring, 16, 0, 0); }
    PG8_STAGE(PG8_SB(0, 0), cB, voffB); PG8_STAGE(PG8_SB(0, 1), cB + hstepB, voffB); PG8_STAGE(PG8_SA(0, 0), Abase, vC0); PG8_STAGE(PG8_SA(0, 1), Abase, vC1);
    if (wr == 1) PG8_BAR;
    PG8_WAIT_V(2); PG8_BAR;
    PG8_STAGE(PG8_SB(1, 0), cB + kstep, voffB); PG8_STAGE(PG8_SA(1, 0), Abase + kstep, vC0); PG8_STAGE(PG8_SB(1, 1), cB + hstepB + kstep, voffB);
    PG8_WAIT_V(6); PG8_BAR;
    for (;;) {
        const bool has_next = S.next(ui + 1, nxt);
        if (has_next) S.arows(nxt, RA, CA, vN0, vN1); else { vN0[0] = vC0[0]; vN0[1] = vC0[1]; vN1[0] = vC1[0]; vN1[1] = vC1[1]; }
        const char* nB = has_next ? nxt.Bp : cB;
#pragma unroll 1
        for (int t = 0; t < nt; t += 2) {
            const bool last = (t == nt - 2);
            if constexpr (Epi::HAS_BIAS) { if (last && has_next && wid == 0) __builtin_amdgcn_global_load_lds((const unsigned*)E.bias_src(nxt, lane), (LAS unsigned*)(bring + ((ui + 1) & 1) * 1024), 16, 0, 0); }
            const char* a1 = Abase + (size_t)(t + 1) * kstep;
            const char* a2 = last ? Abase : Abase + (size_t)(t + 2) * kstep; const char* b2 = last ? nB : cB + (size_t)(t + 2) * kstep;
            const char* a3 = a2 + kstep; const char* b3 = b2 + kstep;
            unsigned v20[2], v21[2];
            v20[0] = last ? vN0[0] : vC0[0]; v20[1] = last ? vN0[1] : vC0[1]; v21[0] = last ? vN1[0] : vC1[0]; v21[1] = last ? vN1[1] : vC1[1];
            PG8_LDB(B0, 0, 0); PG8_LDB(B1, 0, 1); PG8_SCHED; PG8_LDA(At, 0, 0); PG8_STAGE(PG8_SA(1, 1), a1, vC1);
            PG8_WAIT_V(8); PG8_WAIT_L(0); PG8_BAR; PG8_MMA(0, 0, At, B0); PG8_MMA(0, 1, At, B1); PG8_BAR; PG8_SCHED;
            PG8_LDA(At, 0, 1); PG8_STAGE(PG8_SB(0, 0), b2, voffB); PG8_STAGE(PG8_SB(0, 1), b2 + hstepB, voffB); PG8_STAGE(PG8_SA(0, 0), a2, v20);
            PG8_WAIT_V(8); PG8_WAIT_L(0); PG8_BAR; PG8_MMA(1, 0, At, B0); PG8_MMA(1, 1, At, B1); PG8_BAR; PG8_SCHED;
            PG8_LDB(B0, 1, 0); PG8_LDB(B1, 1, 1); PG8_SCHED; PG8_LDA(At, 1, 0); PG8_STAGE(PG8_SA(0, 1), a2, v21);
            PG8_WAIT_V(8); PG8_WAIT_L(0); PG8_BAR; PG8_MMA(0, 0, At, B0); PG8_MMA(0, 1, At, B1); PG8_BAR; PG8_SCHED;
            PG8_LDA(At, 1, 1); PG8_STAGE(PG8_SB(1, 0), b3, voffB); PG8_STAGE(PG8_SB(1, 1), b3 + hstepB, voffB); PG8_STAGE(PG8_SA(1, 0), a3, v20);
            PG8_WAIT_V(8); PG8_WAIT_L(0); PG8_BAR; PG8_MMA(1, 0, At, B0); PG8_MMA(1, 1, At, B1); PG8_BAR; PG8_SCHED;
        }
        if (wr == 0) PG8_BAR;
        if constexpr (FP8) asm volatile("s_nop 15\n\ts_nop 15" ::: "memory");
        E(acc, cur, wr, wc, fr, fq, (const LAS float*)(bring + (ui & 1) * 1024));
#ifdef EPI_TWICE
        asm volatile("" ::: "memory"); E(acc, cur, wr, wc, fr, fq, (const LAS float*)(bring + (ui & 1) * 1024));
#endif
        if (!has_next) break;
#pragma unroll
        for (int a = 0; a < 2; ++a)
#pragma unroll
            for (int b = 0; b < 2; ++b)
#pragma unroll
                for (int m = 0; m < 4; ++m)
#pragma unroll
                    for (int n = 0; n < 2; ++n) acc[a][b][m][n] = (f32x4){0.f, 0.f, 0.f, 0.f};
        cur = nxt; cB = nB; vC0[0] = vN0[0]; vC0[1] = vN0[1]; vC1[0] = vN1[0]; vC1[1] = vN1[1]; ++ui;
        if (wr == 1) PG8_BAR;
    }
    PG8_WAIT_V(0);
    PG8_BAR;
#undef PG8_SA
#undef PG8_SB
#undef PG8_STAGE
#undef PG8_LDA
#undef PG8_LDB
#undef PG8_MMA
#undef PG8_LO
#undef PG8_HI
#undef PG8_WAIT_V
#undef PG8_WAIT_L
#undef PG8_BAR
#undef PG8_SCHED
}

struct PlainSched {
    int nM, nN, nwg, G, c; unsigned lda2; const char* Bt; size_t tstepB;
    DI void init(int M, int N, int K, int lda, const void* Bt_, int G_, int c_, int eb = 2) { nM = M / BM; nN = N / BM; nwg = nM * nN; G = G_; c = c_; lda2 = (unsigned)(lda * eb); Bt = (const char*)Bt_; tstepB = (size_t)BM * K * eb; }
    DI bool next(int i, Unit& u) const {
        const long L = (long)i * G + c; if (L >= nwg) return false;
        int wgid = (int)L; { const int q = nwg / NXCD, r = nwg % NXCD, xcd = wgid % NXCD, off = wgid / NXCD; wgid = (xcd < r ? xcd * (q + 1) : r * (q + 1) + (xcd - r) * q) + off; }
        const int nig = WGM * nN, gid = wgid / nig, fm = gid * WGM, gsz = (nM - fm) < WGM ? (nM - fm) : WGM;
        u.pm = fm + ((wgid % nig) % gsz); u.pn = (wgid % nig) / gsz; u.e = 0; u.slot = i; u.Bp = Bt + (size_t)u.pn * tstepB; return true;
    }
    DI void arows(const Unit& u, const int (&R)[2], const int (&C)[2], unsigned (&v0)[2], unsigned (&v1)[2]) const {
#pragma unroll
        for (int i = 0; i < 2; ++i) { v0[i] = (unsigned)(u.pm * BM + R[i]) * lda2 + (unsigned)C[i] * 2u; v1[i] = (unsigned)(u.pm * BM + HALF + R[i]) * lda2 + (unsigned)C[i] * 2u; }
    }
};
struct MoeSched {
    int to_lane;
    int total, G, c, ntshift; bool gather;
    const LAS unsigned* tab;
    const char* W; size_t wexp, wpn; unsigned rowb;
    DI bool next(int i, Unit& u) const {
        const int per = G >> 3, x = c / per, j = c - x * per, ntile = total >> ntshift, tpx = (ntile + 7) >> 3, tpr = per >> ntshift;
        const int loc = i * tpr + (j >> ntshift), mtg = x * tpx + loc, pn = j & ((1 << ntshift) - 1);
        if (loc >= tpx || mtg >= ntile) return false;
        const int e = __builtin_popcountll(__ballot(to_lane <= mtg));
        u.pm = mtg; u.pn = pn; u.e = e; u.slot = i; u.Bp = W + (size_t)e * wexp + (size_t)pn * wpn; return true;
    }
    DI void arows(const Unit& u, const int (&R)[2], const int (&C)[2], unsigned (&v0)[2], unsigned (&v1)[2]) const {
        if (gather) {
#pragma unroll
            for (int i = 0; i < 2; ++i) { v0[i] = tab[u.slot * 256 + R[i]] + (unsigned)C[i] * 2u; v1[i] = tab[u.slot * 256 + HALF + R[i]] + (unsigned)C[i] * 2u; }
        } else {
#pragma unroll
            for (int i = 0; i < 2; ++i) { v0[i] = (unsigned)(u.pm * BM + R[i]) * rowb + (unsigned)C[i] * 2u; v1[i] = (unsigned)(u.pm * BM + HALF + R[i]) * rowb + (unsigned)C[i] * 2u; }
        }
    }
};

struct EpiProj {
    static constexpr bool PERM = true, HAS_BIAS = false; bf16_t* O; int ldc; float ascale;
    DI void operator()(const f32x4 (&acc)[2][2][4][2], const Unit& u, int wr, int wc, int fr, int fq, const LAS float*) const {
        const int row0 = u.pm * BM + wr * 64 + fr, col0 = u.pn * BM + wc * 32 + 8 * fq;
#pragma unroll
        for (int ai = 0; ai < 2; ++ai)
#pragma unroll
            for (int m = 0; m < 4; ++m) { bf16_t* rowp = O + (size_t)(row0 + ai * HALF + m * 16) * ldc + col0;
#pragma unroll
                for (int bj = 0; bj < 2; ++bj) { const f32x4 v0 = acc[ai][bj][m][0] * ascale, v1 = acc[ai][bj][m][1] * ascale;
                    u32x4 w; w.x = pk_bf16(v0[0], v0[1]); w.y = pk_bf16(v0[2], v0[3]); w.z = pk_bf16(v1[0], v1[1]); w.w = pk_bf16(v1[2], v1[3]);
                    *(u32x4*)(rowp + bj * HALF) = w; } }
    }
};
struct EpiRes {
    static constexpr bool PERM = false, HAS_BIAS = false; const float* res; const bf16_t* resb; bf16_t* out; float ascale;
    DI void operator()(const f32x4 (&acc)[2][2][4][2], const Unit& u, int wr, int wc, int fr, int fq, const LAS float*) const {
        const int row0 = u.pm * BM + wr * 64 + fr, col0 = u.pn * BM + wc * 32 + 4 * fq;
        u32x2 rb[2][4][2][2];
#pragma unroll
        for (int ai = 0; ai < 2; ++ai)
#pragma unroll
            for (int m = 0; m < 4; ++m) { const size_t off = (size_t)(row0 + ai * HALF + m * 16) * D + col0;
#pragma unroll
                for (int bj = 0; bj < 2; ++bj)
#pragma unroll
                    for (int n = 0; n < 2; ++n) rb[ai][m][bj][n] = *(const u32x2*)(resb + off + bj * HALF + n * 16); }
#pragma unroll
        for (int ai = 0; ai < 2; ++ai)
#pragma unroll
            for (int m = 0; m < 4; ++m) { const size_t off = (size_t)(row0 + ai * HALF + m * 16) * D + col0;
#pragma unroll
                for (int bj = 0; bj < 2; ++bj)
#pragma unroll
                    for (int n = 0; n < 2; ++n) { const u32x2 rv = rb[ai][m][bj][n]; const f32x4 r = {bflo(rv.x), bfhi(rv.x), bflo(rv.y), bfhi(rv.y)};
                        const f32x4 o = acc[ai][bj][m][n] * ascale + r * ALPHA; u32x2 w; w.x = pk_bf16(o[0], o[1]); w.y = pk_bf16(o[2], o[3]);
                        *(u32x2*)(out + off + bj * HALF + n * 16) = w; } }
    }
};
struct EpiSwiglu {
    static constexpr bool PERM = true, HAS_BIAS = true; unsigned char* O; const float* bgu; float ascale;
    DI const float* bias_src(const Unit& u, int lane) const { return bgu + (size_t)u.e * 2048 + u.pn * HALF + (lane >> 5) * 1024 + 4 * (lane & 31); }
    DI void operator()(const f32x4 (&acc)[2][2][4][2], const Unit& u, int wr, int wc, int fr, int fq, const LAS float* bias) const {
        const int row0 = u.pm * BM + wr * 64 + fr, col0 = u.pn * HALF + wc * 32 + 8 * fq;
        f32x4 bgv[2], buv[2];
#pragma unroll
        for (int n = 0; n < 2; ++n) { bgv[n] = *(const LAS f32x4*)(bias + wc * 32 + 8 * fq + 4 * n); buv[n] = *(const LAS f32x4*)(bias + 128 + wc * 32 + 8 * fq + 4 * n); }
#pragma unroll
        for (int ai = 0; ai < 2; ++ai)
#pragma unroll
            for (int m = 0; m < 4; ++m) { float o[8];
#pragma unroll
                for (int n = 0; n < 2; ++n)
#pragma unroll
                    for (int jj = 0; jj < 2; ++jj) {
                        const f32x2 ag = {acc[ai][0][m][n][2 * jj], acc[ai][0][m][n][2 * jj + 1]}, au = {acc[ai][1][m][n][2 * jj], acc[ai][1][m][n][2 * jj + 1]};
                        const f32x2 bg2 = {bgv[n][2 * jj], bgv[n][2 * jj + 1]}, bu2 = {buv[n][2 * jj], buv[n][2 * jj + 1]};
                        f32x2 g = ag * ascale + bg2, up = au * ascale + bu2;
                        g = __builtin_elementwise_min(g, (f32x2){7.0f, 7.0f});
                        up = __builtin_elementwise_min(__builtin_elementwise_max(up, (f32x2){-7.0f, -7.0f}), (f32x2){7.0f, 7.0f});
                        const f32x2 ex = g * (-1.702f * LOG2E);
                        f32x2 e2; e2.x = fexp2(ex.x); e2.y = fexp2(ex.y);
                        const f32x2 den = e2 + 1.0f;
                        f32x2 sg; sg.x = frcp(den.x); sg.y = frcp(den.y);
                        const f32x2 r = (g * sg) * (up + 1.0f);
                        o[4 * n + 2 * jj] = r.x; o[4 * n + 2 * jj + 1] = r.y; }
                if (!MOE_FP8) { u32x4 w; w.x = pk_bf16(o[0], o[1]); w.y = pk_bf16(o[2], o[3]); w.z = pk_bf16(o[4], o[5]); w.w = pk_bf16(o[6], o[7]);
                    *(u32x4*)(O + ((size_t)(row0 + ai * HALF + m * 16) * DFF + col0) * 2) = w; }
                else { u32x2 w;
                    int p = __builtin_amdgcn_cvt_pk_fp8_f32(o[0] * ASCALE, o[1] * ASCALE, 0, false); p = __builtin_amdgcn_cvt_pk_fp8_f32(o[2] * ASCALE, o[3] * ASCALE, p, true); w.x = (unsigned)p;
                    p = __builtin_amdgcn_cvt_pk_fp8_f32(o[4] * ASCALE, o[5] * ASCALE, 0, false); p = __builtin_amdgcn_cvt_pk_fp8_f32(o[6] * ASCALE, o[7] * ASCALE, p, true); w.y = (unsigned)p;
                    *(u32x2*)(O + (size_t)(row0 + ai * HALF + m * 16) * DFF + col0) = w; } }
    }
};
struct EpiDown {
    static constexpr bool PERM = true, HAS_BIAS = true; unsigned char* O; const float* bd; float ascale;
    DI const float* bias_src(const Unit& u, int lane) const { return bd + (size_t)u.e * 1024 + u.pn * BM + 4 * lane; }
    DI void operator()(const f32x4 (&acc)[2][2][4][2], const Unit& u, int wr, int wc, int fr, int fq, const LAS float* bias) const {
        const int row0 = u.pm * BM + wr * 64 + fr, col0 = u.pn * BM + wc * 32 + 8 * fq;
        f32x4 bv[2][2];
#pragma unroll
        for (int bj = 0; bj < 2; ++bj)
#pragma unroll
            for (int n = 0; n < 2; ++n) bv[bj][n] = *(const LAS f32x4*)(bias + bj * HALF + wc * 32 + 8 * fq + 4 * n) * YSCALE;
        const float as = ascale * YSCALE;
#pragma unroll
        for (int ai = 0; ai < 2; ++ai)
#pragma unroll
            for (int m = 0; m < 4; ++m) { unsigned char* rowp = O + (size_t)(row0 + ai * HALF + m * 16) * D + col0;
#pragma unroll
                for (int bj = 0; bj < 2; ++bj) { const f32x4 v0 = acc[ai][bj][m][0] * as + bv[bj][0], v1 = acc[ai][bj][m][1] * as + bv[bj][1];
                    u32x2 w; w.x = pk_fp8x4(v0[0], v0[1], v0[2], v0[3]); w.y = pk_fp8x4(v1[0], v1[1], v1[2], v1[3]);
                    *(u32x2*)(rowp + bj * HALF) = w; } }
    }
};
}

struct Frame {
    LAS unsigned char* lds;
    gu32* ctl;
    int tid, lane, wave, vcu, G;
    unsigned char* ws;
    const float* in[22];
    float* out;
};
#define WSP(T_, off) ((T_*)(F.ws + (off)))

DI void p0_transpose_item(const float* W, int K, int N, int Nvalid, bf16_t* WT, LAS float* scr, int item, int lane) {
    const int nblk = N / 32, kb = item / nblk, nb = item % nblk, k0 = 64 * kb, n0 = 32 * nb;
    const int n = n0 + (lane & 31); const bool ok = n < Nvalid;
#pragma unroll 8
    for (int i = 0; i < 32; ++i) { const int kk = 2 * i + (lane >> 5); scr[kk * 33 + (lane & 31)] = ok ? W[(size_t)(k0 + kk) * Nvalid + n] : 0.f; }
    LDS_WAIT(); asm volatile("" ::: "memory");
    const int c = lane & 7;
#pragma unroll
    for (int j = 0; j < 4; ++j) { const int nn = (lane >> 3) + 8 * j; const LAS float* s = scr + (8 * c) * 33 + nn;
        u32x4 o; o.x = pk_bf16(s[0 * 33], s[1 * 33]); o.y = pk_bf16(s[2 * 33], s[3 * 33]); o.z = pk_bf16(s[4 * 33], s[5 * 33]); o.w = pk_bf16(s[6 * 33], s[7 * 33]);
        *(GAS u32x4*)(WT + (size_t)(n0 + nn) * K + k0 + 8 * c) = o; }
    LDS_WAIT(); asm volatile("" ::: "memory");
}
struct P0Desc { const float* W; unsigned char* WT; int N, Nvalid, sub, fp8; float scale; };
template <bool CHECK = true> DI void p0_load(const P0Desc& d, f32x4 (&v)[16], int lane) {
    const int nblk = d.N / 64, kb = d.sub / nblk, nb = d.sub % nblk, k0 = 64 * kb, n0 = 64 * nb;
    const int nn = n0 + 4 * (lane & 15); const bool ok = !CHECK || nn < d.Nvalid;
#pragma unroll
    for (int i = 0; i < 16; ++i) { const int kk = 4 * i + (lane >> 4); v[i] = ok ? __builtin_nontemporal_load((const f32x4*)(d.W + (size_t)(k0 + kk) * d.Nvalid + nn)) : (f32x4){0.f, 0.f, 0.f, 0.f}; }
}
DI void p0_finish(const P0Desc& d, const f32x4 (&v)[16], LAS float* scr, int lane) {
    constexpr int K = 1024;
    const int nblk = d.N / 64, kb = d.sub / nblk, nb = d.sub % nblk, k0 = 64 * kb, n0 = 64 * nb;
#pragma unroll
    for (int i = 0; i < 16; ++i) { const int kk = 4 * i + (lane >> 4); LAS float* p = scr + kk * 65 + 4 * (lane & 15); p[0] = v[i][0]; p[1] = v[i][1]; p[2] = v[i][2]; p[3] = v[i][3]; }
    LDS_WAIT(); asm volatile("" ::: "memory");
    if (!d.fp8) {
        const int c = lane & 7;
#pragma unroll
        for (int j = 0; j < 8; ++j) { const int n = (lane >> 3) + 8 * j; const LAS float* sp = scr + (8 * c) * 65 + n;
            u32x4 o; o.x = pk_bf16(sp[0], sp[65]); o.y = pk_bf16(sp[2 * 65], sp[3 * 65]); o.z = pk_bf16(sp[4 * 65], sp[5 * 65]); o.w = pk_bf16(sp[6 * 65], sp[7 * 65]);
            *(GAS u32x4*)(d.WT + ((size_t)(n0 + n) * K + k0 + 8 * c) * 2) = o; }
    } else {
        const int c = lane & 3; const float ws = d.scale;
#pragma unroll
        for (int j = 0; j < 4; ++j) { const int n = (lane >> 2) + 16 * j; const LAS float* sp = scr + (16 * c) * 65 + n;
            u32x4 o;
#pragma unroll
            for (int q = 0; q < 4; ++q) { int p = __builtin_amdgcn_cvt_pk_fp8_f32(sp[(4 * q) * 65] * ws, sp[(4 * q + 1) * 65] * ws, 0, false);
                p = __builtin_amdgcn_cvt_pk_fp8_f32(sp[(4 * q + 2) * 65] * ws, sp[(4 * q + 3) * 65] * ws, p, true); o[q] = (unsigned)p; }
            *(GAS u32x4*)(d.WT + (size_t)(n0 + n) * K + k0 + 16 * c) = o; }
    }
    LDS_WAIT(); asm volatile("" ::: "memory");
}
constexpr int I_GU = 16 * 32, I_DN = 16 * 16, I_EVIN = 16 * 48, I_EVOUT = 16 * 16, I_ODIN = 16 * 44;
constexpr int N_GU1 = 32 * I_GU, N_DN1 = 32 * I_DN;
DI P0Desc p0_desc(const Frame& F, int it, int part) { P0Desc d; int r = it;
    if (r < N_GU1) { const int mtx = r / I_GU + 32 * part; d.W = F.in[16] + (size_t)mtx * 1024 * 2048; d.WT = WSP(unsigned char, WS_WGU) + (size_t)mtx * 2048 * 1024 * MOE_EB; d.N = 2048; d.Nvalid = 2048; d.sub = r % I_GU; d.fp8 = MOE_FP8; d.scale = WSCALE; return d; } r -= N_GU1;
    if (r < N_DN1) { const int mtx = r / I_DN + 32 * part; d.W = F.in[18] + (size_t)mtx * 1024 * 1024; d.WT = WSP(unsigned char, WS_WD) + (size_t)mtx * 1024 * 1024 * MOE_EB; d.N = 1024; d.Nvalid = 1024; d.sub = r % I_DN; d.fp8 = MOE_FP8; d.scale = WSCALE; return d; } r -= N_DN1;
    if (r < I_EVIN) { d.W = F.in[1]; d.WT = WSP(unsigned char, WS_WEVIN); d.N = EV_COLS; d.Nvalid = EV_COLS; d.sub = r; d.fp8 = IN_FP8; d.scale = WSCALE; return d; } r -= I_EVIN;
    if (r < I_EVOUT) { d.W = F.in[2]; d.WT = WSP(unsigned char, WS_WEVOUT); d.N = 1024; d.Nvalid = 1024; d.sub = r; d.fp8 = PLAIN_FP8; d.scale = WSCALE; return d; } r -= I_EVOUT;
    d.W = F.in[8]; d.WT = WSP(unsigned char, WS_WODIN); d.N = OD_COLS_P; d.Nvalid = OD_COLS; d.sub = r; d.fp8 = IN1_FP8; d.scale = WSCALE; return d; }
DI void p0_convert(const Frame& F, LAS float* scr, int first, int stride, int nitems, int part) {
    int it = first; P0Desc d0, d1; f32x4 v0[16], v1[16];
    if (it < nitems) { d0 = p0_desc(F, it, part); p0_load(d0, v0, F.lane); }
    while (it < nitems) {
        const int itn = it + stride; const bool more = itn < nitems;
        if (more) { d1 = p0_desc(F, itn, part); p0_load(d1, v1, F.lane); }
        p0_finish(d0, v0, scr, F.lane);
        if (more) { d0 = d1;
#pragma unroll
            for (int i = 0; i < 16; ++i) v0[i] = v1[i]; }
        it = itn;
    }
}
DI void p0_convert3(const Frame& F, LAS float* scr, int first, int stride, int nitems, int part) {
    if (first >= nitems) return;
    const int lastit = first + ((nitems - 1 - first) / stride) * stride;
    int it = first; P0Desc dA, dB, dC; f32x4 vA[16], vB[16], vC[16];
#define P0_CL(i_) ((i_) < lastit ? (i_) : lastit)
    dA = p0_desc(F, it, part); p0_load<false>(dA, vA, F.lane);
    dB = p0_desc(F, P0_CL(it + stride), part); p0_load<false>(dB, vB, F.lane);
    for (;;) {
        dC = p0_desc(F, P0_CL(it + 2 * stride), part); p0_load<false>(dC, vC, F.lane);
        p0_finish(dA, vA, scr, F.lane); it += stride; if (it >= nitems) break;
        dA = p0_desc(F, P0_CL(it + 2 * stride), part); p0_load<false>(dA, vA, F.lane);
        p0_finish(dB, vB, scr, F.lane); it += stride; if (it >= nitems) break;
        dB = p0_desc(F, P0_CL(it + 2 * stride), part); p0_load<false>(dB, vB, F.lane);
        p0_finish(dC, vC, scr, F.lane); it += stride; if (it >= nitems) break;
    }
#undef P0_CL
}
DI void p0_prologue(Frame& F) {
    LAS float* scr = (LAS float*)(F.lds + F.wave * 16896);
    const int gw = F.vcu * NWAVES + F.wave, NGW = F.G * NWAVES;
    p0_convert(F, scr, gw, NGW, N_GU1 + N_DN1 + I_EVIN + I_EVOUT + I_ODIN, 0);
    for (int it = gw; it < 32; it += NGW) { const int l = it >> 4; p0_transpose_item(F.in[14] + (size_t)l * 1024 * 32, 1024, 32, 32, WSP(bf16_t, WS_WR) + (size_t)l * 32 * 1024, scr, it & 15, F.lane); }
    {
        const float* wuv = F.in[10]; const float* wout = F.in[11]; bf16_t* wc = WSP(bf16_t, WS_WCOMB); unsigned char* wc8 = WSP(unsigned char, WS_WCOMB);
        for (int it = gw; it < 16 * 512; it += NGW) {
            const int nb = it & 15, kq = __builtin_amdgcn_readfirstlane(it >> 4), k0 = 4 * kq, h = k0 >> 7, n = 64 * nb + F.lane;
            const float* b = wout + (size_t)(h * 64) * 1024 + n; const float* a = wuv + (size_t)k0 * 64;
            float sv[4] = {0.f, 0.f, 0.f, 0.f};
#pragma unroll 32
            for (int d = 0; d < 64; ++d) { const float bv = b[(size_t)d * 1024];
#pragma unroll
                for (int q = 0; q < 4; ++q) sv[q] += a[q * 64 + d] * bv; }
            if (PLAIN_FP8) *(unsigned*)(wc8 + (size_t)n * 2048 + k0) = pk_fp8x4(sv[0] * WCSCALE, sv[1] * WCSCALE, sv[2] * WCSCALE, sv[3] * WCSCALE);
            else { u32x2 w2; w2.x = pk_bf16(sv[0], sv[1]); w2.y = pk_bf16(sv[2], sv[3]); *(u32x2*)(wc + (size_t)n * 2048 + k0) = w2; }
        }
    }
    {
        const float* x = F.in[0]; bf16_t* xb = WSP(bf16_t, WS_XB); unsigned char* x8 = WSP(unsigned char, WS_X8);
        const size_t gt = (size_t)F.vcu * NTHR + F.tid, NGT = (size_t)F.G * NTHR;
        for (size_t o = gt; o < (size_t)T * D / 8; o += 4 * NGT) {
            f32x4 a[4], b[4];
#pragma unroll
            for (int u = 0; u < 4; ++u) { const size_t oo = o + u * NGT; if (oo < (size_t)T * D / 8) { a[u] = __builtin_nontemporal_load((const f32x4*)(x + oo * 8)); b[u] = __builtin_nontemporal_load((const f32x4*)(x + oo * 8 + 4)); } }
#pragma unroll
            for (int u = 0; u < 4; ++u) { const size_t oo = o + u * NGT; if (oo >= (size_t)T * D / 8) break;
                if (IN_FP8) { u32x2 w; w.x = pk_fp8x4(a[u][0] * XSCALE, a[u][1] * XSCALE, a[u][2] * XSCALE, a[u][3] * XSCALE); w.y = pk_fp8x4(b[u][0] * XSCALE, b[u][1] * XSCALE, b[u][2] * XSCALE, b[u][3] * XSCALE); *(u32x2*)(x8 + oo * 8) = w; }
                else { u32x4 w; w.x = pk_bf16(a[u][0], a[u][1]); w.y = pk_bf16(a[u][2], a[u][3]); w.z = pk_bf16(b[u][0], b[u][1]); w.w = pk_bf16(b[u][2], b[u][3]); *(u32x4*)(xb + oo * 8) = w; } }
        }
    }
}

namespace att0 {
constexpr int KP = 144, VP_SB = 144, VP_DF = 288;
constexpr int BUF = 64 * KP + 64 * VP_DF;
constexpr int PITCH = EV_COLS;
DI int crow(int i, int hh) { return (i & 3) + 8 * (i >> 2) + 4 * hh; }
DI bf16x8 pack8(const f32x16& p, int s) {
    u32x4 w; w.x = pk_bf16(p[8 * s], p[8 * s + 1]); w.y = pk_bf16(p[8 * s + 2], p[8 * s + 3]); w.z = pk_bf16(p[8 * s + 4], p[8 * s + 5]); w.w = pk_bf16(p[8 * s + 6], p[8 * s + 7]);
    return __builtin_bit_cast(bf16x8, w);
}
DI s16x4 trrd(const LAS unsigned char* p) { typedef short v4i16_t __attribute__((ext_vector_type(4))); return __builtin_bit_cast(s16x4, __builtin_amdgcn_ds_read_tr16_b64_v4i16((LAS v4i16_t*)p)); }
DI f32x16 qk32(const LAS unsigned char* kb, const bf16x8 (&qf)[4], int lane, f32x16 p = f32x16{}) {
    const LAS unsigned char* kp = kb + (lane & 31) * KP + (lane >> 5) * 16;
#pragma unroll
    for (int s = 0; s < 4; ++s) { const bf16x8 a = *(const LAS bf16x8*)(kp + s * 32); p = __builtin_amdgcn_mfma_f32_32x32x16_bf16(a, qf[s], p, 0, 0, 0); }
    return p;
}
DI const LAS unsigned char* vtlane(const LAS unsigned char* vb, int pitch, int lane) {
    const int hh = lane >> 5, blk = (lane >> 4) & 1, q = (lane & 15) >> 2, p = lane & 3;
    return vb + (4 * hh + q) * pitch + (16 * blk + 4 * p) * 2;
}
DI bf16x8 vtfrag(const LAS unsigned char* vl, int pitch, int c, int rbase) {
    const s16x4 lo = trrd(vl + rbase * pitch + 64 * c), hi = trrd(vl + (rbase + 8) * pitch + 64 * c);
    return __builtin_shufflevector(lo, hi, 0, 1, 2, 3, 4, 5, 6, 7);
}
template <int VD> struct StageRegs { u32x4 k; u32x4 v[VD / 64]; };
template <int VD> DI void stage_load(StageRegs<VD>& r, const bf16_t* proj, int b, int kt, int colK, int colV, int tid) {
    const size_t rowb = (size_t)(b * SEQ + kt * 64);
    r.k = *(const u32x4*)(proj + (rowb + (tid >> 3)) * PITCH + colK + (tid & 7) * 8);
    if (VD == 64) r.v[0] = *(const u32x4*)(proj + (rowb + (tid >> 3)) * PITCH + colV + (tid & 7) * 8);
    else {
#pragma unroll
        for (int j = 0; j < VD / 64; ++j) { const int idx = tid + 512 * j; r.v[j] = *(const u32x4*)(proj + (rowb + (idx >> 4)) * PITCH + colV + (idx & 15) * 8); }
    }
}
template <int VD> DI void stage_write(const StageRegs<VD>& r, LAS unsigned char* buf, int tid) {
    constexpr int VP = VD == 64 ? VP_SB : VP_DF;
    *(LAS u32x4*)(buf + (tid >> 3) * KP + (tid & 7) * 16) = r.k;
    if (VD == 64) *(LAS u32x4*)(buf + 64 * KP + (tid >> 3) * VP + (tid & 7) * 16) = r.v[0];
    else {
#pragma unroll
        for (int j = 0; j < VD / 64; ++j) { const int idx = tid + 512 * j; *(LAS u32x4*)(buf + 64 * KP + (idx >> 4) * VP + (idx & 15) * 16) = r.v[j]; }
    }
}

DI void sb_unit(Frame& F, int b, int h, int qt, const bf16_t* proj, bf16_t* mix) {
    const int tid = F.tid, lane = F.lane, w = F.wave, hh = lane >> 5;
    LAS unsigned char* lds = F.lds;
    volatile LAS int* votes = (volatile LAS int*)(F.lds + LDS_INTS) + 160;
    const int q0 = qt * 256, tw = q0 + 32 * w, t = tw + (lane & 31);
    const int colQ = h * 64, colK = 512 + h * 64, colV = 1024 + h * 64;
    bf16x8 qf[4];
    { const bf16_t* qp = proj + (size_t)(b * SEQ + t) * PITCH + colQ + hh * 8;
#pragma unroll
      for (int s = 0; s < 4; ++s) qf[s] = *(const bf16x8*)(qp + 16 * s); }
    f32x16 O[2]; O[0] = f32x16{}; O[1] = f32x16{};
    float carry = 1.0f;
    int kt = qt * 4 + 3, it = 0;
    StageRegs<64> sr, sn;
    stage_load<64>(sr, proj, b, kt, colK, colV, tid);
    stage_write<64>(sr, lds, tid);
    if (kt > 0) stage_load<64>(sr, proj, b, kt - 1, colK, colV, tid);
    __syncthreads();
    for (;;) {
        const bool more = kt > 0;
        if (kt > 1) stage_load<64>(sn, proj, b, kt - 2, colK, colV, tid);
        const LAS unsigned char* kb = lds + (it & 1) * BUF; const LAS unsigned char* vb = vtlane(kb + 64 * KP, VP_SB, lane);
#pragma unroll
        for (int kbi = 1; kbi >= 0; --kbi) {
            const int key0 = kt * 64 + kbi * 32;
            if (key0 < tw + 31 && __ballot(carry > 0.0f) != 0ull) {
                f32x16 S = qk32(kb + kbi * 32 * KP, qf, lane);
                f32x16 beta, kp;
#pragma unroll
                for (int i = 0; i < 16; ++i) {
                    const int key = key0 + crow(i, hh);
                    float z = fmaxf(S[i] * 0.125f, -30.0f);
                    const float e = fexp2(-z * LOG2E), r = frcp(1.0f + e);
                    const bool valid = key < t;
                    beta[i] = valid ? r : 0.0f; kp[i] = valid ? e * r : 1.0f;
                }
                float a[4], bb[4], wgt[16];
#pragma unroll
                for (int m = 0; m < 4; ++m) { const float k0 = kp[4 * m], k1 = kp[4 * m + 1], k2 = kp[4 * m + 2], k3 = kp[4 * m + 3];
                    wgt[4 * m + 3] = 1.0f; wgt[4 * m + 2] = k3; wgt[4 * m + 1] = k3 * k2; wgt[4 * m] = wgt[4 * m + 1] * k1; a[m] = wgt[4 * m] * k0; }
#pragma unroll
                for (int m = 0; m < 4; ++m) bb[m] = __shfl_xor(a[m], 32);
                float run = carry; f32x16 P;
#pragma unroll
                for (int m = 3; m >= 0; --m) { const float SG = hh ? run : run * bb[m];
#pragma unroll
                    for (int j = 0; j < 4; ++j) P[4 * m + j] = beta[4 * m + j] * (SG * wgt[4 * m + j]);
                    run = run * (a[m] * bb[m]); }
                carry = run;
                const bf16x8 p0 = pack8(P, 0), p1 = pack8(P, 1);
                { const bf16x8 v00 = vtfrag(vb, VP_SB, 0, kbi * 32), v10 = vtfrag(vb, VP_SB, 1, kbi * 32), v01 = vtfrag(vb, VP_SB, 0, kbi * 32 + 16), v11 = vtfrag(vb, VP_SB, 1, kbi * 32 + 16);
                  O[0] = __builtin_amdgcn_mfma_f32_32x32x16_bf16(v00, p0, O[0], 0, 0, 0); O[1] = __builtin_amdgcn_mfma_f32_32x32x16_bf16(v10, p0, O[1], 0, 0, 0);
                  O[0] = __builtin_amdgcn_mfma_f32_32x32x16_bf16(v01, p1, O[0], 0, 0, 0); O[1] = __builtin_amdgcn_mfma_f32_32x32x16_bf16(v11, p1, O[1], 0, 0, 0); }
            }
        }
        if (more) stage_write<64>(sr, lds + ((it + 1) & 1) * BUF, tid);
        const bool act = __ballot(carry > 0.0f) != 0ull;
        if (lane == 0) votes[(it & 1) * 8 + w] = act ? 1 : 0;
        __syncthreads();
        if (!more) break;
        int any = 0;
#pragma unroll
        for (int j = 0; j < 8; ++j) any |= votes[(it & 1) * 8 + j];
        if (!any) break;
        --kt; ++it; sr = sn;
    }
    if (PLAIN_FP8) { unsigned char* op = (unsigned char*)mix + (size_t)(b * SEQ + t) * D + h * 64;
#pragma unroll
        for (int c = 0; c < 2; ++c)
#pragma unroll
            for (int m = 0; m < 4; ++m) *(unsigned*)(op + 32 * c + 8 * m + 4 * hh) = pk_fp8x4(O[c][4 * m] * MSCALE, O[c][4 * m + 1] * MSCALE, O[c][4 * m + 2] * MSCALE, O[c][4 * m + 3] * MSCALE);
    } else { bf16_t* op = mix + (size_t)(b * SEQ + t) * D + h * 64;
#pragma unroll
        for (int c = 0; c < 2; ++c)
#pragma unroll
            for (int m = 0; m < 4; ++m) { u32x2 wv; wv.x = pk_bf16(O[c][4 * m], O[c][4 * m + 1]); wv.y = pk_bf16(O[c][4 * m + 2], O[c][4 * m + 3]);
                *(u32x2*)(op + 32 * c + 8 * m + 4 * hh) = wv; } }
}

DI void diff_unit(Frame& F, int b, int hb, int qt, const bf16_t* proj, bf16_t* mix, float lam, const float* subln) {
    const int tid = F.tid, lane = F.lane, w = F.wave, hh = lane >> 5;
    LAS unsigned char* lds = F.lds;
    const int q0 = qt * 256, tw = q0 + 32 * w, t = tw + (lane & 31);
    const int colV = 2560 + hb * 128;
    const float slope2 = fexp2(-2.0f * (float)(hb + 1)) * LOG2E, sc2 = 0.125f * LOG2E;
    const int ntiles = qt * 4 + 4;
#pragma unroll 1
    for (int cm = 0; cm < 2; ++cm) {
        const int colQ = 1536 + hb * 128 + cm * 64, colK = 2048 + hb * 128 + cm * 64;
        bf16x8 qf[4];
        { const bf16_t* qp = proj + (size_t)(b * SEQ + t) * PITCH + colQ + hh * 8;
#pragma unroll
          for (int s = 0; s < 4; ++s) { const u32x4 raw = *(const u32x4*)(qp + 16 * s); u32x4 sc;
#pragma unroll
              for (int e = 0; e < 4; ++e) sc[e] = pk_bf16(bflo(raw[e]) * sc2, bfhi(raw[e]) * sc2);
              qf[s] = __builtin_bit_cast(bf16x8, sc); } }
        f32x16 O[4];
#pragma unroll
        for (int c = 0; c < 4; ++c) O[c] = f32x16{};
        float mref = 0.0f, lrun = 0.0f;
        StageRegs<128> sr;
        __syncthreads();
        stage_load<128>(sr, proj, b, ntiles - 1, colK, colV, tid);
        stage_write<128>(sr, lds, tid);
        __syncthreads();
        const int kd = tw >> 6;
#pragma unroll 1
        for (int it = 0; it < ntiles; ++it) {
            const int kt = ntiles - 1 - it;
            const bool more = kt > 0;
            if (more) stage_load<128>(sr, proj, b, kt - 1, colK, colV, tid);
            const LAS unsigned char* kb = lds + (it & 1) * BUF; const LAS unsigned char* vb = vtlane(kb + 64 * KP, VP_DF, lane);
            if (kt <= kd) {
                const float cl = slope2 * (float)(64 * kt + 4 * hh - t);
                f32x16 C0, C1;
#pragma unroll
                for (int i = 0; i < 16; ++i) { const float bi = slope2 * (float)((i & 3) + 8 * (i >> 2)); C0[i] = cl + bi; C1[i] = cl + (bi + 32.0f * slope2); }
                f32x16 S0 = C0, S1 = C1;
                { const LAS unsigned char* kp = kb + (lane & 31) * KP + (lane >> 5) * 16;
#pragma unroll
                  for (int s4 = 0; s4 < 4; ++s4) { const bf16x8 a0 = *(const LAS bf16x8*)(kp + s4 * 32), a1 = *(const LAS bf16x8*)(kp + 32 * KP + s4 * 32);
                      S0 = __builtin_amdgcn_mfma_f32_32x32x16_bf16(a0, qf[s4], S0, 0, 0, 0); S1 = __builtin_amdgcn_mfma_f32_32x32x16_bf16(a1, qf[s4], S1, 0, 0, 0); } }
                float mx;
                if (kt == kd) {
#pragma unroll
                    for (int i = 0; i < 16; ++i) { const int k0 = kt * 64 + crow(i, hh);
                        S0[i] = (k0 <= t) ? S0[i] : -INFINITY; S1[i] = (k0 + 32 <= t) ? S1[i] : -INFINITY; }
                }
                mx = fmaxf(S0[0], S1[0]);
#pragma unroll
                for (int i = 1; i < 16; ++i) mx = fmaxf(mx, fmaxf(S0[i], S1[i]));
                mx = fmaxf(mx, __shfl_xor(mx, 32));
                if (kt == kd) mref = mx;
                else if (__ballot(mx > mref + 8.0f) != 0ull) {
                    const float mnew = fmaxf(mref, mx), al = fexp2(mref - mnew); mref = mnew; lrun *= al;
#pragma unroll
                    for (int c = 0; c < 4; ++c)
#pragma unroll
                        for (int i = 0; i < 16; ++i) O[c][i] *= al;
                }
                if (__ballot(mx > mref - 150.0f) != 0ull) {
                float ls = 0.f;
#pragma unroll
                for (int i = 0; i < 16; ++i) { S0[i] = fexp2(S0[i] - mref); S1[i] = fexp2(S1[i] - mref); ls += S0[i] + S1[i]; }
                lrun += ls;
                const bf16x8 p0 = pack8(S0, 0), p1 = pack8(S0, 1), p2 = pack8(S1, 0), p3 = pack8(S1, 1);
#define DF_PVSTEP(row_, p_) do { const bf16x8 f0_ = vtfrag(vb, VP_DF, 0, (row_)), f1_ = vtfrag(vb, VP_DF, 1, (row_)), f2_ = vtfrag(vb, VP_DF, 2, (row_)), f3_ = vtfrag(vb, VP_DF, 3, (row_)); \
                    O[0] = __builtin_amdgcn_mfma_f32_32x32x16_bf16(f0_, (p_), O[0], 0, 0, 0); O[1] = __builtin_amdgcn_mfma_f32_32x32x16_bf16(f1_, (p_), O[1], 0, 0, 0); \
                    O[2] = __builtin_amdgcn_mfma_f32_32x32x16_bf16(f2_, (p_), O[2], 0, 0, 0); O[3] = __builtin_amdgcn_mfma_f32_32x32x16_bf16(f3_, (p_), O[3], 0, 0, 0); __builtin_amdgcn_sched_barrier(0); } while (0)
                DF_PVSTEP(0, p0); DF_PVSTEP(16, p1); DF_PVSTEP(32, p2); DF_PVSTEP(48, p3);
#undef DF_PVSTEP
                }
            }
            if (more) stage_write<128>(sr, lds + ((it + 1) & 1) * BUF, tid);
            __syncthreads();
        }
        const float ltot = lrun + __shfl_xor(lrun, 32);
        const float inv = 1.0f / ltot;
        LAS unsigned char* stash = lds + 2 * BUF + w * 8192 + lane * 16;
        if (cm == 0) {
#pragma unroll
            for (int c = 0; c < 4; ++c)
#pragma unroll
                for (int hf = 0; hf < 2; ++hf) { u32x4 pw;
                    pw.x = pk_bf16(O[c][8 * hf] * inv, O[c][8 * hf + 1] * inv); pw.y = pk_bf16(O[c][8 * hf + 2] * inv, O[c][8 * hf + 3] * inv);
                    pw.z = pk_bf16(O[c][8 * hf + 4] * inv, O[c][8 * hf + 5] * inv); pw.w = pk_bf16(O[c][8 * hf + 6] * inv, O[c][8 * hf + 7] * inv);
                    *(LAS u32x4*)(stash + (2 * c + hf) * 1024) = pw; }
        } else {
            const float li = lam * inv; float ss = 0.f;
#pragma unroll
            for (int c = 0; c < 4; ++c)
#pragma unroll
                for (int hf = 0; hf < 2; ++hf) { const u32x4 pw = *(const LAS u32x4*)(stash + (2 * c + hf) * 1024);
#pragma unroll
                    for (int q = 0; q < 4; ++q) { const float r0 = bflo(pw[q]) - li * O[c][8 * hf + 2 * q], r1 = bfhi(pw[q]) - li * O[c][8 * hf + 2 * q + 1]; ss += r0 * r0 + r1 * r1; } }
            ss += __shfl_xor(ss, 32);
            const float rs = 0.8f / sqrtf(ss * (1.0f / 128.0f) + RMS_EPS);
            bf16_t* op = mix + (size_t)(b * SEQ + t) * D + 512 + hb * 128;
#pragma unroll
            for (int c = 0; c < 4; ++c)
#pragma unroll
                for (int hf = 0; hf < 2; ++hf) { const u32x4 pw = *(const LAS u32x4*)(stash + (2 * c + hf) * 1024);
#pragma unroll
                    for (int mm = 0; mm < 2; ++mm) { const int m = 2 * hf + mm, d0 = 32 * c + 8 * m + 4 * hh; const f32x4 g = *(const f32x4*)(subln + d0);
                        const float r0 = bflo(pw[2 * mm]) - li * O[c][4 * m], r1 = bfhi(pw[2 * mm]) - li * O[c][4 * m + 1], r2 = bflo(pw[2 * mm + 1]) - li * O[c][4 * m + 2], r3 = bfhi(pw[2 * mm + 1]) - li * O[c][4 * m + 3];
                        if (PLAIN_FP8) *(unsigned*)((unsigned char*)mix + (size_t)(b * SEQ + t) * D + 512 + hb * 128 + d0) = pk_fp8x4(r0 * rs * g[0] * MSCALE, r1 * rs * g[1] * MSCALE, r2 * rs * g[2] * MSCALE, r3 * rs * g[3] * MSCALE);
                        else { u32x2 wv; wv.x = pk_bf16(r0 * rs * g[0], r1 * rs * g[1]); wv.y = pk_bf16(r2 * rs * g[2], r3 * rs * g[3]); *(u32x2*)(op + d0) = wv; } } }
        }
    }
}

DI void phase(Frame& F) {
    const bf16_t* proj = WSP(bf16_t, WS_R1); bf16_t* mix = WSP(bf16_t, WS_R2);
    float lam;
    { const float a = F.in[3][F.lane] * F.in[4][F.lane], c = F.in[5][F.lane] * F.in[6][F.lane];
      lam = expf(wave_sum(a)) - expf(wave_sum(c)) + 0.2f; }
    const float* subln = F.in[7];
    const int j = F.vcu;
#ifndef NO_DIFF
    for (int L = j; L < 256; L += F.G) {
#pragma unroll 1
        for (int rep = 0; rep < 2; ++rep) { const int L2 = rep ? 511 - L : L, qt = 7 - (L2 >> 6), bh = L2 & 63; diff_unit(F, bh >> 2, bh & 3, qt, proj, mix, lam, subln); }
    }
#endif
#ifndef NO_SB
    for (int L = j; L < 1024; L += F.G) {
        const int qt = 7 - (L >> 7), bh = L & 127;
        __syncthreads();
        sb_unit(F, bh >> 3, bh & 7, qt, proj, mix);
    }
#endif
    __syncthreads();
}
}

namespace lnr {
constexpr int WP = 2064;
DI void phase(Frame& F, int layer) {
    const int lane = F.lane, w = F.wave, tid = F.tid;
    const bf16_t* pre = WSP(bf16_t, WS_PRE); bf16_t* h1 = WSP(bf16_t, WS_H1); bf16_t* hb = WSP(bf16_t, WS_HB);
    const float* g = F.in[12] + layer * D; const float* bta = F.in[13] + layer * D; const float* rb = F.in[15] + layer * NEXP;
    const bf16_t* wr = WSP(bf16_t, WS_WR) + (size_t)layer * NEXP * D;
    unsigned* cnt = (unsigned*)(F.ctl + (layer ? CW_CNT1 : CW_CNT0));
    int* perm = WSP(int, WS_PERM); int* toker = WSP(int, WS_TOKER); float* tokg = WSP(float, WS_TOKG);
    LAS unsigned char* wl = F.lds;
    LAS float* gl = (LAS float*)(F.lds + 32 * WP);
    LAS int* ints = (LAS int*)(F.lds + LDS_INTS);
    LAS int* hist = ints + 96; LAS int* base = ints + 128;
    for (int i = tid; i < 32 * 128; i += NTHR) { const int r = i >> 7, c = i & 127; *(LAS u32x4*)(wl + r * WP + c * 16) = *(const u32x4*)(wr + (size_t)r * D + c * 8); }
    for (int i = tid; i < D; i += NTHR) { gl[i] = g[i]; gl[D + i] = bta[i]; }
    for (int ub = F.vcu; ub < T / 128; ub += F.G) {
        if (tid < 32) hist[tid] = 0;
        __syncthreads();
        const int r0 = ub * 128 + w * 16;
        float mean_l, rstd_l;
        { const bf16_t* rp = pre + (size_t)(r0 + (lane & 15)) * D + 8 * (lane >> 4);
          float s1 = 0.f, s2 = 0.f;
#pragma unroll 8
          for (int s = 0; s < 32; ++s) { const u32x4 xx = *(const u32x4*)(rp + 32 * s);
#pragma unroll
              for (int e = 0; e < 4; ++e) { const float a = bflo(xx[e]), c = bfhi(xx[e]); s1 += a + c; s2 += a * a + c * c; } }
          s1 += __shfl_xor(s1, 16); s2 += __shfl_xor(s2, 16); s1 += __shfl_xor(s1, 32); s2 += __shfl_xor(s2, 32);
          mean_l = s1 * (1.0f / D);
          const float var = fmaxf(s2 * (1.0f / D) - mean_l * mean_l, 0.0f);
          rstd_l = 1.0f / sqrtf(var + LN_EPS); }
        const int tok = lane & 15, q = lane >> 4; const size_t row = (size_t)(r0 + tok);
        f32x4 acc0 = {0.f, 0.f, 0.f, 0.f}, acc1 = {0.f, 0.f, 0.f, 0.f};
#pragma unroll 2
        for (int s = 0; s < 32; ++s) {
            const int k0 = 32 * s + 8 * q;
            const u32x4 xx = *(const u32x4*)(pre + row * D + k0);
            const f32x4 xa = {bflo(xx.x), bfhi(xx.x), bflo(xx.y), bfhi(xx.y)}, xb = {bflo(xx.z), bfhi(xx.z), bflo(xx.w), bfhi(xx.w)};
            const f32x4 ga = *(const LAS f32x4*)(gl + k0), gb = *(const LAS f32x4*)(gl + k0 + 4), ba = *(const LAS f32x4*)(gl + D + k0), bb = *(const LAS f32x4*)(gl + D + k0 + 4);
            const f32x4 ya = (xa - mean_l) * rstd_l * ga + ba, yb = (xb - mean_l) * rstd_l * gb + bb;
            u32x4 pw; pw.x = pk_bf16(ya[0], ya[1]); pw.y = pk_bf16(ya[2], ya[3]); pw.z = pk_bf16(yb[0], yb[1]); pw.w = pk_bf16(yb[2], yb[3]);
            *(u32x4*)(h1 + row * D + k0) = pw;
            if (!MOE_FP8) *(u32x4*)(hb + row * D + k0) = pw;
            else { u32x2 w8; const f32x4 za = ya * XSCALE, zb = yb * XSCALE;
                int p = __builtin_amdgcn_cvt_pk_fp8_f32(fminf(fmaxf(za[0], -440.f), 440.f), fminf(fmaxf(za[1], -440.f), 440.f), 0, false); p = __builtin_amdgcn_cvt_pk_fp8_f32(fminf(fmaxf(za[2], -440.f), 440.f), fminf(fmaxf(za[3], -440.f), 440.f), p, true); w8.x = (unsigned)p;
                p = __builtin_amdgcn_cvt_pk_fp8_f32(fminf(fmaxf(zb[0], -440.f), 440.f), fminf(fmaxf(zb[1], -440.f), 440.f), 0, false); p = __builtin_amdgcn_cvt_pk_fp8_f32(fminf(fmaxf(zb[2], -440.f), 440.f), fminf(fmaxf(zb[3], -440.f), 440.f), p, true); w8.y = (unsigned)p;
                *(u32x2*)((unsigned char*)hb + row * D + k0) = w8; }
            const bf16x8 bfrag = __builtin_bit_cast(bf16x8, pw);
            const bf16x8 a0 = *(const LAS bf16x8*)(wl + tok * WP + k0 * 2), a1 = *(const LAS bf16x8*)(wl + (16 + tok) * WP + k0 * 2);
            acc0 = __builtin_amdgcn_mfma_f32_16x16x32_bf16(a0, bfrag, acc0, 0, 0, 0);
            acc1 = __builtin_amdgcn_mfma_f32_16x16x32_bf16(a1, bfrag, acc1, 0, 0, 0);
        }
        float v[8];
#pragma unroll
        for (int i = 0; i < 4; ++i) { v[i] = acc0[i] + rb[4 * q + i]; v[4 + i] = acc1[i] + rb[16 + 4 * q + i]; }
        float tv[4]; int te[4];
#pragma unroll
        for (int k = 0; k < 4; ++k) {
            float bv = v[0]; int be = 4 * q;
#pragma unroll
            for (int i = 1; i < 8; ++i) { const int ee = (i < 4) ? 4 * q + i : 16 + 4 * q + (i - 4); if (v[i] > bv) { bv = v[i]; be = ee; } }
#pragma unroll
            for (int o = 16; o <= 32; o <<= 1) { const float ov = __shfl_xor(bv, o); const int oe = __shfl_xor(be, o); if (ov > bv || (ov == bv && oe < be)) { bv = ov; be = oe; } }
            tv[k] = bv; te[k] = be;
#pragma unroll
            for (int i = 0; i < 8; ++i) { const int ee = (i < 4) ? 4 * q + i : 16 + 4 * q + (i - 4); if (ee == be) v[i] = -INFINITY; }
        }
        float ge[4], gs = 0.f;
#pragma unroll
        for (int k = 0; k < 4; ++k) { ge[k] = __expf(tv[k] - tv[0]); gs += ge[k]; }
        const float ginv = 1.0f / gs;
        const int my_e = q == 0 ? te[0] : q == 1 ? te[1] : q == 2 ? te[2] : te[3];
        const float my_g = (q == 0 ? ge[0] : q == 1 ? ge[1] : q == 2 ? ge[2] : ge[3]) * ginv;
        const int rloc = __hip_atomic_fetch_add(hist + my_e, 1, __ATOMIC_RELAXED, __HIP_MEMORY_SCOPE_WORKGROUP);
        __syncthreads();
        if (tid < 32) base[tid] = (int)__hip_atomic_fetch_add(cnt + tid, (unsigned)hist[tid], RLX_AGENT);
        __syncthreads();
        const int rank = base[my_e] + rloc;
        perm[(size_t)my_e * T + rank] = (int)row;
        toker[row * 4 + q] = (my_e << 16) | rank;
        tokg[row * 4 + q] = my_g;
        __syncthreads();
    }
}
}

DI int moe_tileoff(Frame& F, int layer) {
    LAS int* ints = (LAS int*)(F.lds + LDS_INTS);
    unsigned* cnt = (unsigned*)(F.ctl + (layer ? CW_CNT1 : CW_CNT0));
    __syncthreads();
    if (F.tid < 32) ints[F.tid] = (int)__hip_atomic_load(cnt + F.tid, RLX_AGENT);
    __syncthreads();
    if (F.tid < 64) {
        const int tl = (F.tid < 32) ? (ints[F.tid] + 255) >> 8 : 0; int inc = tl;
#pragma unroll
        for (int o = 1; o < 32; o <<= 1) { const int up = __shfl_up(inc, o); if ((F.tid & 63) >= o) inc += up; }
        if (F.tid < 32) ints[32 + F.tid] = inc - tl;
        if (F.tid == 31) ints[64] = inc;
    }
    __syncthreads();
    return ints[64];
}

DI void cmb_phase(Frame& F, int layer, float* outf, bf16_t* outb) {
    const int ntile = moe_tileoff(F, layer); (void)ntile;
    const LAS int* ints = (const LAS int*)(F.lds + LDS_INTS);
    const bf16_t* h1 = WSP(bf16_t, WS_H1); const unsigned char* y = WSP(unsigned char, WS_R1);
    const int* toker = WSP(int, WS_TOKER); const float* tokg = WSP(float, WS_TOKG);
    const float* g = F.in[20] + layer * D; const float* bta = F.in[21] + layer * D;
    const int gw = F.vcu * NWAVES + F.wave, NGW = F.G * NWAVES, lane = F.lane;
    struct RowLd { u32x2 h[4]; int yv[4][4]; f32x4 gg; };
    auto issue = [&](int row, const i32x4& er, const f32x4& gg, RowLd& L) {
        L.gg = gg;
#pragma unroll
        for (int k = 0; k < 4; ++k) { const int e = er[k] >> 16, rank = er[k] & 0xffff; const size_t pos = (size_t)ints[32 + e] * 256 + rank;
#pragma unroll
            for (int j = 0; j < 4; ++j) L.yv[k][j] = __builtin_nontemporal_load((const int*)(y + pos * D) + lane + 64 * j); }
#pragma unroll
        for (int j = 0; j < 4; ++j) L.h[j] = *((const u32x2*)(h1 + (size_t)row * D) + lane + 64 * j);
    };
    if (gw >= T) return;
    const int lastrow = gw + ((T - 1 - gw) / NGW) * NGW;
    auto clampr = [&](int r) { return r < lastrow ? r : lastrow; };
    auto reduce = [&](int row, const RowLd& L0) {
        f32x4 v[4]; float s = 0.f;
#pragma unroll
        for (int j = 0; j < 4; ++j) {
            f32x4 a = (f32x4){bflo(L0.h[j].x), bfhi(L0.h[j].x), bflo(L0.h[j].y), bfhi(L0.h[j].y)} * ALPHA;
#pragma unroll
            for (int k = 0; k < 4; ++k) { const int yy = L0.yv[k][j]; const float gk = L0.gg[k] * (1.0f / YSCALE);
                const f32x2 ylo = __builtin_amdgcn_cvt_pk_f32_fp8(yy, false), yhi = __builtin_amdgcn_cvt_pk_f32_fp8(yy, true);
                a[0] += gk * ylo[0]; a[1] += gk * ylo[1]; a[2] += gk * yhi[0]; a[3] += gk * yhi[1]; }
            v[j] = a; s += (a[0] + a[1]) + (a[2] + a[3]);
        }
        const float mean = wave_sum(s) * (1.0f / D); float s2 = 0.f;
#pragma unroll
        for (int j = 0; j < 4; ++j) { v[j] = v[j] - mean; s2 += (v[j][0] * v[j][0] + v[j][1] * v[j][1]) + (v[j][2] * v[j][2] + v[j][3] * v[j][3]); }
        const float rstd = 1.0f / sqrtf(wave_sum(s2) * (1.0f / D) + LN_EPS);
#pragma unroll
        for (int j = 0; j < 4; ++j) { const f32x4 gv = *((const f32x4*)g + lane + 64 * j), bv = *((const f32x4*)bta + lane + 64 * j);
            const f32x4 o = v[j] * rstd * gv + bv;
            if (outf) __builtin_nontemporal_store(o, (f32x4*)(outf + (size_t)row * D) + lane + 64 * j);
            if (outb) { u32x2 wv; wv.x = pk_bf16(o[0], o[1]); wv.y = pk_bf16(o[2], o[3]); *((u32x2*)(outb + (size_t)row * D) + lane + 64 * j) = wv;
                if (IN1_FP8) *((unsigned*)(WSP(unsigned char, WS_X8) + (size_t)row * D) + lane + 64 * j) = pk_fp8x4(o[0] * XSCALE, o[1] * XSCALE, o[2] * XSCALE, o[3] * XSCALE); } }
    };
    RowLd LA, LB, LC; i32x4 eP, eQ, eR; f32x4 gP, gQ, gR;
#define CMB_ROUTE(e_, g_, r_) do { const int rr_ = clampr(r_); e_ = *(const i32x4*)(toker + (size_t)rr_ * 4); g_ = *(const f32x4*)(tokg + (size_t)rr_ * 4); } while (0)
    { i32x4 e0, e1; f32x4 g0, g1;
      CMB_ROUTE(e0, g0, gw); CMB_ROUTE(e1, g1, gw + NGW); CMB_ROUTE(eP, gP, gw + 2 * NGW); CMB_ROUTE(eQ, gQ, gw + 3 * NGW);
      issue(gw, e0, g0, LA); issue(clampr(gw + NGW), e1, g1, LB); }
#define CMB_STEP(X_, Z_, eP_, gP_, eR_, gR_) do { CMB_ROUTE(eR_, gR_, row + 4 * NGW); issue(clampr(row + 2 * NGW), eP_, gP_, Z_); reduce(row, X_); row += NGW; } while (0)
    for (int row = gw;;) {
        CMB_STEP(LA, LC, eP, gP, eR, gR); if (row >= T) break;
        CMB_STEP(LB, LA, eQ, gQ, eP, gP); if (row >= T) break;
        CMB_STEP(LC, LB, eR, gR, eQ, gQ); if (row >= T) break;
    }
#undef CMB_STEP
#undef CMB_ROUTE
}

DI void moe_up_phase(Frame& F, int layer) {
    const int ntile = moe_tileoff(F, layer);
    LAS int* ints = (LAS int*)(F.lds + LDS_INTS);
    LAS unsigned* tab = (LAS unsigned*)(F.lds + LDS_TAB);
    constexpr unsigned RB = 1024 * MOE_EB;
    pg8::MoeSched S; S.to_lane = (F.lane < 32) ? ints[33 + F.lane] : 0x7fffffff; S.total = ntile * 8; S.G = F.G; S.c = F.vcu; S.ntshift = 3; S.gather = true; S.tab = tab; S.rowb = RB;
    S.W = (const char*)(WSP(unsigned char, WS_WGU) + (size_t)layer * 32 * 2048 * RB); S.wexp = (size_t)2048 * RB; S.wpn = (size_t)128 * RB;
    const int* perm = WSP(int, WS_PERM);
    { int tk[18];
#pragma unroll
      for (int i = 0; i < 18; ++i) { pg8::Unit u; tk[i] = -1;
          if (S.next(i, u) && F.tid < 256) { const int mloc = u.pm - ints[32 + u.e], r = mloc * 256 + F.tid; tk[i] = (r < ints[u.e]) ? perm[(size_t)u.e * T + r] : 0; } }
#pragma unroll
      for (int i = 0; i < 18; ++i) if (tk[i] >= 0) tab[i * 256 + F.tid] = (unsigned)tk[i] * RB; }
    __syncthreads();
    pg8::EpiSwiglu E{WSP(unsigned char, WS_R2), F.in[17] + (size_t)layer * 32 * 2048, MOE_FP8 ? 1.0f / (XSCALE * WSCALE) : 1.0f};
    pg8::gemm_phase<pg8::EpiSwiglu, pg8::MoeSched, MOE_FP8>(F.lds + LDS_STAGE, (const char*)WSP(unsigned char, WS_HB), RB, (size_t)1024 * RB, S, E);
}
DI void moe_down_phase(Frame& F, int layer) {
    const int ntile = moe_tileoff(F, layer);
    LAS int* ints = (LAS int*)(F.lds + LDS_INTS);
    constexpr unsigned RB = 1024 * MOE_EB;
    pg8::MoeSched S; S.to_lane = (F.lane < 32) ? ints[33 + F.lane] : 0x7fffffff; S.total = ntile * 4; S.G = F.G; S.c = F.vcu; S.ntshift = 2; S.gather = false; S.tab = nullptr; S.rowb = RB;
    S.W = (const char*)(WSP(unsigned char, WS_WD) + (size_t)layer * 32 * 1024 * RB); S.wexp = (size_t)1024 * RB; S.wpn = (size_t)256 * RB;
    pg8::EpiDown E{WSP(unsigned char, WS_R1), F.in[19] + (size_t)layer * 32 * 1024, MOE_FP8 ? 1.0f / (ASCALE * WSCALE) : 1.0f};
    pg8::gemm_phase<pg8::EpiDown, pg8::MoeSched, MOE_FP8>(F.lds + LDS_STAGE, (const char*)WSP(unsigned char, WS_R2), RB, (size_t)128 * RB, S, E);
}

namespace idx1 {
constexpr int PITCH = OD_COLS_P;
DI unsigned f2key(float f) { const unsigned u = __float_as_uint(f + 0.0f); return u ^ ((u >> 31) ? 0xffffffffu : 0x80000000u); }
DI int mbcnt64(unsigned long long m) { return (int)__builtin_amdgcn_mbcnt_hi((unsigned)(m >> 32), __builtin_amdgcn_mbcnt_lo((unsigned)m, 0u)); }
DI int wsum6(int c) { int t = 0;
#pragma unroll
    for (int b = 0; b < 6; ++b) t += __builtin_popcountll(__ballot((c >> b) & 1)) << b;
    return t; }
template <int NJ> DI void select_finish(const unsigned (&key)[NJ], unsigned th, int* op, LAS unsigned* bnd, LAS int* list, int lane);
template <int NJ> DI void select256x2(const LAS float* rowA, const LAS float* rowB, int nA, int nB, int* opA, int* opB, LAS unsigned* bnd, LAS int* list, int lane) {
    unsigned keyA[NJ], keyB[NJ];
#pragma unroll
    for (int j = 0; j < NJ; ++j) { const int p = lane + 64 * j; keyA[j] = (p < nA) ? f2key(rowA[p]) : 0u; keyB[j] = (p < nB) ? f2key(rowB[p]) : 0u; }
    unsigned thA = 0u, thB = 0u;
#pragma unroll 1
    for (int bit = 15; bit >= 0; --bit) {
        const unsigned candA = (thA | (1u << bit)) << 16, candB = (thB | (1u << bit)) << 16; int cA = 0, cB = 0;
#pragma unroll
        for (int j = 0; j < NJ; ++j) { cA += (keyA[j] >= candA) ? 1 : 0; cB += (keyB[j] >= candB) ? 1 : 0; }
        int tA = 0, tB = 0;
#pragma unroll
        for (int b = 0; b < 6; ++b) { tA += __builtin_popcountll(__ballot((cA >> b) & 1)) << b; tB += __builtin_popcountll(__ballot((cB >> b) & 1)) << b; }
        if (tA >= 256) thA |= (1u << bit);
        if (tB >= 256) thB |= (1u << bit);
    }
    select_finish<NJ>(keyA, thA, opA, bnd, list, lane);
    select_finish<NJ>(keyB, thB, opB, bnd, list, lane);
}
template <int NJ> DI void select_finish(const unsigned (&key)[NJ], unsigned th, int* op, LAS unsigned* bnd, LAS int* list, int lane) {
    const unsigned lo32 = th << 16;
    int cg = 0, ce = 0;
#pragma unroll
    for (int j = 0; j < NJ; ++j) { const unsigned d = key[j] - lo32; cg += (key[j] >= lo32 && d > 0xffffu) ? 1 : 0; ce += (key[j] >= lo32 && d <= 0xffffu) ? 1 : 0; }
    int G = 0, pre = 0, B = 0, preE = 0;
#pragma unroll
    for (int b = 0; b < 6; ++b) { const unsigned long long m = __ballot((cg >> b) & 1); G += __builtin_popcountll(m) << b; pre += mbcnt64(m) << b;
        const unsigned long long me = __ballot((ce >> b) & 1); B += __builtin_popcountll(me) << b; preE += mbcnt64(me) << b; }
    const int dummy = 256 + lane;
    unsigned lo32b = lo32; asm volatile("" : "+s"(lo32b));
    {   int w = pre;
#pragma unroll
        for (int j = 0; j < NJ; ++j) { const unsigned d = key[j] - lo32b; const bool ab = key[j] >= lo32b && d > 0xffffu; list[ab ? w : dummy] = lane + 64 * j; w += ab ? 1 : 0; }
    }
    const int need = 256 - G;
    if (B <= 64) {
        unsigned lo32c = lo32; asm volatile("" : "+s"(lo32c));
        {   int w = preE;
#pragma unroll
            for (int j = 0; j < NJ; ++j) { const unsigned d = key[j] - lo32c; const bool eq = key[j] >= lo32c && d <= 0xffffu; bnd[eq ? w : 64 + lane] = (d << 11) | (unsigned)(2047 - (lane + 64 * j)); w += eq ? 1 : 0; }
        }
        LDS_WAIT(); asm volatile("" ::: "memory");
        const unsigned mine = (lane < B) ? bnd[lane] : 0u;
        int rank = 0;
#pragma unroll 1
        for (int i = 0; i < B; ++i) { const unsigned o = (unsigned)__builtin_amdgcn_readlane((int)mine, i); rank += (o > mine) ? 1 : 0; }
        list[(lane < B && rank < need) ? G + rank : dummy] = 2047 - (int)(mine & 2047u);
    } else {
        unsigned tl = 0u;
#pragma unroll 1
        for (int bit = 15; bit >= 0; --bit) {
            const unsigned cand = lo32 | tl | (1u << bit); int c = 0;
#pragma unroll
            for (int j = 0; j < NJ; ++j) c += (key[j] >= cand) ? 1 : 0;
            if (wsum6(c) >= 256) tl |= (1u << bit);
        }
        const unsigned tau = lo32 | tl; int base = G;
#pragma unroll
        for (int j = 0; j < NJ; ++j) { const bool sel = key[j] > tau && (key[j] - lo32) <= 0xffffu; const unsigned long long m = __ballot(sel);
            list[sel ? base + mbcnt64(m) : dummy] = lane + 64 * j; base += __builtin_popcountll(m); }
        const int need2 = 256 - base; int eb = 0;
#pragma unroll
        for (int j = 0; j < NJ; ++j) { const bool eq = key[j] == tau; const unsigned long long m = __ballot(eq); const int pos = eb + mbcnt64(m);
            list[(eq && pos < need2) ? base + pos : dummy] = lane + 64 * j; eb += __builtin_popcountll(m); }
    }
    LDS_WAIT(); asm volatile("" ::: "memory");
    *(i32x4*)(op + 4 * lane) = *(const LAS i32x4*)(list + 4 * lane);
    LDS_WAIT(); asm volatile("" ::: "memory");
}
DI void phase(Frame& F) {
    const int lane = F.lane, w = F.wave, tid = F.tid, hh = lane >> 5;
    const bf16_t* proj = WSP(bf16_t, WS_R1);
    { const float* kvw = F.in[9]; bf16_t* ckv = WSP(bf16_t, WS_CKV);
      const int gw = F.vcu * NWAVES + w, NGW = F.G * NWAVES;
      const float w0 = kvw[2 * lane], w1 = kvw[2 * lane + 1];
      for (int row = gw; row < T; row += 4 * NGW) {
          unsigned c[4];
#pragma unroll
          for (int u = 0; u < 4; ++u) c[u] = (row + u * NGW < T) ? *(const unsigned*)(proj + (size_t)(row + u * NGW) * PITCH + 2048 + 2 * lane) : 0u;
#pragma unroll
          for (int u = 0; u < 4; ++u) { if (row + u * NGW >= T) break;
              const float a = bflo(c[u]), b = bfhi(c[u]);
              const float ss = wave_sum(a * a + b * b);
              const float rs = 1.0f / sqrtf(ss * (1.0f / 128.0f) + RMS_EPS);
              *(unsigned*)(ckv + (size_t)(row + u * NGW) * 128 + 2 * lane) = pk_bf16(a * rs * w0, b * rs * w1); }
      } }
    LAS float* sc = (LAS float*)F.lds;
    LAS float* wq = (LAS float*)(F.lds + LDS_TAB);
    LAS unsigned* bnd = (LAS unsigned*)(F.lds + LDS_TAB + 1024) + w * 128;
    LAS int* list = (LAS int*)(F.lds + LDS_TAB + 8192) + w * 320;
    int* idxo = WSP(int, WS_IDX);
    for (int u = F.vcu; u < T / 16; u += F.G) {
        const int b = u >> 7, q0 = (((u & 127) + 16 * (b >> 1)) & 127) * 16;
        __syncthreads();
        if (tid < 128) wq[tid] = bf2f(proj[(size_t)(b * SEQ + q0 + (tid >> 3)) * PITCH + 2752 + (tid & 7)]);
        bf16x8 qf[4][4];
#pragma unroll
        for (int rg = 0; rg < 4; ++rg) { const bf16_t* qp = proj + (size_t)(b * SEQ + q0 + 4 * rg + ((lane & 31) >> 3)) * PITCH + 2176 + (lane & 7) * 64 + hh * 8;
#pragma unroll
            for (int s = 0; s < 4; ++s) qf[rg][s] = *(const bf16x8*)(qp + 16 * s); }
        const int nkb = (q0 + 15) / 32 + 1;
        const bf16_t* kbase = proj + (size_t)(b * SEQ + (lane & 31)) * PITCH + 2688 + hh * 8;
        bf16x8 kf[4], kn[4];
        if (w < nkb) {
#pragma unroll
            for (int s = 0; s < 4; ++s) kf[s] = *(const bf16x8*)(kbase + (size_t)(32 * w) * PITCH + 16 * s); }
        __syncthreads();
        for (int kb = w; kb < nkb; kb += NWAVES) {
            if (kb + NWAVES < nkb) {
#pragma unroll
                for (int s = 0; s < 4; ++s) kn[s] = *(const bf16x8*)(kbase + (size_t)(32 * (kb + NWAVES)) * PITCH + 16 * s); }
#pragma unroll
            for (int rg = 0; rg < 4; ++rg) {
                f32x16 dd = {};
#pragma unroll
                for (int s = 0; s < 4; ++s) dd = __builtin_amdgcn_mfma_f32_32x32x16_bf16(qf[rg][s], kf[s], dd, 0, 0, 0);
                float part[4];
#pragma unroll
                for (int q4 = 0; q4 < 4; ++q4) { const f32x4 wv = *(const LAS f32x4*)(wq + (4 * rg + q4) * 8 + 4 * hh);
                    part[q4] = wv[0] * fmaxf(dd[4 * q4], 0.f) + wv[1] * fmaxf(dd[4 * q4 + 1], 0.f) + wv[2] * fmaxf(dd[4 * q4 + 2], 0.f) + wv[3] * fmaxf(dd[4 * q4 + 3], 0.f); }
#pragma unroll
                for (int q4 = 0; q4 < 4; ++q4) part[q4] += __shfl_xor(part[q4], 32);
                const int key = 32 * kb + (lane & 31);
                if (hh == 0) { sc[(4 * rg + 0) * 2048 + key] = part[0]; sc[(4 * rg + 1) * 2048 + key] = part[1]; }
                else         { sc[(4 * rg + 2) * 2048 + key] = part[2]; sc[(4 * rg + 3) * 2048 + key] = part[3]; }
            }
#pragma unroll
            for (int s = 0; s < 4; ++s) kf[s] = kn[s];
        }
        __syncthreads();
        {
            const int qi = 2 * w, t = q0 + qi, n = t + 1;
            int* opA = idxo + (size_t)(b * SEQ + t) * 256; int* opB = opA + 256;
            if (n + 1 <= 256) {
#pragma unroll
                for (int j = 0; j < 4; ++j) { const int p = lane + 64 * j; opA[p] = (p < n) ? p : -1; opB[p] = (p < n + 1) ? p : -1; }
            } else {
                const LAS float* rowA = sc + qi * 2048; const LAS float* rowB = rowA + 2048;
                if (n + 1 <= 512) select256x2<8>(rowA, rowB, n, n + 1, opA, opB, bnd, list, lane);
                else if (n + 1 <= 1024) select256x2<16>(rowA, rowB, n, n + 1, opA, opB, bnd, list, lane);
                else if (n + 1 <= 1536) select256x2<24>(rowA, rowB, n, n + 1, opA, opB, bnd, list, lane);
                else select256x2<32>(rowA, rowB, n, n + 1, opA, opB, bnd, list, lane);
            }
        }
    }
    __syncthreads();
}
}

namespace spa1 {
constexpr int RP = 272;
constexpr int SPA_WAVES = 7;
constexpr int PITCH = OD_COLS_P;
DI s16x4 trrd(const LAS unsigned char* p) { typedef short v4i16_t __attribute__((ext_vector_type(4))); return __builtin_bit_cast(s16x4, __builtin_amdgcn_ds_read_tr16_b64_v4i16((LAS v4i16_t*)p)); }
DI void phase(Frame& F) {
    const int lane = F.lane, w = F.wave, hd = lane & 15, g = lane >> 4;
    const bf16_t* proj = WSP(bf16_t, WS_R1); const bf16_t* ckv = WSP(bf16_t, WS_CKV); const int* idx = WSP(int, WS_IDX); bf16_t* of = WSP(bf16_t, WS_R2);
    LAS unsigned char* buf = F.lds + w * (32 * RP + 2048);
    LAS float* dl = (LAS float*)(buf + 32 * RP);
    LAS unsigned* ofl = (LAS unsigned*)(buf + 32 * RP + 1024);
    const float slope2 = fexp2(-0.5f * (float)(hd + 1)) * LOG2E, sc2 = 0.08838834764831845f * LOG2E;
    if (w == SPA_WAVES) { p0_convert3(F, (LAS float*)(F.lds + NWAVES * (32 * RP + 2048)), F.vcu, F.G, N_GU1 + N_DN1, 1); return; }
    const int gw = F.vcu * SPA_WAVES + w, NGW = F.G * SPA_WAVES;
#define SPA_Q(jj, b_, t_, row_) const int lin_##jj = gw + (jj) * NGW, b_ = lin_##jj / SEQ, t_ = (lin_##jj + 131 * b_) % SEQ; const size_t row_ = (size_t)(b_ * SEQ + t_)
    i32x4 idr; bf16x8 qn[4];
    if (gw < T) { SPA_Q(0, b0_, t0_, row0_); (void)t0_; idr = *(const i32x4*)(idx + row0_ * 256 + 4 * lane);
        const bf16_t* qp = proj + row0_ * PITCH + hd * 128 + g * 8;
#pragma unroll
        for (int s = 0; s < 4; ++s) qn[s] = *(const bf16x8*)(qp + 32 * s); }
    for (int j = 0; gw + j * NGW < T; ++j) {
        const int lin = gw + j * NGW, b = lin / SEQ, t = (lin + 131 * b) % SEQ;
        const size_t row = (size_t)(b * SEQ + t);
        const int nsel = (t + 1 < 256) ? t + 1 : 256, nch = (nsel + 31) >> 5;
        { f32x4 d4;
#pragma unroll
          for (int e = 0; e < 4; ++e) d4[e] = idr[e] < 0 ? 1.0e30f : (float)(t - idr[e]);
          *(LAS f32x4*)(dl + 4 * lane) = d4; }
        { u32x4 o4;
#pragma unroll
          for (int e = 0; e < 4; ++e) o4[e] = (unsigned)(idr[e] < 0 ? 0 : idr[e]) * 256u;
          *(LAS u32x4*)(ofl + 4 * lane) = o4; }
        const char* ckvb = (const char*)(ckv + (size_t)b * SEQ * 128) + 16 * hd;
        bf16x8 qf[4];
#pragma unroll
        for (int s = 0; s < 4; ++s) qf[s] = qn[s];
        if (gw + (j + 1) * NGW < T) {
            const int lin2 = gw + (j + 1) * NGW, b2 = lin2 / SEQ, t2 = (lin2 + 131 * b2) % SEQ; const size_t row2 = (size_t)(b2 * SEQ + t2);
            idr = *(const i32x4*)(idx + row2 * 256 + 4 * lane);
            const bf16_t* qp = proj + row2 * PITCH + hd * 128 + g * 8;
#pragma unroll
            for (int s = 0; s < 4; ++s) qn[s] = *(const bf16x8*)(qp + 32 * s);
        }
        f32x4 O[8];
#pragma unroll
        for (int c = 0; c < 8; ++c) O[c] = (f32x4){0.f, 0.f, 0.f, 0.f};
        float mrun = -1.0e30f, lrun = 0.f;
#define SPA_CORE             const f32x4 kd0 = *(const LAS f32x4*)(dl + 32 * c + 4 * g) * slope2, kd1 = *(const LAS f32x4*)(dl + 32 * c + 16 + 4 * g) * slope2; \
            f32x4 s0 = {0.f, 0.f, 0.f, 0.f}, s1 = {0.f, 0.f, 0.f, 0.f}; \
_Pragma("unroll") \
            for (int s = 0; s < 4; ++s) { \
                const bf16x8 a0 = *(const LAS bf16x8*)(buf + hd * RP + (32 * s + 8 * g) * 2), a1 = *(const LAS bf16x8*)(buf + (16 + hd) * RP + (32 * s + 8 * g) * 2); \
                s0 = __builtin_amdgcn_mfma_f32_16x16x32_bf16(a0, qf[s], s0, 0, 0, 0); \
                s1 = __builtin_amdgcn_mfma_f32_16x16x32_bf16(a1, qf[s], s1, 0, 0, 0); \
            } \
            float mx = -INFINITY; \
_Pragma("unroll") \
            for (int i = 0; i < 4; ++i) { \
                s0[i] = s0[i] * sc2 - kd0[i]; \
                s1[i] = s1[i] * sc2 - kd1[i]; \
                mx = fmaxf(mx, fmaxf(s0[i], s1[i])); \
            } \
            mx = fmaxf(mx, __shfl_xor(mx, 16)); mx = fmaxf(mx, __shfl_xor(mx, 32)); \
            if (__ballot(mx > mrun + 8.0f) != 0ull) { const float mnew = fmaxf(mrun, mx), al = fexp2(mrun - mnew); mrun = mnew; lrun *= al; \
                _Pragma("unroll") for (int c8 = 0; c8 < 8; ++c8) O[c8] = O[c8] * al; } \
            float ls = 0.f; \
_Pragma("unroll") \
            for (int i = 0; i < 4; ++i) { s0[i] = fexp2(s0[i] - mrun); s1[i] = fexp2(s1[i] - mrun); ls += s0[i] + s1[i]; } \
            lrun += ls; \
            u32x4 pw; pw.x = pk_bf16(s0[0], s0[1]); pw.y = pk_bf16(s0[2], s0[3]); pw.z = pk_bf16(s1[0], s1[1]); pw.w = pk_bf16(s1[2], s1[3]); \
            const bf16x8 pf = __builtin_bit_cast(bf16x8, pw); \
            const int q = hd >> 2, p = hd & 3; \
_Pragma("unroll") \
            for (int c8 = 0; c8 < 8; ++c8) { \
                const LAS unsigned char* a = buf + (4 * g + q) * RP + (16 * c8 + 4 * p) * 2; \
                const s16x4 lo = trrd(a), hi = trrd(a + 16 * RP); \
                const bf16x8 vf = __builtin_shufflevector(lo, hi, 0, 1, 2, 3, 4, 5, 6, 7); \
                O[c8] = __builtin_amdgcn_mfma_f32_16x16x32_bf16(vf, pf, O[c8], 0, 0, 0); \
            }
        u32x4 grA[8], grB[8];
#define SPA_GLOAD(gr_, cc) do { _Pragma("unroll") for (int i_ = 0; i_ < 8; ++i_) gr_[i_] = *(const u32x4*)(ckvb + ofl[32 * (cc) + g + 4 * i_]); } while (0)
#define SPA_CHUNK(gr_, cnext_) do { \
            _Pragma("unroll") for (int i = 0; i < 8; ++i) *(LAS u32x4*)(buf + (g + 4 * i) * RP + 16 * hd) = gr_[i]; \
            if ((cnext_) < nch) SPA_GLOAD(gr_, (cnext_)); \
            SPA_CORE } while (0)
        SPA_GLOAD(grA, 0);
        if (nch > 1) SPA_GLOAD(grB, 1);
#pragma unroll 1
        for (int c2 = 0; c2 < nch; c2 += 2) {
            { const int c = c2; SPA_CHUNK(grA, c2 + 2); }
            if (c2 + 1 < nch) { const int c = c2 + 1; SPA_CHUNK(grB, c2 + 3); }
        }
#undef SPA_CHUNK
#undef SPA_GLOAD
        float lt = lrun + __shfl_xor(lrun, 16); lt += __shfl_xor(lt, 32);
        const float inv = 1.0f / lt;
        if (PLAIN_FP8) { unsigned char* op = (unsigned char*)of + row * 2048 + hd * 128 + 4 * g; const float iv = inv * MSCALE;
#pragma unroll
            for (int c8 = 0; c8 < 8; ++c8) *(unsigned*)(op + 16 * c8) = pk_fp8x4(O[c8][0] * iv, O[c8][1] * iv, O[c8][2] * iv, O[c8][3] * iv);
        } else { bf16_t* op = of + row * 2048 + hd * 128 + 4 * g;
#pragma unroll
            for (int c8 = 0; c8 < 8; ++c8) { u32x2 wv; wv.x = pk_bf16(O[c8][0] * inv, O[c8][1] * inv); wv.y = pk_bf16(O[c8][2] * inv, O[c8][3] * inv); *(u32x2*)(op + 16 * c8) = wv; } }
    }
}
}

constexpr int NPHASE = 16;
struct Args { const float* in[22]; float* out; unsigned char* ws; int ph_lo, ph_hi, bar_region, pad; };
__global__ void __launch_bounds__(NTHR, 2) fwd(Args args) {
    extern __shared__ __attribute__((aligned(16))) unsigned char lds_raw[];
    Frame F;
    F.lds = (LAS unsigned char*)lds_raw;
    F.tid = threadIdx.x; F.lane = F.tid & 63; F.wave = __builtin_amdgcn_readfirstlane(F.tid >> 6);
    F.G = gridDim.x; { const int bx = blockIdx.x; F.vcu = (F.G % 8 == 0) ? (bx % 8) * (F.G / 8) + bx / 8 : bx; }
    F.ws = args.ws; F.ctl = (gu32*)(args.ws + WS_CTL); F.out = args.out;
#pragma unroll
    for (int i = 0; i < 22; ++i) F.in[i] = args.in[i];
    volatile LAS unsigned* MISC = (volatile LAS unsigned*)(F.lds + LDS_MISC);
    if (F.tid < 64) MISC[F.tid] = 0u;
    __syncthreads();
    const int lo = args.ph_lo, hi = args.ph_hi;
    XcdBarrier bar; bar.bar = (unsigned*)(F.ctl + CW_BAR) + args.bar_region * XCD_BAR_WORDS; bar.x = 0; bar.st = nullptr;
    if (hi - lo > 1) bar = xcd_barrier_post((unsigned*)(F.ctl + CW_BAR) + args.bar_region * XCD_BAR_WORDS, MISC + 8);
#ifndef REPEAT_MASK
#define REPEAT_MASK 0
#endif
#ifndef PHASE_MASK
#define PHASE_MASK 0xFFFF
#endif
#define IN(k) (((PHASE_MASK >> (k)) & 1) && lo <= (k) && (k) < hi)
#define REPEAT_LOOP(k)
#define SEAM(k) do { if (IN(k) && IN((k) + 1)) xcd_barrier(bar); } while (0)

    if (IN(0)) { REPEAT_LOOP(0) { p0_prologue(F); } } SEAM(0);
    if (IN(1)) { REPEAT_LOOP(1) { pg8::PlainSched S; S.init(T, EV_COLS, D, D, WSP(unsigned char, WS_WEVIN), F.G, (int)blockIdx.x, IN_EB);
        pg8::EpiProj E{WSP(bf16_t, WS_R1), EV_COLS, IN_FP8 ? 1.0f / (XSCALE * WSCALE) : 1.0f};
        pg8::gemm_phase<pg8::EpiProj, pg8::PlainSched, IN_FP8>(F.lds + LDS_STAGE, (const char*)(IN_FP8 ? WSP(unsigned char, WS_X8) : WSP(unsigned char, WS_XB)), D * IN_EB, (size_t)128 * D * IN_EB, S, E); } } SEAM(1);
    if (IN(2)) { REPEAT_LOOP(2) { att0::phase(F); } } SEAM(2);
    if (IN(3)) { REPEAT_LOOP(3) { pg8::PlainSched S; S.init(T, D, D, D, WSP(unsigned char, WS_WEVOUT), F.G, (int)blockIdx.x, PL_EB);
        pg8::EpiRes E{nullptr, WSP(bf16_t, WS_XB), WSP(bf16_t, WS_PRE), PLAIN_FP8 ? 1.0f / (MSCALE * WSCALE) : 1.0f};
        pg8::gemm_phase<pg8::EpiRes, pg8::PlainSched, PLAIN_FP8>(F.lds + LDS_STAGE, (const char*)WSP(unsigned char, WS_R2), D * PL_EB, (size_t)128 * D * PL_EB, S, E); } } SEAM(3);
    if (IN(4)) { REPEAT_LOOP(4) { lnr::phase(F, 0); } } SEAM(4);
    if (IN(5)) { REPEAT_LOOP(5) { moe_up_phase(F, 0); } } SEAM(5);
    if (IN(6)) { REPEAT_LOOP(6) { moe_down_phase(F, 0); } } SEAM(6);
    if (IN(7)) { REPEAT_LOOP(7) { cmb_phase(F, 0, nullptr, WSP(bf16_t, WS_XB)); } } SEAM(7);
    if (IN(8)) { REPEAT_LOOP(8) { pg8::PlainSched S; S.init(T, OD_COLS_P, D, D, WSP(unsigned char, WS_WODIN), F.G, (int)blockIdx.x, IN1_EB);
        pg8::EpiProj E{WSP(bf16_t, WS_R1), OD_COLS_P, IN1_FP8 ? 1.0f / (XSCALE * WSCALE) : 1.0f};
        pg8::gemm_phase<pg8::EpiProj, pg8::PlainSched, IN1_FP8>(F.lds + LDS_STAGE, (const char*)(IN1_FP8 ? WSP(unsigned char, WS_X8) : WSP(unsigned char, WS_XB)), D * IN1_EB, (size_t)128 * D * IN1_EB, S, E); } } SEAM(8);
    if (IN(9)) { REPEAT_LOOP(9) { idx1::phase(F); } } SEAM(9);
    if (IN(10)) { REPEAT_LOOP(10) { spa1::phase(F); } } SEAM(10);
    if (IN(11)) { REPEAT_LOOP(11) { pg8::PlainSched S; S.init(T, D, 2048, 2048, WSP(unsigned char, WS_WCOMB), F.G, (int)blockIdx.x, PL_EB);
        pg8::EpiRes E{nullptr, WSP(bf16_t, WS_XB), WSP(bf16_t, WS_PRE), PLAIN_FP8 ? 1.0f / (MSCALE * WCSCALE) : 1.0f};
        pg8::gemm_phase<pg8::EpiRes, pg8::PlainSched, PLAIN_FP8>(F.lds + LDS_STAGE, (const char*)WSP(unsigned char, WS_R2), 2048 * PL_EB, (size_t)128 * 2048 * PL_EB, S, E); } } SEAM(11);
    if (IN(12)) { REPEAT_LOOP(12) { lnr::phase(F, 1); } } SEAM(12);
    if (IN(13)) { REPEAT_LOOP(13) { moe_up_phase(F, 1); } } SEAM(13);
    if (IN(14)) { REPEAT_LOOP(14) { moe_down_phase(F, 1); } } SEAM(14);
    if (IN(15)) { REPEAT_LOOP(15) { cmb_phase(F, 1, F.out, nullptr); } } SEAM(15);
#undef IN
#undef SEAM
}

extern "C" void kernel_launch(void* const* d_in, const int* in_sizes, int n_in, void* d_out, int out_size, void* d_ws, size_t ws_size, hipStream_t stream) {
    static int grid = 0;
    if (grid == 0) {
        if (n_in != 22 || out_size != T * D || ws_size < WS_END) { fprintf(stderr, "kernel_launch: unexpected shapes (n_in %d out %d ws %zu need %zu)\n", n_in, out_size, ws_size, (size_t)WS_END); grid = -1; return; }
        int dev = 0, cus = 0;
        if (hipGetDevice(&dev) != hipSuccess || hipDeviceGetAttribute(&cus, hipDeviceAttributeMultiprocessorCount, dev) != hipSuccess) { grid = -1; return; }
        if (hipFuncSetAttribute((const void*)fwd, hipFuncAttributeMaxDynamicSharedMemorySize, LDS_BYTES) != hipSuccess) { fprintf(stderr, "kernel_launch: hipFuncSetAttribute failed\n"); grid = -1; return; }
        int per_cu = 0;
        if (hipOccupancyMaxActiveBlocksPerMultiprocessor(&per_cu, (const void*)fwd, NTHR, LDS_BYTES) != hipSuccess || per_cu < 1) fprintf(stderr, "kernel_launch: occupancy query reports %d\n", per_cu);
        (void)hipGetLastError();
        grid = cus;
    }
    if (grid < 0) return;
    if (hipMemsetAsync((char*)d_ws + WS_CTL, 0, CTL_ZERO_BYTES, stream) != hipSuccess) return;
    Args a{};
    for (int i = 0; i < 22; ++i) a.in[i] = (const float*)d_in[i];
    a.out = (float*)d_out; a.ws = (unsigned char*)d_ws;
#if MK_PER_PHASE
    for (int p = 0; p < NPHASE; ++p) { a.ph_lo = p; a.ph_hi = p + 1; hipLaunchKernelGGL(fwd, dim3(grid), dim3(NTHR), LDS_BYTES, stream, a); }
#elif REPEAT_MASK
    { int lo = 0, reg = 0;
      for (int k = 0; k < NPHASE; ++k) if ((REPEAT_MASK >> k) & 1) {
          a.ph_lo = lo; a.ph_hi = k + 1; a.bar_region = reg++; hipLaunchKernelGGL(fwd, dim3(grid), dim3(NTHR), LDS_BYTES, stream, a);
          a.ph_lo = k; a.ph_hi = k + 1; a.bar_region = reg++; hipLaunchKernelGGL(fwd, dim3(grid), dim3(NTHR), LDS_BYTES, stream, a);
          lo = k + 1; }
      if (lo < NPHASE) { a.ph_lo = lo; a.ph_hi = NPHASE; a.bar_region = reg++; hipLaunchKernelGGL(fwd, dim3(grid), dim3(NTHR), LDS_BYTES, stream, a); } }
#else
    a.ph_lo = 0; a.ph_hi = NPHASE; hipLaunchKernelGGL(fwd, dim3(grid), dim3(NTHR), LDS_BYTES, stream, a);
#endif
}
```
